# Optimizing an MI355X kernel written in HIP

```python
import math
import jax, jax.numpy as jnp
from jax import lax
import numpy as np

D_MODEL = 1024
BATCH = 2
SEQ = 8192
DEPTH = 2

HEAD_DIM = 64
N_HEADS = 8
N_KV_HEADS = 2
GQA = N_HEADS // N_KV_HEADS
ATTN_WIDTH = N_HEADS * HEAD_DIM
KV_WIDTH = N_KV_HEADS * HEAD_DIM
WINDOW = 128
ATTN_BLOCK = 128
SSM_WIDTH = D_MODEL - ATTN_WIDTH
SSM_GROUP_DIM = 16
SSM_GROUPS = SSM_WIDTH // SSM_GROUP_DIM
SSM_STATE = 64
DT_MIN = 1e-3
DT_MAX = 1e-1
IN_WIDTH = ATTN_WIDTH + 2 * KV_WIDTH + SSM_WIDTH
D_FF = 3584
N_EXPERTS = 8
TOP_K = 2
MOE_BLOCK = 256
N_DENSE = (DEPTH + 1) // 2
N_MOE = DEPTH // 2
NORM_EPS = 1e-6
NEG_INF = -1e30

kernel_name = "hymba_swa_sink_s5_moe"


def _rms(x, g):
    xf = x.astype(jnp.float32)
    y = xf * lax.rsqrt(jnp.mean(xf * xf, axis=-1, keepdims=True) + NORM_EPS)
    return y * g.astype(jnp.float32)


def _swa_sink_attention(q, k, v, sinks):
    bsz, seq = q.shape[0], q.shape[1]
    nb = seq // ATTN_BLOCK
    qb = q.reshape(bsz, nb, ATTN_BLOCK, N_KV_HEADS, GQA, HEAD_DIM)
    kb = k.reshape(bsz, nb, ATTN_BLOCK, N_KV_HEADS, HEAD_DIM)
    vb = v.reshape(bsz, nb, ATTN_BLOCK, N_KV_HEADS, HEAD_DIM)

    def with_prev(t):
        prev = jnp.concatenate([jnp.zeros_like(t[:, :1]), t[:, :-1]], axis=1)
        return jnp.concatenate([prev, t], axis=2)

    kk, vv = with_prev(kb), with_prev(vb)
    s = jnp.einsum('bnqkgd,bnskd->bnkgqs', qb, kk) * (HEAD_DIM ** -0.5)
    qi = jnp.arange(ATTN_BLOCK)[:, None]
    sj = jnp.arange(2 * ATTN_BLOCK)[None, :]
    delta = qi + ATTN_BLOCK - sj
    band = (delta >= 0) & (delta < WINDOW)
    not_first = (jnp.arange(nb) > 0)[:, None, None]
    valid = band[None] & (not_first | (sj >= ATTN_BLOCK)[None])
    s = jnp.where(valid[None, :, None, None], s, NEG_INF)
    sink = jnp.broadcast_to(
        sinks.astype(jnp.float32).reshape(1, 1, N_KV_HEADS, GQA, 1, 1), s.shape[:-1] + (1,))
    p = jax.nn.softmax(jnp.concatenate([s, sink], axis=-1), axis=-1)[..., :-1]
    o = jnp.einsum('bnkgqs,bnskd->bnqkgd', p, vv)
    return o.reshape(bsz, seq, ATTN_WIDTH)


def _s5_mixer(u, lam_re, lam_im, log_dt, b_re, b_im, c_re, c_im, d_skip, w_glu):
    f32 = jnp.float32
    bsz, seq = u.shape[0], u.shape[1]
    ug = u.astype(f32).reshape(bsz, seq, SSM_GROUPS, SSM_GROUP_DIM)
    lr, li = lam_re.astype(f32), lam_im.astype(f32)
    dt = jnp.exp(log_dt.astype(f32))[:, None]
    mag = jnp.exp(lr * dt)
    ang = li * dt
    ab_re, ab_im = mag * jnp.cos(ang), mag * jnp.sin(ang)
    nr = ab_re - 1.0
    den = lr * lr + li * li
    f_re = (nr * lr + ab_im * li) / den
    f_im = (ab_im * lr - nr * li) / den
    br, bi = b_re.astype(f32), b_im.astype(f32)
    bb_re = f_re[..., None] * br - f_im[..., None] * bi
    bb_im = f_re[..., None] * bi + f_im[..., None] * br
    bu_re = jnp.einsum('blgc,gnc->blgn', ug, bb_re)
    bu_im = jnp.einsum('blgc,gnc->blgn', ug, bb_im)
    a_re = jnp.broadcast_to(ab_re, bu_re.shape)
    a_im = jnp.broadcast_to(ab_im, bu_im.shape)

    def combine(e1, e2):
        a1r, a1i, b1r, b1i = e1
        a2r, a2i, b2r, b2i = e2
        return (a2r * a1r - a2i * a1i,
                a2r * a1i + a2i * a1r,
                a2r * b1r - a2i * b1i + b2r,
                a2r * b1i + a2i * b1r + b2i)

    _, _, s_re, s_im = lax.associative_scan(combine, (a_re, a_im, bu_re, bu_im), axis=1)
    y = (jnp.einsum('blgn,gcn->blgc', s_re, c_re.astype(f32))
         - jnp.einsum('blgn,gcn->blgc', s_im, c_im.astype(f32))
         + d_skip.astype(f32).reshape(SSM_GROUPS, SSM_GROUP_DIM) * ug)
    y = jax.nn.gelu(y.reshape(bsz, seq, SSM_WIDTH))
    return y * jax.nn.sigmoid(y @ w_glu.astype(f32))


def _swiglu(h, wg, wu, wd):
    return (jax.nn.silu(h @ wg) * (h @ wu)) @ wd


def _moe_swiglu(x2d, w_router, wg, wu, wd):
    n_tok = x2d.shape[0]
    logits = (x2d @ w_router).astype(jnp.float32)
    top_v, top_i = lax.top_k(logits, TOP_K)
    gates = jax.nn.softmax(top_v, axis=-1).astype(x2d.dtype)
    n_assign = n_tok * TOP_K
    flat_e = top_i.reshape(-1)
    flat_tok = jnp.repeat(jnp.arange(n_tok, dtype=jnp.int32), TOP_K)
    flat_g = gates.reshape(-1)
    order = jnp.argsort(flat_e)
    se = flat_e[order]
    counts = jnp.bincount(flat_e, length=N_EXPERTS)
    start = jnp.cumsum(counts) - counts
    padded = ((counts + MOE_BLOCK - 1) // MOE_BLOCK) * MOE_BLOCK
    pend = jnp.cumsum(padded)
    pstart = pend - padded
    dest = pstart[se] + jnp.arange(n_assign) - start[se]
    nblk = -(-n_assign // MOE_BLOCK) + N_EXPERTS
    cap = nblk * MOE_BLOCK
    buf_tok = jnp.zeros((cap,), jnp.int32).at[dest].set(flat_tok[order])
    buf_gate = jnp.zeros((cap,), x2d.dtype).at[dest].set(flat_g[order])
    block_e = jnp.clip(jnp.searchsorted(pend, jnp.arange(nblk) * MOE_BLOCK, side='right'),
                       0, N_EXPERTS - 1)

    def run_block(args):
        tok, g, e = args
        xb = x2d[tok]
        return _swiglu(xb, wg[e], wu[e], wd[e]) * g[:, None]

    y = lax.map(run_block, (buf_tok.reshape(nblk, MOE_BLOCK),
                            buf_gate.reshape(nblk, MOE_BLOCK), block_e))
    return jnp.zeros_like(x2d).at[buf_tok].add(y.reshape(cap, D_MODEL))


def setup_inputs(seed: int = 0) -> dict:
    key = jax.random.key(seed)
    ks = iter(jax.random.split(key, 32))
    nrm = lambda shape, scale: jax.random.normal(next(ks), shape, jnp.float32) * scale
    gain = lambda shape: 1.0 + nrm(shape, 0.02)
    n_idx = jnp.arange(SSM_STATE, dtype=jnp.float32)[None, None, :]
    return {
        "x": nrm((BATCH, SEQ, D_MODEL), 1.0),
        "attn_norm_g": gain((DEPTH, D_MODEL)),
        "w_in": nrm((DEPTH, D_MODEL, IN_WIDTH), D_MODEL ** -0.5),
        "q_norm_g": gain((DEPTH, HEAD_DIM)),
        "k_norm_g": gain((DEPTH, HEAD_DIM)),
        "sinks": nrm((DEPTH, N_HEADS), 0.5),
        "lam_re": -0.5 + nrm((DEPTH, SSM_GROUPS, SSM_STATE), 0.01),
        "lam_im": math.pi * n_idx + nrm((DEPTH, SSM_GROUPS, SSM_STATE), 0.01),
        "log_dt": jax.random.uniform(next(ks), (DEPTH, SSM_GROUPS), jnp.float32,
                                     math.log(DT_MIN), math.log(DT_MAX)),
        "b_re": nrm((DEPTH, SSM_GROUPS, SSM_STATE, SSM_GROUP_DIM), (2 * SSM_GROUP_DIM) ** -0.5),
        "b_im": nrm((DEPTH, SSM_GROUPS, SSM_STATE, SSM_GROUP_DIM), (2 * SSM_GROUP_DIM) ** -0.5),
        "c_re": nrm((DEPTH, SSM_GROUPS, SSM_GROUP_DIM, SSM_STATE), (2 * SSM_STATE) ** -0.5),
        "c_im": nrm((DEPTH, SSM_GROUPS, SSM_GROUP_DIM, SSM_STATE), (2 * SSM_STATE) ** -0.5),
        "d_skip": nrm((DEPTH, SSM_WIDTH), 1.0),
        "w_glu": nrm((DEPTH, SSM_WIDTH, SSM_WIDTH), SSM_WIDTH ** -0.5),
        "attn_out_g": gain((DEPTH, ATTN_WIDTH)),
        "ssm_out_g": gain((DEPTH, SSM_WIDTH)),
        "w_o": nrm((DEPTH, D_MODEL, D_MODEL), D_MODEL ** -0.5),
        "ffn_norm_g": gain((DEPTH, D_MODEL)),
        "dense_wg": nrm((N_DENSE, D_MODEL, D_FF), D_MODEL ** -0.5),
        "dense_wu": nrm((N_DENSE, D_MODEL, D_FF), D_MODEL ** -0.5),
        "dense_wd": nrm((N_DENSE, D_FF, D_MODEL), D_FF ** -0.5),
        "router_w": nrm((N_MOE, D_MODEL, N_EXPERTS), D_MODEL ** -0.5),
        "moe_wg": nrm((N_MOE, N_EXPERTS, D_MODEL, D_FF), D_MODEL ** -0.5),
        "moe_wu": nrm((N_MOE, N_EXPERTS, D_MODEL, D_FF), D_MODEL ** -0.5),
        "moe_wd": nrm((N_MOE, N_EXPERTS, D_FF, D_MODEL), D_FF ** -0.5),
    }


def reference(x, attn_norm_g, w_in, q_norm_g, k_norm_g, sinks, lam_re, lam_im, log_dt,
              b_re, b_im, c_re, c_im, d_skip, w_glu, attn_out_g, ssm_out_g, w_o,
              ffn_norm_g, dense_wg, dense_wu, dense_wd, router_w, moe_wg, moe_wu, moe_wd):
    bsz, seq = x.shape[0], x.shape[1]
    for l in range(DEPTH):
        hn = _rms(x, attn_norm_g[l]).astype(x.dtype)
        proj = hn @ w_in[l]
        q = proj[..., :ATTN_WIDTH].reshape(bsz, seq, N_HEADS, HEAD_DIM)
        k = proj[..., ATTN_WIDTH:ATTN_WIDTH + KV_WIDTH].reshape(bsz, seq, N_KV_HEADS, HEAD_DIM)
        v = proj[..., ATTN_WIDTH + KV_WIDTH:ATTN_WIDTH + 2 * KV_WIDTH].reshape(
            bsz, seq, N_KV_HEADS, HEAD_DIM)
        u = proj[..., ATTN_WIDTH + 2 * KV_WIDTH:]
        q = _rms(q, q_norm_g[l])
        k = _rms(k, k_norm_g[l])
        attn = _swa_sink_attention(q, k, v.astype(jnp.float32), sinks[l])
        ssm = _s5_mixer(u, lam_re[l], lam_im[l], log_dt[l], b_re[l], b_im[l],
                        c_re[l], c_im[l], d_skip[l], w_glu[l])
        mix = jnp.concatenate([_rms(attn, attn_out_g[l]), _rms(ssm, ssm_out_g[l])],
                              axis=-1).astype(x.dtype)
        x = x + mix @ w_o[l]
        hn = _rms(x, ffn_norm_g[l]).astype(x.dtype)
        if l % 2 == 0:
            i = l // 2
            x = x + _swiglu(hn, dense_wg[i], dense_wu[i], dense_wd[i])
        else:
            i = l // 2
            y = _moe_swiglu(hn.reshape(bsz * seq, D_MODEL), router_w[i],
                            moe_wg[i], moe_wu[i], moe_wd[i])
            x = x + y.reshape(bsz, seq, D_MODEL)
    return x
```

```cpp
#include <hip/hip_runtime.h>
#include <cstdio>
#include <cstdint>

#ifndef MK_N_LAUNCHES
#define MK_N_LAUNCHES 0
#endif

constexpr int BATCH = 2, SEQ = 8192, T = BATCH * SEQ, D = 1024, INW = 1280, FF = 3584, NE = 8;
constexpr int NH = 8, NKV = 2, HD = 64, AW = 512, KVW = 128, SW = 512, NG = 32, GD = 16, NS = 64, WIN = 128;
constexpr int QOFF = 0, KOFF = 512, VOFF = 640, UOFF = 768;
constexpr float EPS = 1e-6f;
constexpr float LOG2E = 1.4426950408889634f;
constexpr int CAP = 2 * T + NE * 256;
constexpr int CN = 16;

namespace pg8 {
#define PG8_LAS __attribute__((address_space(3)))
typedef unsigned short bf16_t;
typedef short bf16x8 __attribute__((ext_vector_type(8)));
typedef float f32x4 __attribute__((ext_vector_type(4)));
typedef float f32x2 __attribute__((ext_vector_type(2)));
typedef unsigned u32x4 __attribute__((ext_vector_type(4)));
typedef unsigned u32x2 __attribute__((ext_vector_type(2)));
constexpr int BM = 256, BK = 64, HALF = 128, HTB = HALF * BK * 2, STAGE_BYTES = 8 * HTB, NXCD = 8, WGM = 8;

__host__ __device__ __forceinline__ int lds_byte(int r, int c) { const int st = (r >> 4) * 2 + (c >> 5), rr = r & 15, cc = c & 31, ob = rr * 64 + cc * 2; return st * 1024 + (ob ^ (((ob >> 9) & 1) << 5)); }
__host__ __device__ __forceinline__ void stage_rc(int b, int& R, int& C) { const int st = b / 1024, sb = b % 1024, swz = sb ^ (((sb >> 9) & 1) << 5); R = (st >> 1) * 16 + swz / 64; C = (st & 1) * 32 + (swz % 64) / 2; }
__host__ __device__ __forceinline__ int perm32(int rho) { const int n = rho >> 4, i = rho & 15; return 8 * (i >> 2) + 4 * n + (i & 3); }

struct Unit { int pm, pn, pb; };
struct Gemm { const bf16_t* A; const bf16_t* Bt; int K; const int* idx; };

struct StaticOrder {
    int nM, nN, nwg, G, c;
    __device__ void init(int M, int N, int G_, int c_) { nM = M / BM; nN = N / BM; nwg = nM * nN; G = G_; c = c_; }
    __device__ bool next(int i, Unit& u) const {
        const long L = (long)i * G + c; if (L >= nwg) return false;
        int wgid = (int)L; { const int q = nwg / NXCD, r = nwg % NXCD, xcd = wgid % NXCD, off = wgid / NXCD; wgid = (xcd < r ? xcd * (q + 1) : r * (q + 1) + (xcd - r) * q) + off; }
        const int nig = WGM * nN, gid = wgid / nig, fm = gid * WGM, gsz = (nM - fm) < WGM ? (nM - fm) : WGM;
        u.pm = fm + ((wgid % nig) % gsz); u.pn = (wgid % nig) / gsz; u.pb = u.pn; return true;
    }
};
struct MoeOrder {
    int nM, nN, nwg, G, c; int pend[8];
    __device__ void init(const int* pendg, int N, int G_, int c_) {
#pragma unroll
        for (int e = 0; e < 8; ++e) pend[e] = __builtin_amdgcn_readfirstlane(pendg[e]);
        nM = pend[7]; nN = N / BM; nwg = nM * nN; G = G_; c = c_; }
    __device__ bool next(int i, Unit& u) const {
        const long L = (long)i * G + c; if (L >= nwg) return false;
        int wgid = (int)L; { const int q = nwg / NXCD, r = nwg % NXCD, xcd = wgid % NXCD, off = wgid / NXCD; wgid = (xcd < r ? xcd * (q + 1) : r * (q + 1) + (xcd - r) * q) + off; }
        const int nig = WGM * nN, gid = wgid / nig, fm = gid * WGM, gsz = (nM - fm) < WGM ? (nM - fm) : WGM;
        u.pm = fm + ((wgid % nig) % gsz); u.pn = (wgid % nig) / gsz;
        int e = 0;
#pragma unroll
        for (int k = 0; k < 7; ++k) e += (pend[k] <= u.pm) ? 1 : 0;
        u.pb = e * nN + u.pn; return true;
    }
};

__device__ __forceinline__ unsigned cvt_pk_bf16(float lo, float hi) { unsigned r; asm volatile("v_cvt_pk_bf16_f32 %0, %1, %2" : "=v"(r) : "v"(lo), "v"(hi)); return r; }
__device__ __forceinline__ float bf_lo(unsigned w) { return __uint_as_float(w << 16); }
__device__ __forceinline__ float bf_hi(unsigned w) { return __uint_as_float(w & 0xffff0000u); }
__device__ __forceinline__ float sum4(const float* p) { const f32x4 v = *(const f32x4*)p; return (v[0] + v[1]) + (v[2] + v[3]); }
__device__ __forceinline__ float sum16(const float* p) { return (sum4(p) + sum4(p + 4)) + (sum4(p + 8) + sum4(p + 12)); }
__device__ __forceinline__ float sum8(const float* p) { return sum4(p) + sum4(p + 4); }

struct EpiInProj {
    static constexpr bool PERM = true, MID = false; static constexpr int MID_T = 0;
    bf16_t* O; const float* ssq; const float* gq; const float* gk; float qscale;
    __device__ __forceinline__ void begin(const Unit&, int) const {}
    __device__ __forceinline__ void mid(f32x4 (&)[2][2][4][2], const Unit&, int, int, int, int, int) const {}
    __device__ __forceinline__ void operator()(const f32x4 (&acc)[2][2][4][2], const Unit& u, int ui, int wr, int wc, int fr, int fq) const {
        const int row0 = u.pm * BM + wr * 64 + fr, tcol0 = u.pn * BM + 64 * wc;
        const int kind = tcol0 < KOFF ? 0 : (tcol0 < VOFF ? 1 : 2);
        f32x4 gv[2][2];
        if (kind < 2) { const float* g = kind == 0 ? gq : gk;
#pragma unroll
            for (int bj = 0; bj < 2; ++bj)
#pragma unroll
                for (int n = 0; n < 2; ++n) gv[bj][n] = *(const f32x4*)(g + 32 * bj + 8 * fq + 4 * n); }
#pragma unroll
        for (int ai = 0; ai < 2; ++ai)
#pragma unroll
            for (int m = 0; m < 4; ++m) {
                const int row = row0 + ai * HALF + m * 16;
                const float rinv = 1.0f / sqrtf(sum16(ssq + (size_t)row * 16) * (1.0f / D) + EPS);
                f32x4 v[2][2];
#pragma unroll
                for (int bj = 0; bj < 2; ++bj)
#pragma unroll
                    for (int n = 0; n < 2; ++n) v[bj][n] = acc[ai][bj][m][n] * rinv;
                if (kind < 2) {
                    float ss = 0.f;
#pragma unroll
                    for (int bj = 0; bj < 2; ++bj)
#pragma unroll
                        for (int n = 0; n < 2; ++n) { const f32x4 x = v[bj][n]; ss += (x[0] * x[0] + x[1] * x[1]) + (x[2] * x[2] + x[3] * x[3]); }
                    ss += __shfl_xor(ss, 16); ss += __shfl_xor(ss, 32);
                    const float hr = (1.0f / sqrtf(ss * (1.0f / HD) + EPS)) * (kind == 0 ? qscale : 1.0f);
#pragma unroll
                    for (int bj = 0; bj < 2; ++bj)
#pragma unroll
                        for (int n = 0; n < 2; ++n) v[bj][n] = v[bj][n] * gv[bj][n] * hr;
                }
                bf16_t* rowp = O + (size_t)row * INW + tcol0 + 8 * fq;
#pragma unroll
                for (int bj = 0; bj < 2; ++bj) { u32x4 w; w.x = cvt_pk_bf16(v[bj][0][0], v[bj][0][1]); w.y = cvt_pk_bf16(v[bj][0][2], v[bj][0][3]); w.z = cvt_pk_bf16(v[bj][1][0], v[bj][1][1]); w.w = cvt_pk_bf16(v[bj][1][2], v[bj][1][3]);
                    *(u32x4*)(rowp + 32 * bj) = w; }
            }
    }
};
struct EpiGlu {
    static constexpr bool PERM = true, MID = false; static constexpr int MID_T = 0;
    const bf16_t* Y; bf16_t* MIX; float* ssq;
    __device__ __forceinline__ void begin(const Unit&, int) const {}
    __device__ __forceinline__ void mid(f32x4 (&)[2][2][4][2], const Unit&, int, int, int, int, int) const {}
    __device__ __forceinline__ void operator()(const f32x4 (&acc)[2][2][4][2], const Unit& u, int ui, int wr, int wc, int fr, int fq) const {
        const int row0 = u.pm * BM + wr * 64 + fr, col0 = u.pn * BM + wc * 32 + 8 * fq;
#pragma unroll
        for (int ai = 0; ai < 2; ++ai)
#pragma unroll
            for (int m = 0; m < 4; ++m) {
                const int row = row0 + ai * HALF + m * 16; float ss = 0.f;
#pragma unroll
                for (int bj = 0; bj < 2; ++bj) {
                    const u32x4 yw = *(const u32x4*)(Y + (size_t)row * SW + col0 + bj * HALF);
                    const float y[8] = {bf_lo(yw.x), bf_hi(yw.x), bf_lo(yw.y), bf_hi(yw.y), bf_lo(yw.z), bf_hi(yw.z), bf_lo(yw.w), bf_hi(yw.w)};
                    float s[8];
#pragma unroll
                    for (int n = 0; n < 2; ++n)
#pragma unroll
                        for (int j = 0; j < 4; ++j) { const float g = acc[ai][bj][m][n][j]; const float o = y[4 * n + j] / (1.0f + __expf(-g)); s[4 * n + j] = o; ss += o * o; }
                    u32x4 w; w.x = cvt_pk_bf16(s[0], s[1]); w.y = cvt_pk_bf16(s[2], s[3]); w.z = cvt_pk_bf16(s[4], s[5]); w.w = cvt_pk_bf16(s[6], s[7]);
                    *(u32x4*)(MIX + (size_t)row * D + AW + col0 + bj * HALF) = w;
                }
                ss += __shfl_xor(ss, 16); ss += __shfl_xor(ss, 32);
                if (fq == 0) ssq[(size_t)row * 8 + u.pn * 4 + wc] = ss;
            }
    }
};
template <bool WO> struct EpiRes {
    static constexpr bool PERM = false, MID = WO; static constexpr int MID_T = 8;
    const float* res; float* out; bf16_t* XB; float* ssq_out; const float* ssq_a; const float* ssq_s;
    PG8_LAS float* tab;
    __device__ __forceinline__ void begin(const Unit& u, int ui) const {
        if (WO) { const int tid = threadIdx.x; if (tid < BM) { const int row = u.pm * BM + tid;
            const float ra = 1.0f / sqrtf(sum8(ssq_a + (size_t)row * 8) * (1.0f / AW) + EPS), rs = 1.0f / sqrtf(sum8(ssq_s + (size_t)row * 8) * (1.0f / SW) + EPS);
            *(PG8_LAS f32x2*)(tab + ((ui & 1) * BM + tid) * 2) = (f32x2){ra / rs, rs}; } }
    }
    __device__ __forceinline__ void mid(f32x4 (&acc)[2][2][4][2], const Unit& u, int ui, int wr, int wc, int fr, int fq) const {
        const int r0 = wr * 64 + fr;
#pragma unroll
        for (int ai = 0; ai < 2; ++ai)
#pragma unroll
            for (int m = 0; m < 4; ++m) {
                const float f = tab[((ui & 1) * BM + r0 + ai * HALF + m * 16) * 2];
#pragma unroll
                for (int bj = 0; bj < 2; ++bj)
#pragma unroll
                    for (int n = 0; n < 2; ++n) acc[ai][bj][m][n] *= f;
            }
    }
    __device__ __forceinline__ void operator()(const f32x4 (&acc)[2][2][4][2], const Unit& u, int ui, int wr, int wc, int fr, int fq) const {
        const int r0 = wr * 64 + fr, row0 = u.pm * BM + r0, col0 = u.pn * BM + wc * 32 + 4 * fq;
#pragma unroll
        for (int ai = 0; ai < 2; ++ai)
#pragma unroll
            for (int m = 0; m < 4; ++m) {
                const int row = row0 + ai * HALF + m * 16; float ss = 0.f;
                float sc = 1.0f; if (WO) sc = tab[((ui & 1) * BM + r0 + ai * HALF + m * 16) * 2 + 1];
                const size_t off = (size_t)row * D + col0;
#pragma unroll
                for (int bj = 0; bj < 2; ++bj)
#pragma unroll
                    for (int n = 0; n < 2; ++n) {
                        const f32x4 r = *(const f32x4*)(res + off + bj * HALF + n * 16);
                        const f32x4 o = r + acc[ai][bj][m][n] * sc;
                        *(f32x4*)(out + off + bj * HALF + n * 16) = o;
                        u32x2 w; w.x = cvt_pk_bf16(o[0], o[1]); w.y = cvt_pk_bf16(o[2], o[3]);
                        *(u32x2*)(XB + off + bj * HALF + n * 16) = w;
                        ss += (o[0] * o[0] + o[1] * o[1]) + (o[2] * o[2] + o[3] * o[3]);
                    }
                ss += __shfl_xor(ss, 16); ss += __shfl_xor(ss, 32);
                if (fq == 0) ssq_out[(size_t)row * 16 + u.pn * 4 + wc] = ss;
            }
    }
};
template <bool MOE> struct EpiSwiglu {
    static constexpr bool PERM = true, MID = false; static constexpr int MID_T = 0;
    bf16_t* H; const float* rs;
    __device__ __forceinline__ void begin(const Unit&, int) const {}
    __device__ __forceinline__ void mid(f32x4 (&)[2][2][4][2], const Unit&, int, int, int, int, int) const {}
    __device__ __forceinline__ void operator()(const f32x4 (&acc)[2][2][4][2], const Unit& u, int ui, int wr, int wc, int fr, int fq) const {
        const int row0 = u.pm * BM + wr * 64 + fr, hcol = u.pn * HALF + wc * 32 + 8 * fq;
#pragma unroll
        for (int ai = 0; ai < 2; ++ai)
#pragma unroll
            for (int m = 0; m < 4; ++m) {
                const int row = row0 + ai * HALF + m * 16;
                float rinv; if (MOE) rinv = rs[row]; else rinv = 1.0f / sqrtf(sum16(rs + (size_t)row * 16) * (1.0f / D) + EPS);
                float h[8];
#pragma unroll
                for (int n = 0; n < 2; ++n)
#pragma unroll
                    for (int j = 0; j < 4; ++j) { const float g = acc[ai][0][m][n][j] * rinv, uu = acc[ai][1][m][n][j] * rinv; h[4 * n + j] = g / (1.0f + __expf(-g)) * uu; }
                u32x4 w; w.x = cvt_pk_bf16(h[0], h[1]); w.y = cvt_pk_bf16(h[2], h[3]); w.z = cvt_pk_bf16(h[4], h[5]); w.w = cvt_pk_bf16(h[6], h[7]);
                *(u32x4*)(H + (size_t)row * FF + hcol) = w;
            }
    }
};
struct EpiMoeDown {
    static constexpr bool PERM = true, MID = false; static constexpr int MID_T = 0;
    bf16_t* Ys; const float* gate;
    __device__ __forceinline__ void begin(const Unit&, int) const {}
    __device__ __forceinline__ void mid(f32x4 (&)[2][2][4][2], const Unit&, int, int, int, int, int) const {}
    __device__ __forceinline__ void operator()(const f32x4 (&acc)[2][2][4][2], const Unit& u, int ui, int wr, int wc, int fr, int fq) const {
        const int row0 = u.pm * BM + wr * 64 + fr, col0 = u.pn * BM + wc * 32 + 8 * fq;
#pragma unroll
        for (int ai = 0; ai < 2; ++ai)
#pragma unroll
            for (int m = 0; m < 4; ++m) {
                const int row = row0 + ai * HALF + m * 16; const float g = gate[row];
#pragma unroll
                for (int bj = 0; bj < 2; ++bj) { const f32x4 v0 = acc[ai][bj][m][0] * g, v1 = acc[ai][bj][m][1] * g;
                    u32x4 w; w.x = cvt_pk_bf16(v0[0], v0[1]); w.y = cvt_pk_bf16(v0[2], v0[3]); w.z = cvt_pk_bf16(v1[0], v1[1]); w.w = cvt_pk_bf16(v1[2], v1[3]);
                    *(u32x4*)(Ys + (size_t)row * D + col0 + bj * HALF) = w; }
            }
    }
};

template <class Epi, class Sched, bool GATHER, bool ALIGN_EPI = true, bool SP2 = true>
__device__ __forceinline__ void gemm_phase(PG8_LAS unsigned char* lds, const Gemm g, const Sched& S, const Epi& E) {
    int tid_ = threadIdx.x; asm volatile("" : "+v"(tid_));
    const int tid = tid_, wid = __builtin_amdgcn_readfirstlane(tid >> 6), lane = tid & 63, wr = wid >> 2, wc = wid & 3, fr = lane & 15, fq = lane >> 4;
    const int K = g.K, nt = K / BK;
    unsigned voffA[2], voffB[2]; int RA[2], CA[2];
#pragma unroll
    for (int i = 0; i < 2; ++i) { int R, C; stage_rc(tid * 16 + i * 8192, R, C); const int Rb = Epi::PERM ? ((R & ~31) + perm32(R & 31)) : R;
        RA[i] = R; CA[i] = C; voffA[i] = (unsigned)(R * K + C) * 2u; voffB[i] = (unsigned)(Rb * K + C) * 2u; }
    const size_t kstep = (size_t)(BK * 2);
    const size_t hstep = (size_t)HALF * K * 2;
    const size_t tstep = 2 * hstep;
    const unsigned ldsw = (unsigned)wid * 1024u;
    const int aoff = lds_byte(wr * 64 + fr, fq * 8), boff = lds_byte(wc * 32 + fr, fq * 8);
#define PG8_SA(b, h) (((b) * 2 + (h)) * HTB)
#define PG8_SB(b, h) ((4 + (b) * 2 + (h)) * HTB)
#define PG8_STAGE(bufoff, gbase, voff) do { _Pragma("unroll") for (int _i = 0; _i < 2; ++_i) \
        __builtin_amdgcn_global_load_lds((const unsigned*)((const char*)(gbase) + (voff)[_i]), (PG8_LAS unsigned*)(lds + (bufoff) + ldsw + _i * 8192), 16, 0, 0); } while (0)
#define PG8_STAGE_A(bufoff, gbase, h, VG) do { if constexpr (GATHER) { PG8_STAGE(bufoff, gbase, VG[h]); } else { PG8_STAGE(bufoff, (gbase) + (h) * hstep, voffA); } } while (0)
#define PG8_LDA(dst, b, h) do { _Pragma("unroll") for (int m = 0; m < 4; ++m) _Pragma("unroll") for (int k = 0; k < 2; ++k) dst[m][k] = *(const PG8_LAS bf16x8*)(lds + PG8_SA(b, h) + aoff + m * 2048 + k * 1024); } while (0)
#define PG8_LDB(dst, b, h) do { _Pragma("unroll") for (int n = 0; n < 2; ++n) _Pragma("unroll") for (int k = 0; k < 2; ++k) dst[n][k] = *(const PG8_LAS bf16x8*)(lds + PG8_SB(b, h) + boff + n * 2048 + k * 1024); } while (0)
#define PG8_MMA(ai, bj, At, Bt) do { __builtin_amdgcn_s_setprio(1); _Pragma("unroll") for (int m = 0; m < 4; ++m) _Pragma("unroll") for (int n = 0; n < 2; ++n) _Pragma("unroll") for (int k = 0; k < 2; ++k) \
        acc[ai][bj][m][n] = __builtin_amdgcn_mfma_f32_16x16x32_bf16(Bt[n][k], At[m][k], acc[ai][bj][m][n], 0, 0, 0); __builtin_amdgcn_s_setprio(0); } while (0)
#define PG8_WAIT_V(n) asm volatile("s_waitcnt vmcnt(" #n ")" ::: "memory")
#define PG8_WAIT_L(n) asm volatile("s_waitcnt lgkmcnt(" #n ")" ::: "memory")
#define PG8_BAR __builtin_amdgcn_s_barrier()
#define PG8_SCHED __builtin_amdgcn_sched_barrier(0)
#define PG8_GOFF(dst, U) do { _Pragma("unroll") for (int _h = 0; _h < 2; ++_h) _Pragma("unroll") for (int _i = 0; _i < 2; ++_i) \
        dst[_h][_i] = ((unsigned)g.idx[(U).pm * BM + _h * HALF + RA[_i]] * (unsigned)K + (unsigned)CA[_i]) * 2u; } while (0)
    Unit cur, nxt; int ui = 0;
    if (!S.next(0, cur)) return;
    f32x4 acc[2][2][4][2];
#pragma unroll
    for (int a = 0; a < 2; ++a)
#pragma unroll
        for (int b = 0; b < 2; ++b)
#pragma unroll
            for (int m = 0; m < 4; ++m)
#pragma unroll
                for (int n = 0; n < 2; ++n) acc[a][b][m][n] = (f32x4){0.f, 0.f, 0.f, 0.f};
    bf16x8 At[4][2], B0[2][2], B1[2][2];
    unsigned vgc[2][2] = {{0u, 0u}, {0u, 0u}}, vgn[2][2] = {{0u, 0u}, {0u, 0u}};
    const char* cA = GATHER ? (const char*)g.A : (const char*)g.A + (size_t)cur.pm * tstep; const char* cB = (const char*)g.Bt + (size_t)cur.pb * tstep;
    if constexpr (GATHER) PG8_GOFF(vgc, cur);
    E.begin(cur, 0);
    if constexpr (SP2) {
        PG8_STAGE(PG8_SB(0, 0), cB, voffB); PG8_STAGE(PG8_SB(0, 1), cB + hstep, voffB); PG8_STAGE_A(PG8_SA(0, 0), cA, 0, vgc); PG8_STAGE_A(PG8_SA(0, 1), cA, 1, vgc);
        if (wr == 1) PG8_BAR;
        PG8_WAIT_V(2); PG8_BAR;
        PG8_STAGE(PG8_SB(1, 0), cB + kstep, voffB); PG8_STAGE_A(PG8_SA(1, 0), cA + kstep, 0, vgc); PG8_STAGE(PG8_SB(1, 1), cB + hstep + kstep, voffB);
        PG8_WAIT_V(6); PG8_BAR;
    } else {
        PG8_STAGE(PG8_SB(0, 0), cB, voffB); PG8_STAGE_A(PG8_SA(0, 0), cA, 0, vgc); PG8_STAGE(PG8_SB(0, 1), cB + hstep, voffB); PG8_STAGE_A(PG8_SA(0, 1), cA, 1, vgc);
        if (wr == 1) PG8_BAR;
        PG8_WAIT_V(4); PG8_BAR;
        PG8_STAGE(PG8_SB(1, 0), cB + kstep, voffB); PG8_STAGE_A(PG8_SA(1, 0), cA + kstep, 0, vgc); PG8_STAGE(PG8_SB(1, 1), cB + hstep + kstep, voffB);
        PG8_WAIT_V(6); PG8_BAR;
    }
    for (;;) {
        const bool has_next = S.next(ui + 1, nxt);
        const char* nA = GATHER ? (const char*)g.A : (has_next ? (const char*)g.A + (size_t)nxt.pm * tstep : cA); const char* nB = has_next ? (const char*)g.Bt + (size_t)nxt.pb * tstep : cB;
        if constexpr (GATHER) { if (has_next) PG8_GOFF(vgn, nxt); else {
#pragma unroll
            for (int h = 0; h < 2; ++h)
#pragma unroll
                for (int i = 0; i < 2; ++i) vgn[h][i] = vgc[h][i]; } }
        for (int t = 0; t < nt; t += 2) {
            const bool last = (t == nt - 2);
            if constexpr (Epi::MID) { if (t == Epi::MID_T) E.mid(acc, cur, ui, wr, wc, fr, fq); }
            const char* a1 = cA + (size_t)(t + 1) * kstep;
            const char* a2 = last ? nA : cA + (size_t)(t + 2) * kstep; const char* b2 = last ? nB : cB + (size_t)(t + 2) * kstep;
            const char* a3 = a2 + kstep; const char* b3 = b2 + kstep;
            unsigned vgs[2][2];
#pragma unroll
            for (int h = 0; h < 2; ++h)
#pragma unroll
                for (int i = 0; i < 2; ++i) vgs[h][i] = last ? vgn[h][i] : vgc[h][i];
            if constexpr (SP2) {
            PG8_LDB(B0, 0, 0); PG8_LDB(B1, 0, 1); PG8_SCHED; PG8_LDA(At, 0, 0); PG8_STAGE_A(PG8_SA(1, 1), a1, 1, vgc);
            PG8_WAIT_V(8); PG8_WAIT_L(0); PG8_BAR; PG8_MMA(0, 0, At, B0); PG8_MMA(0, 1, At, B1); PG8_BAR; PG8_SCHED;
            PG8_LDA(At, 0, 1); PG8_STAGE(PG8_SB(0, 0), b2, voffB); PG8_STAGE(PG8_SB(0, 1), b2 + hstep, voffB); PG8_STAGE_A(PG8_SA(0, 0), a2, 0, vgs);
            PG8_WAIT_V(8); PG8_WAIT_L(0); PG8_BAR; PG8_MMA(1, 0, At, B0); PG8_MMA(1, 1, At, B1); PG8_BAR; PG8_SCHED;
            PG8_LDB(B0, 1, 0); PG8_LDB(B1, 1, 1); PG8_SCHED; PG8_LDA(At, 1, 0); PG8_STAGE_A(PG8_SA(0, 1), a2, 1, vgs);
            PG8_WAIT_V(8); PG8_WAIT_L(0); PG8_BAR; PG8_MMA(0, 0, At, B0); PG8_MMA(0, 1, At, B1); PG8_BAR; PG8_SCHED;
            PG8_LDA(At, 1, 1); PG8_STAGE(PG8_SB(1, 0), b3, voffB); PG8_STAGE(PG8_SB(1, 1), b3 + hstep, voffB); PG8_STAGE_A(PG8_SA(1, 0), a3, 0, vgs);
            PG8_WAIT_V(8); PG8_WAIT_L(0); PG8_BAR; PG8_MMA(1, 0, At, B0); PG8_MMA(1, 1, At, B1); PG8_BAR; PG8_SCHED;
            } else {
            PG8_LDB(B0, 0, 0); PG8_SCHED; PG8_LDA(At, 0, 0); PG8_STAGE_A(PG8_SA(1, 1), a1, 1, vgc);
            PG8_WAIT_L(8); PG8_BAR; PG8_WAIT_L(0); PG8_MMA(0, 0, At, B0); PG8_BAR; PG8_SCHED;
            PG8_LDB(B1, 0, 1); PG8_STAGE(PG8_SB(0, 0), b2, voffB);
            PG8_BAR; PG8_WAIT_L(0); PG8_MMA(0, 1, At, B1); PG8_BAR;
            PG8_LDA(At, 0, 1); PG8_STAGE_A(PG8_SA(0, 0), a2, 0, vgs);
            PG8_BAR; PG8_WAIT_L(0); PG8_MMA(1, 0, At, B0); PG8_BAR; PG8_SCHED;
            PG8_STAGE(PG8_SB(0, 1), b2 + hstep, voffB);
            PG8_WAIT_V(6); PG8_BAR; PG8_MMA(1, 1, At, B1); PG8_BAR;
            PG8_LDB(B0, 1, 0); PG8_SCHED; PG8_LDA(At, 1, 0); PG8_STAGE_A(PG8_SA(0, 1), a2, 1, vgs);
            PG8_WAIT_L(8); PG8_BAR; PG8_WAIT_L(0); PG8_MMA(0, 0, At, B0); PG8_BAR; PG8_SCHED;
            PG8_LDB(B1, 1, 1); PG8_STAGE(PG8_SB(1, 0), b3, voffB);
            PG8_BAR; PG8_WAIT_L(0); PG8_MMA(0, 1, At, B1); PG8_BAR;
            PG8_LDA(At, 1, 1); PG8_STAGE_A(PG8_SA(1, 0), a3, 0, vgs);
            PG8_BAR; PG8_WAIT_L(0); PG8_MMA(1, 0, At, B0); PG8_BAR; PG8_SCHED;
            PG8_STAGE(PG8_SB(1, 1), b3 + hstep, voffB);
            PG8_WAIT_V(6); PG8_BAR; PG8_MMA(1, 1, At, B1); PG8_BAR;
            }
        }
        if constexpr (ALIGN_EPI) { if (wr == 0) PG8_BAR; }
        E(acc, cur, ui, wr, wc, fr, fq);
        if (!has_next) break;
#pragma unroll
        for (int a = 0; a < 2; ++a)
#pragma unroll
            for (int b = 0; b < 2; ++b)
#pragma unroll
                for (int m = 0; m < 4; ++m)
#pragma unroll
                    for (int n = 0; n < 2; ++n) acc[a][b][m][n] = (f32x4){0.f, 0.f, 0.f, 0.f};
        cur = nxt; cA = nA; cB = nB; ++ui;
        E.begin(cur, ui);
#pragma unroll
        for (int h = 0; h < 2; ++h)
#pragma unroll
            for (int i = 0; i < 2; ++i) vgc[h][i] = vgn[h][i];
        if constexpr (ALIGN_EPI) { if (wr == 1) PG8_BAR; }
    }
    PG8_WAIT_V(0);
    if constexpr (!ALIGN_EPI) { if (wr == 0) PG8_BAR; }
    PG8_BAR;
#undef PG8_SA
#undef PG8_SB
#undef PG8_STAGE
#undef PG8_STAGE_A
#undef PG8_LDA
#undef PG8_LDB
#undef PG8_MMA
#undef PG8_WAIT_V
#undef PG8_WAIT_L
#undef PG8_BAR
#undef PG8_SCHED
#undef PG8_GOFF
}
}

constexpr size_t MiB = 1u << 20;
constexpr size_t WS_CTL = 0, CTL_ZERO_BYTES = 1 * MiB;
constexpr size_t WS_SSQ_A = 1 * MiB, WS_SSQ_F = 2 * MiB, WS_SSQ_ATT = 3 * MiB, WS_SSQ_SSM = 3 * MiB + 512 * 1024;
constexpr size_t WS_ROUTE = 4 * MiB;
constexpr size_t RT_IDX = 0, RT_GATE = 160 * 1024, RT_RINVS = 320 * 1024, RT_POS = 480 * 1024, RT_TOPE = 608 * 1024, RT_TOPG = 736 * 1024, RT_RINVT = 864 * 1024, RT_HIST = 928 * 1024, RT_PEND = 944 * 1024;
constexpr size_t WS_SSMPRE = 6 * MiB, SSMPRE_STRIDE = 9 * MiB, SP_KT = 0, SP_WST = 512 * 1024, SP_WOUT = 512 * 1024 + 4 * MiB, SP_AC = 512 * 1024 + 8 * MiB;
constexpr size_t WS_WSMALL = 24 * MiB, WSMALL_STRIDE = 5 * MiB, WS_WIN = 0, WS_WGLU = 5 * MiB / 2, WS_WO = 3 * MiB;
constexpr size_t WS_DGU = 34 * MiB, WS_DD = 48 * MiB;
constexpr size_t WS_MOEW = 56 * MiB, WS_XB = 168 * MiB, WS_YS = 112 * MiB;
constexpr size_t WS_RA = 200 * MiB, WS_QKVU = WS_RA, WS_MIX = 240 * MiB, WS_YG = 272 * MiB, WS_HD = 288 * MiB, WS_HS = WS_RA;
constexpr size_t WS_END = 438 * MiB;
static_assert(WS_YS + (size_t)CAP * D * 2 <= WS_XB + (size_t)T * D * 2 && WS_HS + (size_t)CAP * FF * 2 <= WS_END && WS_HD + (size_t)T * FF * 2 <= WS_END, "ws map");
constexpr int CW_BAR = 4096;

constexpr int RING_OFF = 0, RING_BYTES = 131072;
constexpr int LDSCTL_OFF = RING_BYTES, MISC_OFF = LDSCTL_OFF + 320;
constexpr int TAB_OFF = MISC_OFF + 192;
constexpr int LDS_BYTES = 147456;
static_assert(TAB_OFF % 16 == 0 && TAB_OFF + 4096 <= LDS_BYTES, "LDS map");
constexpr int NWAVES = 8;

#define GAS __attribute__((address_space(1)))
#define LAS __attribute__((address_space(3)))
typedef unsigned short bf16;
typedef unsigned v4u __attribute__((ext_vector_type(4)));
typedef float f32x4 __attribute__((ext_vector_type(4)));
typedef GAS unsigned gu32;
#define RLX_AGENT __ATOMIC_RELAXED, __HIP_MEMORY_SCOPE_AGENT
#define LDS_WAIT() asm volatile("s_waitcnt lgkmcnt(0)" ::: "memory")
#define VM_WAIT() asm volatile("s_waitcnt vmcnt(0)" ::: "memory")
__device__ __forceinline__ unsigned f2bf(float f) { unsigned u = __builtin_bit_cast(unsigned, f); return (u + 0x7fffu + ((u >> 16) & 1u)) >> 16; }
__device__ __forceinline__ unsigned pk2(float lo, float hi) { return f2bf(lo) | (f2bf(hi) << 16); }
__device__ __forceinline__ float bf2f(bf16 v) { return __uint_as_float((unsigned)v << 16); }

#define XB_TMO      128
#define XB_XCNT(j)  (256  + 64 * (j))
#define XB_XSUB(j)  (1280 + 64 * (j))
#define XB_XGEN(j)  (2304 + 64 * (j))
#define XB_TOP      3328
#define XB_TOPGEN   3392
#define XCD_BAR_WORDS 3456
#define XB_SPIN_CAP (1u << 22)
__device__ __forceinline__ unsigned xb_ld(unsigned* p)              { return __hip_atomic_load(p, __ATOMIC_RELAXED, __HIP_MEMORY_SCOPE_AGENT); }
__device__ __forceinline__ unsigned xb_add(unsigned* p, unsigned v) { return __hip_atomic_fetch_add(p, v, __ATOMIC_RELAXED, __HIP_MEMORY_SCOPE_AGENT); }
__device__ __forceinline__ unsigned xb_xcc_id() { return (unsigned)__builtin_amdgcn_s_getreg((3 << 11) | 20) & 0xFu; }
#define XB_SPIN(cond, bar) do { unsigned _sp = 0; while (cond) { __builtin_amdgcn_s_sleep(1); \
    if ((++_sp & 255u) == 0u) { if (xb_ld(&(bar)[XB_TMO])) break; if (_sp > XB_SPIN_CAP) { atomicAdd(&(bar)[XB_TMO], 1u); break; } } } } while (0)
struct XcdBarrier { unsigned* bar; unsigned x; volatile LAS unsigned* st; };
__device__ __forceinline__ XcdBarrier xcd_barrier_post(unsigned* bar, volatile LAS unsigned* st) {
    XcdBarrier b; b.bar = bar; b.x = xb_xcc_id(); b.st = st;
    if (threadIdx.x == 0) (void)xb_add(&bar[XB_XCNT(b.x)], 1u);
    return b;
}
__device__ __forceinline__ void xcd_barrier_complete(unsigned* bar, unsigned x, unsigned& nloc, unsigned& nx) {
    const unsigned G = gridDim.x * gridDim.y * gridDim.z;
    unsigned sum, cnt, mine, sp = 0u;
    for (;;) {
        sum = 0u; cnt = 0u; mine = 0u;
#pragma unroll
        for (unsigned j = 0; j < 16; ++j) { const unsigned c = xb_ld(&bar[XB_XCNT(j)]); sum += c; cnt += (c > 0u) ? 1u : 0u; mine = (j == x) ? c : mine; }
        if (sum == G) break;
        __builtin_amdgcn_s_sleep(1);
        if ((++sp & 255u) == 0u) { if (xb_ld(&bar[XB_TMO])) break; if (sp > XB_SPIN_CAP) { atomicAdd(&bar[XB_TMO], 1u); break; } }
    }
    nloc = mine > 0u ? mine : 1u; nx = cnt > 0u ? cnt : 1u;
}
__device__ __forceinline__ void xcd_barrier(const XcdBarrier& b) {
    asm volatile("s_waitcnt vmcnt(0)" ::: "memory");
    __syncthreads();
    if (threadIdx.x == 0) {
        unsigned* bar = b.bar;
        __builtin_amdgcn_s_waitcnt(0);
        unsigned nloc = b.st[0], nx = b.st[1];
        if (nloc == 0u) { xcd_barrier_complete(bar, b.x, nloc, nx); b.st[0] = nloc; b.st[1] = nx; }
        const unsigned old = xb_add(&bar[XB_XSUB(b.x)], 1u);
        const unsigned gen = old / nloc;
        if (old + 1u == (gen + 1u) * nloc) {
            __builtin_amdgcn_fence(__ATOMIC_RELEASE, "agent");
            asm volatile("s_waitcnt vmcnt(0)" ::: "memory");
            const unsigned og = xb_add(&bar[XB_TOP], 1u);
            const unsigned tg = og / nx;
            if (og + 1u == (tg + 1u) * nx) xb_add(&bar[XB_TOPGEN], 1u);
            else XB_SPIN(xb_ld(&bar[XB_TOPGEN]) == tg, bar);
            __builtin_amdgcn_fence(__ATOMIC_ACQUIRE, "agent");
            xb_add(&bar[XB_XGEN(b.x)], 1u);
            asm volatile("s_waitcnt vmcnt(0)" ::: "memory");
        } else {
            XB_SPIN(xb_ld(&bar[XB_XGEN(b.x)]) == gen, bar);
            __builtin_amdgcn_fence(__ATOMIC_ACQUIRE, "agent");
            asm volatile("s_waitcnt vmcnt(0)" ::: "memory");
        }
    }
    __syncthreads();
}

struct Args { const float* in[26]; float* out; unsigned char* ws; int ph_lo, ph_hi; };
struct Frame {
    LAS unsigned char* lds; volatile LAS unsigned* MISC; gu32* ctl;
    int tid, lane, wave, vcu, G;
    unsigned char* ws; float* out;
};
__device__ __forceinline__ float wave_sum(float v) {
#pragma unroll
    for (int o = 1; o < 64; o <<= 1) v += __shfl_xor(v, o);
    return v;
}
__device__ __forceinline__ float wave_max(float v) {
#pragma unroll
    for (int o = 1; o < 64; o <<= 1) v = fmaxf(v, __shfl_xor(v, o));
    return v;
}

__device__ __forceinline__ void transpose_item(const float* W, int ldn, int n0, int k0, const float* kscale, bf16* WT, int drow0, int K, LAS float* scr, int lane) {
#pragma unroll 8
    for (int i = 0; i < 32; ++i) { const int kk = 2 * i + (lane >> 5); float v = W[(size_t)(k0 + kk) * ldn + n0 + (lane & 31)]; if (kscale) v *= kscale[k0 + kk]; scr[kk * 33 + (lane & 31)] = v; }
    LDS_WAIT(); asm volatile("" ::: "memory");
    const int c = lane & 7;
#pragma unroll
    for (int j = 0; j < 4; ++j) { const int n = (lane >> 3) + 8 * j; const LAS float* s = scr + (8 * c) * 33 + n;
        v4u o; o.x = pk2(s[0 * 33], s[1 * 33]); o.y = pk2(s[2 * 33], s[3 * 33]); o.z = pk2(s[4 * 33], s[5 * 33]); o.w = pk2(s[6 * 33], s[7 * 33]);
        *(GAS v4u*)(WT + (size_t)(drow0 + n) * K + k0 + 8 * c) = o; }
    LDS_WAIT(); asm volatile("" ::: "memory");
}
__device__ __forceinline__ void conv_plain(const float* W, int K, int N, const float* ks_lo, const float* ks_hi, bf16* WT, int item, LAS float* scr, int lane) {
    const int nblk = N / 32, kb = item / nblk, nb = item % nblk, k0 = 64 * kb;
    const float* ks = ks_lo ? (k0 < 512 || !ks_hi ? ks_lo : ks_hi - 512) : nullptr;
    transpose_item(W, N, 32 * nb, k0, ks, WT, 32 * nb, K, scr, lane);
}
__device__ __forceinline__ void conv_inproj(const float* W, const float* ks, bf16* WT, int item, LAS float* scr, int lane) {
    const int nblk = INW / 32, kb = item / nblk, drb = item % nblk, pn = drb >> 3, r = drb & 7, bj = r >> 2, wc = r & 3;
    transpose_item(W, INW, 256 * pn + 64 * wc + 32 * bj, 64 * kb, ks, WT, 32 * drb, D, scr, lane);
}
__device__ __forceinline__ void conv_gu(const float* Wg, const float* Wu, const float* ks, bf16* WT, int item, LAS float* scr, int lane) {
    const int nblk = 2 * FF / 32, kb = item / nblk, drb = item % nblk, pn = drb >> 3, r = drb & 7, bj = r >> 2, q = r & 3;
    transpose_item(bj ? Wu : Wg, FF, 128 * pn + 32 * q, 64 * kb, ks, WT, 32 * drb, D, scr, lane);
}

constexpr int IT_IN = (D / 64) * (INW / 32), IT_GLU = (SW / 64) * (SW / 32), IT_WO = (D / 64) * (D / 32), IT_L = IT_IN + IT_GLU + IT_WO;
constexpr int IT_GU = (D / 64) * (2 * FF / 32), IT_DN = (FF / 64) * (D / 32);
constexpr int IT_P0 = 2 * IT_L + IT_GU + IT_DN + NE * IT_GU;

__device__ __forceinline__ void p0_convert(Frame& F, const Args& a) {
    LAS float* scr = (LAS float*)(F.lds + RING_OFF + F.wave * 16384);
    const int gw = F.vcu * NWAVES + F.wave, NGW = F.G * NWAVES;
    for (int it = gw; it < IT_P0; it += NGW) {
        int r = it;
        if (r < 2 * IT_L) { const int l = r / IT_L; r -= l * IT_L; unsigned char* wb = F.ws + WS_WSMALL + l * WSMALL_STRIDE;
            if (r < IT_IN) { conv_inproj(a.in[2] + (size_t)l * D * INW, a.in[1] + l * D, (bf16*)(wb + WS_WIN), r, scr, F.lane); continue; } r -= IT_IN;
            if (r < IT_GLU) { conv_plain(a.in[14] + (size_t)l * SW * SW, SW, SW, nullptr, nullptr, (bf16*)(wb + WS_WGLU), r, scr, F.lane); continue; } r -= IT_GLU;
            conv_plain(a.in[17] + (size_t)l * D * D, D, D, a.in[15] + l * AW, a.in[16] + l * SW, (bf16*)(wb + WS_WO), r, scr, F.lane); continue; }
        r -= 2 * IT_L;
        if (r < IT_GU) { conv_gu(a.in[19], a.in[20], a.in[18], (bf16*)(F.ws + WS_DGU), r, scr, F.lane); continue; } r -= IT_GU;
        if (r < IT_DN) { conv_plain(a.in[21], FF, D, nullptr, nullptr, (bf16*)(F.ws + WS_DD), r, scr, F.lane); continue; } r -= IT_DN;
        { const int e = r / IT_GU; r -= e * IT_GU;
          conv_gu(a.in[23] + (size_t)e * D * FF, a.in[24] + (size_t)e * D * FF, a.in[18] + D, (bf16*)(F.ws + WS_MOEW) + (size_t)e * 2 * FF * D, r, scr, F.lane); }
    }
}
__device__ __forceinline__ void moe_wd_convert(Frame& F, const Args& a) {
    LAS float* scr = (LAS float*)(F.lds + RING_OFF + F.wave * 16384);
    const int gw = F.vcu * NWAVES + F.wave, NGW = F.G * NWAVES;
    for (int it = gw; it < NE * IT_DN; it += NGW) { const int e = it / IT_DN, r = it % IT_DN;
        conv_plain(a.in[25] + (size_t)e * FF * D, FF, D, nullptr, nullptr, (bf16*)(F.ws + WS_MOEW) + (size_t)e * D * FF, r, scr, F.lane); }
}
__device__ __forceinline__ void p0_xb(Frame& F, const float* x) {
    const int gw = F.vcu * NWAVES + F.wave, NGW = F.G * NWAVES;
    bf16* XB = (bf16*)(F.ws + WS_XB); float* ssq = (float*)(F.ws + WS_SSQ_A);
    for (int m = gw; m < T; m += NGW) {
        const GAS f32x4* xr = (const GAS f32x4*)(x + (size_t)m * D) + F.lane; float s = 0.f;
        GAS unsigned long long* o8 = (GAS unsigned long long*)(XB + (size_t)m * D) + F.lane;
#pragma unroll
        for (int j = 0; j < 4; ++j) { const f32x4 v = xr[64 * j]; s += (v.x * v.x + v.y * v.y) + (v.z * v.z + v.w * v.w);
            o8[64 * j] = (unsigned long long)pk2(v.x, v.y) | ((unsigned long long)pk2(v.z, v.w) << 32); }
        s = wave_sum(s);
        if (F.lane < 16) ssq[(size_t)m * 16 + F.lane] = F.lane == 0 ? s : 0.f;
    }
}
__device__ __forceinline__ void ssm_precompute(Frame& F, const Args& a, int l, int g) {
    LAS float* apr = (LAS float*)(F.lds + RING_OFF); LAS float* api = apr + 17 * 64; LAS float* bbr = api + 17 * 64; LAS float* bbi = bbr + 1024; LAS float* cr = bbi + 1024; LAS float* ci = cr + 1024;
    unsigned char* sp = F.ws + WS_SSMPRE + l * SSMPRE_STRIDE;
    float* KT = (float*)(sp + SP_KT) + (size_t)g * 4096; float* WST = (float*)(sp + SP_WST) + (size_t)g * 32768; float* WOUT = (float*)(sp + SP_WOUT) + (size_t)g * 32768; float* AC = (float*)(sp + SP_AC) + g * 128;
    const int lg = l * NG + g, tid = F.tid;
    __syncthreads();
    if (tid < 64) { const int n = tid;
        const double lr = a.in[6][lg * 64 + n], li = a.in[7][lg * 64 + n], dt = exp((double)a.in[8][lg]);
        double a1r = 0, a1i = 0;
        for (int tau = 0; tau <= 16; ++tau) { const double mag = exp(lr * dt * tau), ang = li * dt * tau; const double pr = mag * cos(ang), pi = mag * sin(ang);
            apr[tau * 64 + n] = (float)pr; api[tau * 64 + n] = (float)pi; if (tau == 1) { a1r = pr; a1i = pi; } }
        const double nr = a1r - 1.0, den = lr * lr + li * li, fre = (nr * lr + a1i * li) / den, fim = (a1i * lr - nr * li) / den;
        for (int c = 0; c < 16; ++c) { const double br = a.in[9][(size_t)(lg * 64 + n) * 16 + c], bi = a.in[10][(size_t)(lg * 64 + n) * 16 + c];
            bbr[n * 16 + c] = (float)(fre * br - fim * bi); bbi[n * 16 + c] = (float)(fre * bi + fim * br); }
        AC[n] = apr[16 * 64 + n]; AC[64 + n] = api[16 * 64 + n];
    }
    for (int o = tid; o < 1024; o += 512) { cr[o] = a.in[11][(size_t)lg * 1024 + o]; ci[o] = a.in[12][(size_t)lg * 1024 + o]; }
    __syncthreads();
    for (int o = tid; o < 4096; o += 512) { const int tau = o >> 8, co = (o >> 4) & 15, c = o & 15; float s = 0.f;
        for (int n = 0; n < 64; ++n) { const float pr = apr[tau * 64 + n], pi = api[tau * 64 + n], c_r = cr[co * 64 + n], c_i = ci[co * 64 + n];
            const float xr = c_r * pr - c_i * pi, xi = c_r * pi + c_i * pr; s += xr * bbr[n * 16 + c] - xi * bbi[n * 16 + c]; }
        if (tau == 0 && co == c) s += a.in[13][l * SW + g * 16 + co];
        KT[o] = s; }
    for (int o = tid; o < 32768; o += 512) { const int n2 = o & 127, sci = o >> 7, s = sci >> 4, c = sci & 15, n = n2 & 63;
        const float pr = apr[(15 - s) * 64 + n], pi = api[(15 - s) * 64 + n], br = bbr[n * 16 + c], bi = bbi[n * 16 + c];
        WST[o] = (n2 < 64) ? (pr * br - pi * bi) : (pr * bi + pi * br); }
    for (int o = tid; o < 32768; o += 512) { const int n2 = o >> 8, tl = (o >> 4) & 15, co = o & 15, n = n2 & 63;
        const float pr = apr[(tl + 1) * 64 + n], pi = api[(tl + 1) * 64 + n], c_r = cr[co * 64 + n], c_i = ci[co * 64 + n];
        WOUT[o] = (n2 < 64) ? (c_r * pr - c_i * pi) : -(c_r * pi + c_i * pr); }
    __syncthreads();
}

__device__ __forceinline__ void attn_phase_v0(Frame& F, const Args& a, int l) {
    const bf16* QKVU = (const bf16*)(F.ws + WS_QKVU); bf16* MIX = (bf16*)(F.ws + WS_MIX); float* ssq = (float*)(F.ws + WS_SSQ_ATT);
    const int gw = F.vcu * NWAVES + F.wave, NGW = F.G * NWAVES;
    for (int item = gw; item < BATCH * NH * (SEQ / 64); item += NGW) {
        const int tb = item % (SEQ / 64), h = (item / (SEQ / 64)) % NH, b = item / (NH * (SEQ / 64)), kvh = h >> 2;
        const int t = tb * 64 + F.lane; const size_t row = (size_t)b * SEQ + t;
        float q[64], o[64];
        { const v4u* qp = (const v4u*)(QKVU + row * INW + QOFF + h * 64);
#pragma unroll
          for (int i = 0; i < 8; ++i) { const v4u w = qp[i]; q[8 * i] = pg8::bf_lo(w.x); q[8 * i + 1] = pg8::bf_hi(w.x); q[8 * i + 2] = pg8::bf_lo(w.y); q[8 * i + 3] = pg8::bf_hi(w.y);
              q[8 * i + 4] = pg8::bf_lo(w.z); q[8 * i + 5] = pg8::bf_hi(w.z); q[8 * i + 6] = pg8::bf_lo(w.w); q[8 * i + 7] = pg8::bf_hi(w.w); } }
#pragma unroll
        for (int d = 0; d < 64; ++d) o[d] = 0.f;
        float m = a.in[5][l * NH + h] * LOG2E, lsum = 1.0f;
        for (int j = 0; j < WIN; ++j) {
            const int kp = t - (WIN - 1) + j;
            if (kp >= 0) {
                const bf16* kr = QKVU + ((size_t)b * SEQ + kp) * INW;
                const v4u* kq = (const v4u*)(kr + KOFF + kvh * 64); float s = 0.f;
#pragma unroll
                for (int i = 0; i < 8; ++i) { const v4u w = kq[i];
                    s += q[8 * i] * pg8::bf_lo(w.x) + q[8 * i + 1] * pg8::bf_hi(w.x) + q[8 * i + 2] * pg8::bf_lo(w.y) + q[8 * i + 3] * pg8::bf_hi(w.y)
                       + q[8 * i + 4] * pg8::bf_lo(w.z) + q[8 * i + 5] * pg8::bf_hi(w.z) + q[8 * i + 6] * pg8::bf_lo(w.w) + q[8 * i + 7] * pg8::bf_hi(w.w); }
                const float mn = fmaxf(m, s), al = exp2f(m - mn), p = exp2f(s - mn);
                lsum = lsum * al + p; m = mn;
                const v4u* vq = (const v4u*)(kr + VOFF + kvh * 64);
#pragma unroll
                for (int i = 0; i < 8; ++i) { const v4u w = vq[i];
                    o[8 * i] = o[8 * i] * al + p * pg8::bf_lo(w.x); o[8 * i + 1] = o[8 * i + 1] * al + p * pg8::bf_hi(w.x); o[8 * i + 2] = o[8 * i + 2] * al + p * pg8::bf_lo(w.y); o[8 * i + 3] = o[8 * i + 3] * al + p * pg8::bf_hi(w.y);
                    o[8 * i + 4] = o[8 * i + 4] * al + p * pg8::bf_lo(w.z); o[8 * i + 5] = o[8 * i + 5] * al + p * pg8::bf_hi(w.z); o[8 * i + 6] = o[8 * i + 6] * al + p * pg8::bf_lo(w.w); o[8 * i + 7] = o[8 * i + 7] * al + p * pg8::bf_hi(w.w); }
            }
        }
        const float inv = 1.0f / lsum; float ss = 0.f;
        v4u* op = (v4u*)(MIX + row * D + h * 64);
#pragma unroll
        for (int i = 0; i < 8; ++i) { float v[8];
#pragma unroll
            for (int k = 0; k < 8; ++k) { v[k] = o[8 * i + k] * inv; ss += v[k] * v[k]; }
            v4u w; w.x = pk2(v[0], v[1]); w.y = pk2(v[2], v[3]); w.z = pk2(v[4], v[5]); w.w = pk2(v[6], v[7]); op[i] = w; }
        ssq[row * 8 + h] = ss;
    }
}

__device__ __forceinline__ float gelu_tanh(float y) { const float z = 0.7978845608028654f * (y + 0.044715f * y * y * y); return y - y / (1.0f + __expf(2.0f * z)); }
__device__ __forceinline__ void ssm_phase_v0(Frame& F, int l) {
    const bf16* QKVU = (const bf16*)(F.ws + WS_QKVU); bf16* YG = (bf16*)(F.ws + WS_YG);
    unsigned char* sp = F.ws + WS_SSMPRE + l * SSMPRE_STRIDE;
    LAS float* Ut = (LAS float*)(F.lds + RING_OFF); LAS float* Sl = Ut + 16384; LAS float* KTl = Sl + 8192;
    const int tid = F.tid;
    for (int job = blockIdx.x; job < BATCH * NG; job += F.G) {
        const int b = job / NG, g = job % NG;
        const float* KT = (const float*)(sp + SP_KT) + (size_t)g * 4096; const float* WST = (const float*)(sp + SP_WST) + (size_t)g * 32768; const float* WOUT = (const float*)(sp + SP_WOUT) + (size_t)g * 32768; const float* AC = (const float*)(sp + SP_AC) + g * 128;
        __syncthreads();
        for (int o = tid; o < 4096; o += 512) KTl[o] = KT[o];
        float hr = 0.f, hi = 0.f, acr = 0.f, aci = 0.f; if (tid < 64) { acr = AC[tid]; aci = AC[64 + tid]; }
        for (int sb = 0; sb < SEQ / 1024; ++sb) {
            const size_t row0 = (size_t)b * SEQ + sb * 1024;
            __syncthreads();
#pragma unroll
            for (int rr = 0; rr < 2; ++rr) { const int r = tid + 512 * rr; const v4u* up = (const v4u*)(QKVU + (row0 + r) * INW + UOFF + g * 16);
#pragma unroll
                for (int i = 0; i < 2; ++i) { const v4u w = up[i]; LAS float* d = Ut + r * 16 + 8 * i;
                    d[0] = pg8::bf_lo(w.x); d[1] = pg8::bf_hi(w.x); d[2] = pg8::bf_lo(w.y); d[3] = pg8::bf_hi(w.y); d[4] = pg8::bf_lo(w.z); d[5] = pg8::bf_hi(w.z); d[6] = pg8::bf_lo(w.w); d[7] = pg8::bf_hi(w.w); } }
            __syncthreads();
            {
                const int n2 = tid & 127, cg = tid >> 7; float acc[16];
#pragma unroll
                for (int i = 0; i < 16; ++i) acc[i] = 0.f;
                for (int sci = 0; sci < 256; ++sci) { const float w = WST[sci * 128 + n2]; const int s = sci >> 4, c = sci & 15;
#pragma unroll
                    for (int i = 0; i < 16; ++i) acc[i] += w * Ut[((cg + 4 * i) * 16 + s) * 16 + c]; }
#pragma unroll
                for (int i = 0; i < 16; ++i) Sl[(cg + 4 * i) * 128 + n2] = acc[i];
            }
            __syncthreads();
            if (tid < 64) { for (int c = 0; c < 64; ++c) { const float sr = Sl[c * 128 + tid], si = Sl[c * 128 + 64 + tid]; Sl[c * 128 + tid] = hr; Sl[c * 128 + 64 + tid] = hi;
                    const float nr = acr * hr - aci * hi + sr, ni = acr * hi + aci * hr + si; hr = nr; hi = ni; } }
            __syncthreads();
            {
                const int co = tid & 15, tb = tid >> 4, tl = tb & 15, c0 = tb >> 4; float y[32];
#pragma unroll
                for (int i = 0; i < 32; ++i) y[i] = 0.f;
                for (int n2 = 0; n2 < 128; ++n2) { const float w = WOUT[n2 * 256 + tl * 16 + co];
#pragma unroll
                    for (int i = 0; i < 32; ++i) y[i] += w * Sl[(c0 + 2 * i) * 128 + n2]; }
                for (int s = 0; s <= tl; ++s)
                    for (int c = 0; c < 16; ++c) { const float kv = KTl[(tl - s) * 256 + co * 16 + c];
#pragma unroll
                        for (int i = 0; i < 32; ++i) y[i] += kv * Ut[((c0 + 2 * i) * 16 + s) * 16 + c]; }
#pragma unroll
                for (int i = 0; i < 32; ++i) { const int t = tb + 32 * i; YG[(row0 + t) * SW + g * 16 + co] = (bf16)f2bf(gelu_tanh(y[i])); }
            }
        }
    }
    __syncthreads();
}

__device__ __forceinline__ void route1(Frame& F, const Args& a) {
    LAS float* wrs = (LAS float*)(F.lds + RING_OFF); LAS int* hl = (LAS int*)(wrs + 8192);
    unsigned char* rt = F.ws + WS_ROUTE; int* TOPE = (int*)(rt + RT_TOPE); float* TOPG = (float*)(rt + RT_TOPG); float* RINVT = (float*)(rt + RT_RINVT); int* HIST = (int*)(rt + RT_HIST);
    const float* wr = a.in[22]; const float* gn = a.in[18] + D;
    __syncthreads();
    for (int o = F.tid; o < 8192; o += 512) wrs[o] = wr[o] * gn[o >> 3];
    for (int blk = blockIdx.x; blk < T / 64; blk += F.G) {
        __syncthreads();
        if (F.tid < 8) hl[F.tid] = 0;
        __syncthreads();
        for (int i = 0; i < 8; ++i) {
            const int t = blk * 64 + F.wave * 8 + i;
            const GAS f32x4* xr = (const GAS f32x4*)(F.out + (size_t)t * D) + F.lane;
            float lg[8], ss = 0.f;
#pragma unroll
            for (int e = 0; e < 8; ++e) lg[e] = 0.f;
#pragma unroll
            for (int j = 0; j < 4; ++j) { const f32x4 v = xr[64 * j]; const float xv[4] = {v.x, v.y, v.z, v.w};
#pragma unroll
                for (int q = 0; q < 4; ++q) { const int k = 4 * (F.lane + 64 * j) + q; ss += xv[q] * xv[q];
                    const f32x4 w0 = *(const LAS f32x4*)(wrs + k * 8), w1 = *(const LAS f32x4*)(wrs + k * 8 + 4);
                    lg[0] += xv[q] * w0.x; lg[1] += xv[q] * w0.y; lg[2] += xv[q] * w0.z; lg[3] += xv[q] * w0.w; lg[4] += xv[q] * w1.x; lg[5] += xv[q] * w1.y; lg[6] += xv[q] * w1.z; lg[7] += xv[q] * w1.w; } }
            ss = wave_sum(ss);
#pragma unroll
            for (int e = 0; e < 8; ++e) lg[e] = wave_sum(lg[e]);
            const float rinv = 1.0f / sqrtf(ss * (1.0f / D) + EPS);
            int e1 = 0; float l1 = lg[0];
#pragma unroll
            for (int e = 1; e < 8; ++e) if (lg[e] > l1) { l1 = lg[e]; e1 = e; }
            int e2 = -1; float l2 = -3.0e38f;
#pragma unroll
            for (int e = 0; e < 8; ++e) if (e != e1 && lg[e] > l2) { l2 = lg[e]; e2 = e; }
            const float g2 = 1.0f / (1.0f + __expf((l1 - l2) * rinv)), g1 = 1.0f - g2;
            if (F.lane == 0) { TOPE[t * 2] = e1; TOPE[t * 2 + 1] = e2; TOPG[t * 2] = g1; TOPG[t * 2 + 1] = g2; RINVT[t] = rinv; atomicAdd((int*)&hl[e1], 1); atomicAdd((int*)&hl[e2], 1); }
        }
        __syncthreads();
        if (F.tid < 8) HIST[blk * 8 + F.tid] = hl[F.tid];
    }
    __syncthreads();
}
__device__ __forceinline__ void route2(Frame& F) {
    LAS int* sb = (LAS int*)(F.lds + RING_OFF);
    unsigned char* rt = F.ws + WS_ROUTE; const int* TOPE = (const int*)(rt + RT_TOPE); const float* TOPG = (const float*)(rt + RT_TOPG); const float* RINVT = (const float*)(rt + RT_RINVT); const int* HIST = (const int*)(rt + RT_HIST);
    int* IDX = (int*)(rt + RT_IDX); float* GATE = (float*)(rt + RT_GATE); float* RINVS = (float*)(rt + RT_RINVS); int* POS = (int*)(rt + RT_POS); int* PEND = (int*)(rt + RT_PEND);
    for (int blk = blockIdx.x; blk < T / 64; blk += F.G) {
        __syncthreads();
        if (F.tid < 8) { int cnt = 0, base = 0; for (int b2 = 0; b2 < T / 64; ++b2) { const int h = HIST[b2 * 8 + F.tid]; cnt += h; if (b2 < blk) base += h; } sb[F.tid] = cnt; sb[8 + F.tid] = base; }
        __syncthreads();
        if (F.tid == 0) { int ps = 0; for (int e = 0; e < 8; ++e) { const int pd = (sb[e] + 255) & ~255; sb[16 + e] = ps; sb[24 + e] = pd; ps += pd; if (blk == 0) PEND[e] = ps >> 8; } }
        __syncthreads();
        if (F.wave == 0) {
            const int t = blk * 64 + F.lane; int run[8];
#pragma unroll
            for (int e = 0; e < 8; ++e) run[e] = sb[16 + e] + sb[8 + e];
#pragma unroll
            for (int k = 0; k < 2; ++k) { const int e = TOPE[t * 2 + k]; int slot = 0;
#pragma unroll
                for (int ee = 0; ee < 8; ++ee) { const unsigned long long mk = __ballot(e == ee); const int below = __popcll(mk & ((1ull << F.lane) - 1ull));
                    if (e == ee) slot = run[ee] + below; run[ee] += __popcll(mk); }
                IDX[slot] = t; GATE[slot] = TOPG[t * 2 + k]; RINVS[slot] = RINVT[t]; POS[t * 2 + k] = slot; }
        }
        if (blk == 0) {
            for (int e = 0; e < 8; ++e) { const int s0 = sb[16 + e] + sb[e], s1 = sb[16 + e] + sb[24 + e]; for (int s = s0 + F.tid; s < s1; s += 512) { IDX[s] = 0; GATE[s] = 0.f; RINVS[s] = 0.f; } }
        }
    }
    __syncthreads();
}
__device__ __forceinline__ void moe_combine(Frame& F) {
    const bf16* YS = (const bf16*)(F.ws + WS_YS); const int* POS = (const int*)(F.ws + WS_ROUTE + RT_POS);
    const int gw = F.vcu * NWAVES + F.wave, NGW = F.G * NWAVES;
    for (int t = gw; t < T; t += NGW) {
        const int p0 = POS[t * 2], p1 = POS[t * 2 + 1];
        GAS f32x4* xr = (GAS f32x4*)(F.out + (size_t)t * D) + F.lane;
        const GAS unsigned long long* y0 = (const GAS unsigned long long*)(YS + (size_t)p0 * D) + F.lane; const GAS unsigned long long* y1 = (const GAS unsigned long long*)(YS + (size_t)p1 * D) + F.lane;
#pragma unroll
        for (int j = 0; j < 4; ++j) { f32x4 v = xr[64 * j]; const unsigned long long a0 = y0[64 * j], a1 = y1[64 * j];
            const unsigned a0l = (unsigned)a0, a0h = (unsigned)(a0 >> 32), a1l = (unsigned)a1, a1h = (unsigned)(a1 >> 32);
            v.x += pg8::bf_lo(a0l) + pg8::bf_lo(a1l); v.y += pg8::bf_hi(a0l) + pg8::bf_hi(a1l); v.z += pg8::bf_lo(a0h) + pg8::bf_lo(a1h); v.w += pg8::bf_hi(a0h) + pg8::bf_hi(a1h);
            xr[64 * j] = v; }
    }
}

constexpr int NPHASE = 19;
__global__ void __launch_bounds__(NWAVES * 64, 2) hymba_fwd(Args args) {
    extern __shared__ __attribute__((aligned(16))) unsigned char lds[];
    Frame F;
    F.lds = (LAS unsigned char*)lds; F.MISC = (volatile LAS unsigned*)(F.lds + MISC_OFF);
    F.tid = threadIdx.x; F.lane = F.tid & 63; F.wave = __builtin_amdgcn_readfirstlane(F.tid >> 6);
    F.G = gridDim.x; { const int bx = blockIdx.x; F.vcu = (F.G % 8 == 0) ? (bx % 8) * (F.G / 8) + bx / 8 : bx; }
    F.ws = args.ws; F.out = args.out; F.ctl = (gu32*)(args.ws + WS_CTL);
    for (int u = F.tid; u < (LDS_BYTES - LDSCTL_OFF) / 4; u += NWAVES * 64) ((LAS unsigned*)(F.lds + LDSCTL_OFF))[u] = 0u;
    __syncthreads();
    const int lo = args.ph_lo, hi = args.ph_hi;
    XcdBarrier bar; bar.bar = (unsigned*)(F.ctl + CW_BAR); bar.x = 0; bar.st = nullptr;
    if (hi - lo > 1) bar = xcd_barrier_post((unsigned*)(F.ctl + CW_BAR), F.MISC + 8);
#ifndef PH_MASK
#define PH_MASK 0x7FFFF
#endif
#define IN(k) (((PH_MASK >> (k)) & 1) && lo <= (k) && (k) < hi)
#define SEAM(k) do { if ((k) + 1 < hi) xcd_barrier(bar); } while (0)
    unsigned char* ws = args.ws;
#define PH() do { unsigned char* w_ = args.ws; float* o_ = args.out; int t_ = threadIdx.x; asm volatile("" : "+s"(w_), "+s"(o_), "+v"(t_)); F.ws = w_; F.out = o_; F.tid = t_; F.lane = t_ & 63; ws = w_; } while (0)
#define XB_ ((bf16*)(ws + WS_XB))
#define QKVU_ ((bf16*)(ws + WS_QKVU))
#define MIX_ ((bf16*)(ws + WS_MIX))
#define YG_ ((bf16*)(ws + WS_YG))
#define SSQ_A_ ((float*)(ws + WS_SSQ_A))
#define SSQ_F_ ((float*)(ws + WS_SSQ_F))
#define SSQ_ATT_ ((float*)(ws + WS_SSQ_ATT))
#define SSQ_SSM_ ((float*)(ws + WS_SSQ_SSM))

    if (IN(0)) {
        PH();
        p0_convert(F, args); p0_xb(F, args.in[0]);
        for (int job = blockIdx.x; job < 2 * NG; job += F.G) ssm_precompute(F, args, job / NG, job % NG);
        SEAM(0);
    }
    for (int l = 0; l < 2; ++l) {
        const int pb = l == 0 ? 1 : 8;
        if (IN(pb)) {
            PH(); unsigned char* wb = ws + WS_WSMALL + l * WSMALL_STRIDE;
            pg8::Gemm g{XB_, (const bf16*)(wb + WS_WIN), D, nullptr}; pg8::StaticOrder S; S.init(T, INW, F.G, (int)blockIdx.x);
            pg8::EpiInProj E{QKVU_, SSQ_A_, args.in[3] + l * HD, args.in[4] + l * HD, 0.125f * LOG2E};
            pg8::gemm_phase<pg8::EpiInProj, pg8::StaticOrder, false>(F.lds + RING_OFF, g, S, E);
            SEAM(pb);
        }
        if (IN(pb + 1)) { PH(); attn_phase_v0(F, args, l); SEAM(pb + 1); }
        if (IN(pb + 2)) { PH(); ssm_phase_v0(F, l); SEAM(pb + 2); }
        if (IN(pb + 3)) {
            PH(); unsigned char* wb = ws + WS_WSMALL + l * WSMALL_STRIDE;
            pg8::Gemm g{YG_, (const bf16*)(wb + WS_WGLU), SW, nullptr}; pg8::StaticOrder S; S.init(T, SW, F.G, (int)blockIdx.x);
            pg8::EpiGlu E{YG_, MIX_, SSQ_SSM_};
            pg8::gemm_phase<pg8::EpiGlu, pg8::StaticOrder, false>(F.lds + RING_OFF, g, S, E);
            SEAM(pb + 3);
        }
        if (IN(pb + 4)) {
            PH(); unsigned char* wb = ws + WS_WSMALL + l * WSMALL_STRIDE;
            pg8::Gemm g{MIX_, (const bf16*)(wb + WS_WO), D, nullptr}; pg8::StaticOrder S; S.init(T, D, F.G, (int)blockIdx.x);
            pg8::EpiRes<true> E{l == 0 ? args.in[0] : F.out, F.out, XB_, SSQ_F_, SSQ_ATT_, SSQ_SSM_, (LAS float*)(F.lds + TAB_OFF)};
            pg8::gemm_phase<pg8::EpiRes<true>, pg8::StaticOrder, false>(F.lds + RING_OFF, g, S, E);
            SEAM(pb + 4);
        }
    if (l == 0) {
        if (IN(6)) {
            PH();
            pg8::Gemm g{XB_, (const bf16*)(ws + WS_DGU), D, nullptr}; pg8::StaticOrder S; S.init(T, 2 * FF, F.G, (int)blockIdx.x);
            pg8::EpiSwiglu<false> E{(bf16*)(ws + WS_HD), SSQ_F_};
            pg8::gemm_phase<pg8::EpiSwiglu<false>, pg8::StaticOrder, false>(F.lds + RING_OFF, g, S, E);
            SEAM(6);
        }
        if (IN(7)) {
            PH();
            pg8::Gemm g{(const bf16*)(ws + WS_HD), (const bf16*)(ws + WS_DD), FF, nullptr}; pg8::StaticOrder S; S.init(T, D, F.G, (int)blockIdx.x);
            pg8::EpiRes<false> E{F.out, F.out, XB_, SSQ_A_, nullptr, nullptr, (LAS float*)(F.lds + TAB_OFF)};
            pg8::gemm_phase<pg8::EpiRes<false>, pg8::StaticOrder, false>(F.lds + RING_OFF, g, S, E);
            SEAM(7);
        }
    } else {
        if (IN(13)) { PH(); route1(F, args); SEAM(13); }
        if (IN(14)) { PH(); route2(F); SEAM(14); }
        if (IN(15)) {
            PH(); unsigned char* rt = ws + WS_ROUTE;
            pg8::Gemm g{XB_, (const bf16*)(ws + WS_MOEW), D, (const int*)(rt + RT_IDX)}; pg8::MoeOrder S; S.init((const int*)(rt + RT_PEND), 2 * FF, F.G, (int)blockIdx.x);
            pg8::EpiSwiglu<true> E{(bf16*)(ws + WS_HS), (const float*)(rt + RT_RINVS)};
            pg8::gemm_phase<pg8::EpiSwiglu<true>, pg8::MoeOrder, true>(F.lds + RING_OFF, g, S, E);
            SEAM(15);
        }
        if (IN(16)) { PH(); moe_wd_convert(F, args); SEAM(16); }
        if (IN(17)) {
            PH(); unsigned char* rt = ws + WS_ROUTE;
            pg8::Gemm g{(const bf16*)(ws + WS_HS), (const bf16*)(ws + WS_MOEW), FF, nullptr}; pg8::MoeOrder S; S.init((const int*)(rt + RT_PEND), D, F.G, (int)blockIdx.x);
            pg8::EpiMoeDown E{(bf16*)(ws + WS_YS), (const float*)(rt + RT_GATE)};
            pg8::gemm_phase<pg8::EpiMoeDown, pg8::MoeOrder, false>(F.lds + RING_OFF, g, S, E);
            SEAM(17);
        }
        if (IN(18)) { PH(); moe_combine(F); }
    }
    }
#undef IN
#undef SEAM
}

extern "C" void kernel_launch(void* const* d_in, const int* in_sizes, int n_in, void* d_out, int out_size, void* d_ws, size_t ws_size, hipStream_t stream) {
    static int grid = 0;
    if (grid == 0) {
        if (n_in != 26 || in_sizes[0] != T * D || out_size != T * D || ws_size < WS_END) { fprintf(stderr, "kernel_launch: unexpected shapes/workspace (n_in %d, in0 %d, out %d, ws %zu, need %zu); nothing launched\n", n_in, n_in > 0 ? in_sizes[0] : -1, out_size, ws_size, (size_t)WS_END); grid = -1; return; }
        int dev = 0, cus = 0, per_cu = 0;
        if (hipGetDevice(&dev) != hipSuccess || hipDeviceGetAttribute(&cus, hipDeviceAttributeMultiprocessorCount, dev) != hipSuccess) { grid = -1; return; }
        if (hipFuncSetAttribute((const void*)hymba_fwd, hipFuncAttributeMaxDynamicSharedMemorySize, LDS_BYTES) != hipSuccess) { fprintf(stderr, "kernel_launch: hipFuncSetAttribute failed\n"); grid = -1; return; }
        if (hipOccupancyMaxActiveBlocksPerMultiprocessor(&per_cu, (const void*)hymba_fwd, NWAVES * 64, LDS_BYTES) != hipSuccess || per_cu < 1) { fprintf(stderr, "kernel_launch: occupancy query reports %d workgroups per CU\n", per_cu); (void)hipGetLastError(); grid = -1; return; }
        grid = cus;
    }
    if (grid < 0) return;
    (void)hipMemsetAsync((char*)d_ws + WS_CTL, 0, CTL_ZERO_BYTES, stream);
    Args a{};
    for (int i = 0; i < 26; ++i) a.in[i] = (const float*)d_in[i];
    a.out = (float*)d_out; a.ws = (unsigned char*)d_ws;
#if MK_N_LAUNCHES == 1
    a.ph_lo = 0; a.ph_hi = NPHASE;
    hipLaunchKernelGGL(hymba_fwd, dim3(grid), dim3(NWAVES * 64), LDS_BYTES, stream, a);
#else
    for (int p = 0; p < NPHASE; ++p) { a.ph_lo = p; a.ph_hi = p + 1; hipLaunchKernelGGL(hymba_fwd, dim3(grid), dim3(NWAVES * 64), LDS_BYTES, stream, a); }
#endif
}
```

```cpp
#include <hip/hip_runtime.h>
#include <cstdio>
#include <cstdint>

#ifndef MK_N_LAUNCHES
#define MK_N_LAUNCHES 1
#endif

constexpr int BATCH = 2, SEQ = 8192, T = BATCH * SEQ, D = 1024, INW = 1280, FF = 3584, NE = 8;
constexpr int NH = 8, NKV = 2, HD = 64, AW = 512, KVW = 128, SW = 512, NG = 32, GD = 16, NS = 64, WIN = 128;
constexpr int QOFF = 0, KOFF = 512, VOFF = 640, UOFF = 768;
constexpr float EPS = 1e-6f;
constexpr float LOG2E = 1.4426950408889634f;
constexpr int CAP = 2 * T + NE * 256;
constexpr int CN = 16;

namespace pg8 {
#define PG8_LAS __attribute__((address_space(3)))
typedef unsigned short bf16_t;
typedef short bf16x8 __attribute__((ext_vector_type(8)));
typedef float f32x4 __attribute__((ext_vector_type(4)));
typedef float f32x2 __attribute__((ext_vector_type(2)));
typedef unsigned u32x4 __attribute__((ext_vector_type(4)));
typedef unsigned u32x2 __attribute__((ext_vector_type(2)));
constexpr int BM = 256, BK = 64, HALF = 128, HTB = HALF * BK * 2, STAGE_BYTES = 8 * HTB, NXCD = 8, WGM = 8;

__host__ __device__ __forceinline__ int lds_byte(int r, int c) { const int st = (r >> 4) * 2 + (c >> 5), rr = r & 15, cc = c & 31, ob = rr * 64 + cc * 2; return st * 1024 + (ob ^ (((ob >> 9) & 1) << 5)); }
__host__ __device__ __forceinline__ void stage_rc(int b, int& R, int& C) { const int st = b / 1024, sb = b % 1024, swz = sb ^ (((sb >> 9) & 1) << 5); R = (st >> 1) * 16 + swz / 64; C = (st & 1) * 32 + (swz % 64) / 2; }
__host__ __device__ __forceinline__ int perm32(int rho) { const int n = rho >> 4, i = rho & 15; return 8 * (i >> 2) + 4 * n + (i & 3); }

struct Unit { int pm, pn, pb, k0, nk, sl; };
struct Gemm { const bf16_t* A; const bf16_t* Bt; const int* idx; };

struct StaticOrder {
    static constexpr bool KSPLIT = false;
    int nM, nN, nwg, G, c;
    __device__ void init(int M, int N, int G_, int c_) { nM = M / BM; nN = N / BM; nwg = nM * nN; G = G_; c = c_; }
    __device__ bool next(int i, Unit& u) const {
        const long L = (long)i * G + c; if (L >= nwg) return false;
        int wgid = (int)L; { const int q = nwg / NXCD, r = nwg % NXCD, xcd = wgid % NXCD, off = wgid / NXCD; wgid = (xcd < r ? xcd * (q + 1) : r * (q + 1) + (xcd - r) * q) + off; }
        const int nig = WGM * nN, gid = wgid / nig, fm = gid * WGM, gsz = (nM - fm) < WGM ? (nM - fm) : WGM;
        u.pm = fm + ((wgid % nig) % gsz); u.pn = (wgid % nig) / gsz; u.pb = u.pn; return true;
    }
};
struct MoeOrder {
    static constexpr bool KSPLIT = false;
    int nM, nN, nwg, G, c; int pend[8];
    __device__ void init(const int* pendg, int N, int G_, int c_) {
#pragma unroll
        for (int e = 0; e < 8; ++e) pend[e] = __builtin_amdgcn_readfirstlane(pendg[e]);
        nM = pend[7]; nN = N / BM; nwg = nM * nN; G = G_; c = c_; }
    __device__ bool next(int i, Unit& u) const {
        const long L = (long)i * G + c; if (L >= nwg) return false;
        int wgid = (int)L; { const int q = nwg / NXCD, r = nwg % NXCD, xcd = wgid % NXCD, off = wgid / NXCD; wgid = (xcd < r ? xcd * (q + 1) : r * (q + 1) + (xcd - r) * q) + off; }
        const int nig = WGM * nN, gid = wgid / nig, fm = gid * WGM, gsz = (nM - fm) < WGM ? (nM - fm) : WGM;
        u.pm = fm + ((wgid % nig) % gsz); u.pn = (wgid % nig) / gsz;
        int e = 0;
#pragma unroll
        for (int k = 0; k < 7; ++k) e += (pend[k] <= u.pm) ? 1 : 0;
        u.pb = e * nN + u.pn; return true;
    }
};

constexpr int KS_MAXSLAB = 144, KS_MAXS = 8;
__device__ __forceinline__ int ks_slices(int nwg, int G) { const int rem = nwg % G; if (rem == 0) return 1; int S = G / rem; S = S > KS_MAXS ? KS_MAXS : S; if (S * rem > KS_MAXSLAB) S = KS_MAXSLAB / rem; return S < 2 ? 1 : S; }
template <int NT> struct MoeOrderSplit {
    static constexpr bool KSPLIT = true;
    int nM, nN, nwg, G, c, nfull, S, e7tile; int pend[8];
    __device__ void init(const int* pendg, int N, int G_, int c_, int e7tile_) { e7tile = e7tile_;
#pragma unroll
        for (int e = 0; e < 8; ++e) pend[e] = __builtin_amdgcn_readfirstlane(pendg[e]);
        nM = pend[7]; nN = N / BM; nwg = nM * nN; G = G_; c = c_; S = ks_slices(nwg, G); nfull = S > 1 ? (nwg / G) * G : nwg; }
    __device__ bool next(int i, Unit& u) const {
        const long L = (long)i * G + c; int wgid, sl = -1, s = 0;
        if (L < nfull) wgid = (int)L; else { const int j = (int)(L - nfull); if (j >= (nwg - nfull) * S) return false; wgid = nfull + j / S; s = j % S; sl = j; }
        { const int q = nwg / NXCD, r = nwg % NXCD, xcd = wgid % NXCD, off = wgid / NXCD; wgid = (xcd < r ? xcd * (q + 1) : r * (q + 1) + (xcd - r) * q) + off; }
        const int nig = WGM * nN, gid = wgid / nig, fm = gid * WGM, gsz = (nM - fm) < WGM ? (nM - fm) : WGM;
        u.pm = fm + ((wgid % nig) % gsz); u.pn = (wgid % nig) / gsz;
        int e = 0;
#pragma unroll
        for (int k = 0; k < 7; ++k) e += (pend[k] <= u.pm) ? 1 : 0;
        u.pb = (e < 7 ? e * nN : e7tile) + u.pn; u.sl = sl;
        if (sl < 0) { u.k0 = 0; u.nk = NT; } else { const int p0 = (NT / 2) * s / S, p1 = (NT / 2) * (s + 1) / S; u.k0 = 2 * p0; u.nk = 2 * (p1 - p0); }
        return true;
    }
};

__device__ __forceinline__ unsigned cvt_pk_bf16(float lo, float hi) { unsigned r; asm volatile("v_cvt_pk_bf16_f32 %0, %1, %2" : "=v"(r) : "v"(lo), "v"(hi)); return r; }
__device__ __forceinline__ float bf_lo(unsigned w) { return __uint_as_float(w << 16); }
__device__ __forceinline__ float bf_hi(unsigned w) { return __uint_as_float(w & 0xffff0000u); }
__device__ __forceinline__ float sum4(const float* p) { const f32x4 v = *(const f32x4*)p; return (v[0] + v[1]) + (v[2] + v[3]); }
__device__ __forceinline__ float sum16(const float* p) { return (sum4(p) + sum4(p + 4)) + (sum4(p + 8) + sum4(p + 12)); }
__device__ __forceinline__ float sum8(const float* p) { return sum4(p) + sum4(p + 4); }

struct EpiInProj {
    static constexpr bool PERM = true, MID = false; static constexpr int MID_T = 0;
    bf16_t* O; bf16_t* UG; const float* ssq; const float* gq; const float* gk; float qscale;
    struct State {};
    __device__ __forceinline__ void begin(const Unit&, int, int, State&) const {}
    __device__ __forceinline__ void mid(f32x4 (&)[2][2][4][2], const Unit&, int, int, int, int, int, State&) const {}
    __device__ __forceinline__ void operator()(const f32x4 (&acc)[2][2][4][2], const Unit& u, int ui, int wr, int wc, int fr, int fq, const State& est) const {
        const int row0 = u.pm * BM + wr * 64 + fr, tcol0 = u.pn * BM + 64 * wc;
        const int kind = tcol0 < KOFF ? 0 : (tcol0 < VOFF ? 1 : 2);
        f32x4 gv[2][2];
        if (kind < 2) { const float* g = kind == 0 ? gq : gk;
#pragma unroll
            for (int bj = 0; bj < 2; ++bj)
#pragma unroll
                for (int n = 0; n < 2; ++n) gv[bj][n] = *(const f32x4*)(g + 32 * bj + 8 * fq + 4 * n); }
#pragma unroll
        for (int ai = 0; ai < 2; ++ai) {
            float rinv4[4];
#pragma unroll
            for (int m = 0; m < 4; ++m) rinv4[m] = __builtin_amdgcn_rsqf(sum16(ssq + (size_t)(row0 + ai * HALF + m * 16) * 16) * (1.0f / D) + EPS);
            asm volatile("" : "+v"(rinv4[0]), "+v"(rinv4[1]), "+v"(rinv4[2]), "+v"(rinv4[3]));
#pragma unroll
            for (int m = 0; m < 4; ++m) {
                const int row = row0 + ai * HALF + m * 16;
                const float rinv = rinv4[m];
                f32x4 v[2][2];
#pragma unroll
                for (int bj = 0; bj < 2; ++bj)
#pragma unroll
                    for (int n = 0; n < 2; ++n) v[bj][n] = acc[ai][bj][m][n] * rinv;
                if (kind < 2) {
                    float ss = 0.f;
#pragma unroll
                    for (int bj = 0; bj < 2; ++bj)
#pragma unroll
                        for (int n = 0; n < 2; ++n) { const f32x4 x = v[bj][n]; ss += (x[0] * x[0] + x[1] * x[1]) + (x[2] * x[2] + x[3] * x[3]); }
                    ss += __shfl_xor(ss, 16); ss += __shfl_xor(ss, 32);
                    const float hr = __builtin_amdgcn_rsqf(ss * (1.0f / HD) + EPS) * (kind == 0 ? qscale : 1.0f);
#pragma unroll
                    for (int bj = 0; bj < 2; ++bj)
#pragma unroll
                        for (int n = 0; n < 2; ++n) v[bj][n] = v[bj][n] * gv[bj][n] * hr;
                }
                bf16_t* rowp = O + (size_t)row * INW + tcol0 + 8 * fq;
#pragma unroll
                for (int bj = 0; bj < 2; ++bj) { u32x4 w; w.x = cvt_pk_bf16(v[bj][0][0], v[bj][0][1]); w.y = cvt_pk_bf16(v[bj][0][2], v[bj][0][3]); w.z = cvt_pk_bf16(v[bj][1][0], v[bj][1][1]); w.w = cvt_pk_bf16(v[bj][1][2], v[bj][1][3]);
                    if (tcol0 >= UOFF) { const int uc = tcol0 - UOFF + 32 * bj + 8 * fq;
                        *(u32x4*)(UG + ((size_t)(uc >> 4) * T + row) * GD + (uc & 15)) = w; }
                    else *(u32x4*)(rowp + 32 * bj) = w; }
            }
        }
    }
};
struct EpiGlu {
    static constexpr bool PERM = true, MID = false; static constexpr int MID_T = 0;
    const bf16_t* Y; bf16_t* MIX; float* ssq;
    struct State {};
    __device__ __forceinline__ void begin(const Unit&, int, int, State&) const {}
    __device__ __forceinline__ void mid(f32x4 (&)[2][2][4][2], const Unit&, int, int, int, int, int, State&) const {}
    __device__ __forceinline__ void operator()(const f32x4 (&acc)[2][2][4][2], const Unit& u, int ui, int wr, int wc, int fr, int fq, const State& est) const {
        const int row0 = u.pm * BM + wr * 64 + fr, col0 = u.pn * BM + wc * 32 + 8 * fq;
#pragma unroll
        for (int ai = 0; ai < 2; ++ai) {
            u32x4 yall[4][2];
#pragma unroll
            for (int m = 0; m < 4; ++m)
#pragma unroll
                for (int bj = 0; bj < 2; ++bj) yall[m][bj] = *(const u32x4*)(Y + (size_t)(row0 + ai * HALF + m * 16) * SW + col0 + bj * HALF);
#pragma unroll
            for (int m = 0; m < 4; ++m) {
                const int row = row0 + ai * HALF + m * 16; float ss = 0.f;
#pragma unroll
                for (int bj = 0; bj < 2; ++bj) {
                    const u32x4 yw = yall[m][bj];
                    const float y[8] = {bf_lo(yw.x), bf_hi(yw.x), bf_lo(yw.y), bf_hi(yw.y), bf_lo(yw.z), bf_hi(yw.z), bf_lo(yw.w), bf_hi(yw.w)};
                    float s[8];
#pragma unroll
                    for (int n = 0; n < 2; ++n)
#pragma unroll
                        for (int j = 0; j < 4; ++j) { const float g = acc[ai][bj][m][n][j]; const float o = y[4 * n + j] * __builtin_amdgcn_rcpf(1.0f + __builtin_amdgcn_exp2f(-LOG2E * g)); s[4 * n + j] = o; ss += o * o; }
                    u32x4 w; w.x = cvt_pk_bf16(s[0], s[1]); w.y = cvt_pk_bf16(s[2], s[3]); w.z = cvt_pk_bf16(s[4], s[5]); w.w = cvt_pk_bf16(s[6], s[7]);
                    *(u32x4*)(MIX + (size_t)row * D + AW + col0 + bj * HALF) = w;
                }
                ss += __shfl_xor(ss, 16); ss += __shfl_xor(ss, 32);
                if (fq == 0) ssq[(size_t)row * 8 + u.pn * 4 + wc] = ss;
            }
        }
    }
};
template <bool WO, bool RESF32> struct EpiRes {
    static constexpr bool PERM = true, MID = WO; static constexpr int MID_T = 8;
    const float* res; bf16_t* XB; float* ssq_out; const float* ssq_a; const float* ssq_s;
    PG8_LAS float* tab;
    struct State {};
    __device__ __forceinline__ void begin(const Unit& u, int ui, int tid, State&) const {
        if (WO) { if (tid < BM) { const int row = u.pm * BM + tid;
            const float ra = 1.0f / sqrtf(sum8(ssq_a + (size_t)row * 8) * (1.0f / AW) + EPS), rs = 1.0f / sqrtf(sum8(ssq_s + (size_t)row * 8) * (1.0f / SW) + EPS);
            *(PG8_LAS f32x2*)(tab + ((ui & 1) * BM + tid) * 2) = (f32x2){ra / rs, rs}; } }
    }
    __device__ __forceinline__ void mid(f32x4 (&acc)[2][2][4][2], const Unit& u, int ui, int wr, int wc, int fr, int fq, State&) const {
        const int r0 = wr * 64 + fr;
#pragma unroll
        for (int ai = 0; ai < 2; ++ai)
#pragma unroll
            for (int m = 0; m < 4; ++m) {
                const float f = tab[((ui & 1) * BM + r0 + ai * HALF + m * 16) * 2];
#pragma unroll
                for (int bj = 0; bj < 2; ++bj)
#pragma unroll
                    for (int n = 0; n < 2; ++n) acc[ai][bj][m][n] *= f;
            }
    }
    __device__ __forceinline__ void operator()(const f32x4 (&acc)[2][2][4][2], const Unit& u, int ui, int wr, int wc, int fr, int fq, const State& est) const {
        const int r0 = wr * 64 + fr, row0 = u.pm * BM + r0, col0 = u.pn * BM + wc * 32 + 8 * fq;
        constexpr int NB = RESF32 ? 2 : 4;
#pragma unroll
        for (int b0 = 0; b0 < 8; b0 += NB) {
            f32x4 rf[NB][2][2]; u32x4 rb[NB][2];
#pragma unroll
            for (int q = 0; q < NB; ++q) { const int ai = (b0 + q) >> 2, m = (b0 + q) & 3; const size_t off = (size_t)(row0 + ai * HALF + m * 16) * D + col0;
#pragma unroll
                for (int bj = 0; bj < 2; ++bj) { if (RESF32) { rf[q][bj][0] = *(const f32x4*)(res + off + bj * HALF); rf[q][bj][1] = *(const f32x4*)(res + off + bj * HALF + 4); } else rb[q][bj] = *(const u32x4*)(XB + off + bj * HALF); } }
#pragma unroll
            for (int q = 0; q < NB; ++q) { const int ai = (b0 + q) >> 2, m = (b0 + q) & 3, row = row0 + ai * HALF + m * 16; float ss = 0.f;
                float sc = 1.0f; if (WO) sc = tab[((ui & 1) * BM + r0 + ai * HALF + m * 16) * 2 + 1];
#pragma unroll
                for (int bj = 0; bj < 2; ++bj) {
                    f32x4 r0v, r1v;
                    if (RESF32) { r0v = rf[q][bj][0]; r1v = rf[q][bj][1]; }
                    else { const u32x4 w = rb[q][bj]; r0v = (f32x4){bf_lo(w.x), bf_hi(w.x), bf_lo(w.y), bf_hi(w.y)}; r1v = (f32x4){bf_lo(w.z), bf_hi(w.z), bf_lo(w.w), bf_hi(w.w)}; }
                    const f32x4 o0 = r0v + acc[ai][bj][m][0] * sc, o1 = r1v + acc[ai][bj][m][1] * sc;
                    u32x4 w; w.x = cvt_pk_bf16(o0[0], o0[1]); w.y = cvt_pk_bf16(o0[2], o0[3]); w.z = cvt_pk_bf16(o1[0], o1[1]); w.w = cvt_pk_bf16(o1[2], o1[3]);
                    *(u32x4*)(XB + (size_t)row * D + col0 + bj * HALF) = w;
                    ss += ((o0[0] * o0[0] + o0[1] * o0[1]) + (o0[2] * o0[2] + o0[3] * o0[3])) + ((o1[0] * o1[0] + o1[1] * o1[1]) + (o1[2] * o1[2] + o1[3] * o1[3]));
                }
                ss += __shfl_xor(ss, 16); ss += __shfl_xor(ss, 32);
                if (fq == 0) ssq_out[(size_t)row * 16 + u.pn * 4 + wc] = ss;
            }
        }
    }
};
template <bool MOE> struct EpiSwiglu {
    static constexpr bool PERM = true, MID = false; static constexpr int MID_T = 0;
    bf16_t* H; const float* rs;
    PG8_LAS float* tab;
    struct State { float r[MOE ? 8 : 1]; };
    __device__ __forceinline__ void begin(const Unit& u, int ui, int tid, State& st) const {
        if (MOE) { const int wid = tid >> 6, lane = tid & 63, row0 = u.pm * BM + (wid >> 2) * 64 + (lane & 15);
#pragma unroll
            for (int ai = 0; ai < 2; ++ai)
#pragma unroll
                for (int m = 0; m < 4; ++m) st.r[ai * 4 + m] = rs[row0 + ai * HALF + m * 16]; }
    }
    __device__ __forceinline__ void mid(f32x4 (&)[2][2][4][2], const Unit&, int, int, int, int, int, State&) const {}
    __device__ __forceinline__ void operator()(const f32x4 (&acc)[2][2][4][2], const Unit& u, int ui, int wr, int wc, int fr, int fq, const State& est) const {
        const int r0 = wr * 64 + fr, row0 = u.pm * BM + r0, hcol = u.pn * HALF + wc * 32 + 8 * fq;
#pragma unroll
        for (int ai = 0; ai < 2; ++ai)
#pragma unroll
            for (int m = 0; m < 4; ++m) {
                const int row = row0 + ai * HALF + m * 16;
                const float rinv = MOE ? est.r[MOE ? ai * 4 + m : 0] : tab[ui * BM + r0 + ai * HALF + m * 16];
                float h[8];
#pragma unroll
                for (int n = 0; n < 2; ++n)
#pragma unroll
                    for (int j = 0; j < 4; ++j) { const float g = acc[ai][0][m][n][j] * rinv, uu = acc[ai][1][m][n][j] * rinv; h[4 * n + j] = g * __builtin_amdgcn_rcpf(1.0f + __builtin_amdgcn_exp2f(-LOG2E * g)) * uu; }
                u32x4 w; w.x = cvt_pk_bf16(h[0], h[1]); w.y = cvt_pk_bf16(h[2], h[3]); w.z = cvt_pk_bf16(h[4], h[5]); w.w = cvt_pk_bf16(h[6], h[7]);
                *(u32x4*)(H + (size_t)row * FF + hcol) = w;
            }
    }
};
template <class Sched> __device__ __forceinline__ void fill_rinv_tab(const Sched& S, const float* ssq, PG8_LAS float* tab, int tid, int maxu) {
    if (tid < BM) { Unit u;
        for (int i = 0; i < maxu && S.next(i, u); ++i) tab[i * BM + tid] = __builtin_amdgcn_rsqf(sum16(ssq + (size_t)(u.pm * BM + tid) * 16) * (1.0f / D) + EPS); }
    asm volatile("s_waitcnt lgkmcnt(0)\n\ts_barrier" ::: "memory");
}
struct EpiMoeDown {
    static constexpr bool PERM = true, MID = false; static constexpr int MID_T = 0;
    bf16_t* Ys; bf16_t* Ys2; int ysplit; const float* gate; float* slab; unsigned* tailmap; int S;
    struct State {};
    __device__ __forceinline__ void begin(const Unit&, int, int, State&) const {}
    __device__ __forceinline__ void mid(f32x4 (&)[2][2][4][2], const Unit&, int, int, int, int, int, State&) const {}
    __device__ __forceinline__ void operator()(const f32x4 (&acc)[2][2][4][2], const Unit& u, int ui, int wr, int wc, int fr, int fq, const State& est) const {
        if (u.sl >= 0) {
            float* sb = slab + (size_t)u.sl * (BM * BM) + (size_t)(wr * 64 + fr) * BM + wc * 32 + 8 * fq;
#pragma unroll
            for (int ai = 0; ai < 2; ++ai)
#pragma unroll
                for (int m = 0; m < 4; ++m)
#pragma unroll
                    for (int bj = 0; bj < 2; ++bj) { float* q = sb + (size_t)(ai * HALF + m * 16) * BM + bj * HALF; *(f32x4*)q = acc[ai][bj][m][0]; *(f32x4*)(q + 4) = acc[ai][bj][m][1]; }
            if (u.sl % S == 0 && wr == 0 && wc == 0 && fr == 0 && fq == 0) tailmap[u.pm * 4 + u.pn] = 1u + (unsigned)(u.sl / S);
            return;
        }
        const int row0 = u.pm * BM + wr * 64 + fr, col0 = u.pn * BM + wc * 32 + 8 * fq;
        bf16_t* ysb = u.pm * BM < ysplit ? Ys + (size_t)u.pm * BM * D : Ys2 + (size_t)(u.pm * BM - ysplit) * D;
        float g8[2][4];
#pragma unroll
        for (int ai = 0; ai < 2; ++ai)
#pragma unroll
            for (int m = 0; m < 4; ++m) g8[ai][m] = gate[row0 + ai * HALF + m * 16];
#pragma unroll
        for (int ai = 0; ai < 2; ++ai)
#pragma unroll
            for (int m = 0; m < 4; ++m) {
                const int row = row0 + ai * HALF + m * 16; const float g = g8[ai][m];
#pragma unroll
                for (int bj = 0; bj < 2; ++bj) { const f32x4 v0 = acc[ai][bj][m][0] * g, v1 = acc[ai][bj][m][1] * g;
                    u32x4 w; w.x = cvt_pk_bf16(v0[0], v0[1]); w.y = cvt_pk_bf16(v0[2], v0[3]); w.z = cvt_pk_bf16(v1[0], v1[1]); w.w = cvt_pk_bf16(v1[2], v1[3]);
                    *(u32x4*)(ysb + (size_t)(row - u.pm * BM) * D + col0 + bj * HALF) = w; }
            }
    }
};

template <class Epi, class Sched, bool GATHER, int K, bool ALIGN_EPI = true, bool SP2 = true>
__device__ __forceinline__ void gemm_phase(PG8_LAS unsigned char* lds, const Gemm g, const Sched& S, const Epi& E) {
    int tid_ = threadIdx.x; asm volatile("" : "+v"(tid_));
    const int tid = tid_, wid = __builtin_amdgcn_readfirstlane(tid >> 6), lane = tid & 63, wr = wid >> 2, wc = wid & 3, fr = lane & 15, fq = lane >> 4;
    constexpr int nt = K / BK;
    unsigned voffA[2], voffB[2]; int RA[2], CA[2];
#pragma unroll
    for (int i = 0; i < 2; ++i) { int R, C; stage_rc(tid * 16 + i * 8192, R, C); const int Rb = Epi::PERM ? ((R & ~31) + perm32(R & 31)) : R;
        RA[i] = R; CA[i] = C; voffA[i] = (unsigned)(R * K + C) * 2u; voffB[i] = (unsigned)(Rb * K + C) * 2u; }
    constexpr size_t kstep = (size_t)(BK * 2);
    constexpr size_t hstep = (size_t)HALF * K * 2;
    constexpr size_t tstep = 2 * hstep;
    const unsigned ldsw = (unsigned)wid * 1024u;
    const int aoff = lds_byte(wr * 64 + fr, fq * 8), boff = lds_byte(wc * 32 + fr, fq * 8);
#define PG8_SA(b, h) (((b) * 2 + (h)) * HTB)
#define PG8_SB(b, h) ((4 + (b) * 2 + (h)) * HTB)
    const __amdgpu_buffer_rsrc_t rsA = __builtin_amdgcn_make_buffer_rsrc((void*)g.A, (short)0, -1, 0x00020000), rsB = __builtin_amdgcn_make_buffer_rsrc((void*)g.Bt, (short)0, -1, 0x00020000);
#define PG8_STAGE_R(bufoff, rs, soff, voff) do { _Pragma("unroll") for (int _i = 0; _i < 2; ++_i) \
        __builtin_amdgcn_raw_ptr_buffer_load_lds(rs, (PG8_LAS unsigned*)(lds + (bufoff) + ldsw + _i * 8192), 16, (voff)[_i], (unsigned)(soff), 0, 0); } while (0)
#define PG8_STAGE(bufoff, soff, voff) PG8_STAGE_R(bufoff, rsB, soff, voff)
#define PG8_STAGE_A(bufoff, soff, h, VG) do { if constexpr (GATHER) { PG8_STAGE_R(bufoff, rsA, soff, VG[h]); } else { PG8_STAGE_R(bufoff, rsA, (soff) + (unsigned)((h) * hstep), voffA); } } while (0)
#define PG8_LDA(dst, b, h) do { _Pragma("unroll") for (int m = 0; m < 4; ++m) _Pragma("unroll") for (int k = 0; k < 2; ++k) dst[m][k] = *(const PG8_LAS bf16x8*)(lds + PG8_SA(b, h) + aoff + m * 2048 + k * 1024); } while (0)
#define PG8_LDB(dst, b, h) do { _Pragma("unroll") for (int n = 0; n < 2; ++n) _Pragma("unroll") for (int k = 0; k < 2; ++k) dst[n][k] = *(const PG8_LAS bf16x8*)(lds + PG8_SB(b, h) + boff + n * 2048 + k * 1024); } while (0)
#define PG8_MMA(ai, bj, At, Bt) do { __builtin_amdgcn_s_setprio(1); _Pragma("unroll") for (int m = 0; m < 4; ++m) _Pragma("unroll") for (int n = 0; n < 2; ++n) _Pragma("unroll") for (int k = 0; k < 2; ++k) \
        acc[ai][bj][m][n] = __builtin_amdgcn_mfma_f32_16x16x32_bf16(Bt[n][k], At[m][k], acc[ai][bj][m][n], 0, 0, 0); __builtin_amdgcn_s_setprio(0); } while (0)
#define PG8_WAIT_V(n) asm volatile("s_waitcnt vmcnt(" #n ")" ::: "memory")
#define PG8_WAIT_L(n) asm volatile("s_waitcnt lgkmcnt(" #n ")" ::: "memory")
#define PG8_BAR __builtin_amdgcn_s_barrier()
#define PG8_SCHED __builtin_amdgcn_sched_barrier(0)
#define PG8_GOFF(dst, U) do { _Pragma("unroll") for (int _h = 0; _h < 2; ++_h) _Pragma("unroll") for (int _i = 0; _i < 2; ++_i) \
        dst[_h][_i] = ((unsigned)g.idx[(U).pm * BM + _h * HALF + RA[_i]] * (unsigned)K + (unsigned)CA[_i]) * 2u; } while (0)
    Unit cur, nxt; int ui = 0;
    if (!S.next(0, cur)) return;
    if constexpr (!Sched::KSPLIT) { cur.k0 = 0; cur.nk = nt; cur.sl = -1; }
    f32x4 acc[2][2][4][2];
#pragma unroll
    for (int a = 0; a < 2; ++a)
#pragma unroll
        for (int b = 0; b < 2; ++b)
#pragma unroll
            for (int m = 0; m < 4; ++m)
#pragma unroll
                for (int n = 0; n < 2; ++n) acc[a][b][m][n] = (f32x4){0.f, 0.f, 0.f, 0.f};
    bf16x8 At[4][2], B0[2][2], B1[2][2];
    unsigned vgc[2][2] = {{0u, 0u}, {0u, 0u}}, vgn[2][2] = {{0u, 0u}, {0u, 0u}};
    unsigned cA = (GATHER ? 0u : (unsigned)cur.pm * (unsigned)tstep) + (unsigned)cur.k0 * (unsigned)kstep, cB = (unsigned)cur.pb * (unsigned)tstep + (unsigned)cur.k0 * (unsigned)kstep;
    if constexpr (GATHER) PG8_GOFF(vgc, cur);
    typename Epi::State est;
    E.begin(cur, 0, tid, est);
    if constexpr (SP2) {
        PG8_STAGE(PG8_SB(0, 0), cB, voffB); PG8_STAGE(PG8_SB(0, 1), cB + hstep, voffB); PG8_STAGE_A(PG8_SA(0, 0), cA, 0, vgc); PG8_STAGE_A(PG8_SA(0, 1), cA, 1, vgc);
        if (wr == 1) PG8_BAR;
        PG8_WAIT_V(2); PG8_BAR;
        PG8_STAGE(PG8_SB(1, 0), cB + kstep, voffB); PG8_STAGE_A(PG8_SA(1, 0), cA + kstep, 0, vgc); PG8_STAGE(PG8_SB(1, 1), cB + hstep + kstep, voffB);
        PG8_WAIT_V(6); PG8_BAR;
    } else {
        PG8_STAGE(PG8_SB(0, 0), cB, voffB); PG8_STAGE_A(PG8_SA(0, 0), cA, 0, vgc); PG8_STAGE(PG8_SB(0, 1), cB + hstep, voffB); PG8_STAGE_A(PG8_SA(0, 1), cA, 1, vgc);
        if (wr == 1) PG8_BAR;
        PG8_WAIT_V(4); PG8_BAR;
        PG8_STAGE(PG8_SB(1, 0), cB + kstep, voffB); PG8_STAGE_A(PG8_SA(1, 0), cA + kstep, 0, vgc); PG8_STAGE(PG8_SB(1, 1), cB + hstep + kstep, voffB);
        PG8_WAIT_V(6); PG8_BAR;
    }
    for (;;) {
        const bool has_next = S.next(ui + 1, nxt);
        if constexpr (!Sched::KSPLIT) { nxt.k0 = 0; nxt.nk = nt; nxt.sl = -1; }
        const unsigned nA = has_next ? (GATHER ? 0u : (unsigned)nxt.pm * (unsigned)tstep) + (unsigned)nxt.k0 * (unsigned)kstep : cA, nB = has_next ? (unsigned)nxt.pb * (unsigned)tstep + (unsigned)nxt.k0 * (unsigned)kstep : cB;
        if constexpr (GATHER) { if (has_next) PG8_GOFF(vgn, nxt); else {
#pragma unroll
            for (int h = 0; h < 2; ++h)
#pragma unroll
                for (int i = 0; i < 2; ++i) vgn[h][i] = vgc[h][i]; } }
        const int nk = cur.nk;
        for (int t = 0; t < nk; t += 2) {
            const bool last = (t == nk - 2);
            if constexpr (Epi::MID) { if (t == Epi::MID_T) E.mid(acc, cur, ui, wr, wc, fr, fq, est); }
            const unsigned a1 = cA + (unsigned)(t + 1) * (unsigned)kstep;
            const unsigned a2 = last ? nA : cA + (unsigned)(t + 2) * (unsigned)kstep, b2 = last ? nB : cB + (unsigned)(t + 2) * (unsigned)kstep;
            const unsigned a3 = a2 + (unsigned)kstep, b3 = b2 + (unsigned)kstep;
            unsigned vgs[2][2];
#pragma unroll
            for (int h = 0; h < 2; ++h)
#pragma unroll
                for (int i = 0; i < 2; ++i) vgs[h][i] = last ? vgn[h][i] : vgc[h][i];
            if constexpr (SP2) {
            PG8_LDB(B0, 0, 0); PG8_LDB(B1, 0, 1); PG8_SCHED; PG8_LDA(At, 0, 0); PG8_STAGE_A(PG8_SA(1, 1), a1, 1, vgc);
            PG8_WAIT_V(8); PG8_WAIT_L(0); PG8_BAR; PG8_MMA(0, 0, At, B0); PG8_MMA(0, 1, At, B1); PG8_BAR; PG8_SCHED;
            PG8_LDA(At, 0, 1); PG8_STAGE(PG8_SB(0, 0), b2, voffB); PG8_STAGE(PG8_SB(0, 1), b2 + hstep, voffB); PG8_STAGE_A(PG8_SA(0, 0), a2, 0, vgs);
            PG8_WAIT_V(8); PG8_WAIT_L(0); PG8_BAR; PG8_MMA(1, 0, At, B0); PG8_MMA(1, 1, At, B1); PG8_BAR; PG8_SCHED;
            PG8_LDB(B0, 1, 0); PG8_LDB(B1, 1, 1); PG8_SCHED; PG8_LDA(At, 1, 0); PG8_STAGE_A(PG8_SA(0, 1), a2, 1, vgs);
            PG8_WAIT_V(8); PG8_WAIT_L(0); PG8_BAR; PG8_MMA(0, 0, At, B0); PG8_MMA(0, 1, At, B1); PG8_BAR; PG8_SCHED;
            PG8_LDA(At, 1, 1); PG8_STAGE(PG8_SB(1, 0), b3, voffB); PG8_STAGE(PG8_SB(1, 1), b3 + hstep, voffB); PG8_STAGE_A(PG8_SA(1, 0), a3, 0, vgs);
            PG8_WAIT_V(8); PG8_WAIT_L(0); PG8_BAR; PG8_MMA(1, 0, At, B0); PG8_MMA(1, 1, At, B1); PG8_BAR; PG8_SCHED;
            } else {
            PG8_LDB(B0, 0, 0); PG8_SCHED; PG8_LDA(At, 0, 0); PG8_STAGE_A(PG8_SA(1, 1), a1, 1, vgc);
            PG8_WAIT_L(8); PG8_BAR; PG8_WAIT_L(0); PG8_MMA(0, 0, At, B0); PG8_BAR; PG8_SCHED;
            PG8_LDB(B1, 0, 1); PG8_STAGE(PG8_SB(0, 0), b2, voffB);
            PG8_BAR; PG8_WAIT_L(0); PG8_MMA(0, 1, At, B1); PG8_BAR;
            PG8_LDA(At, 0, 1); PG8_STAGE_A(PG8_SA(0, 0), a2, 0, vgs);
            PG8_BAR; PG8_WAIT_L(0); PG8_MMA(1, 0, At, B0); PG8_BAR; PG8_SCHED;
            PG8_STAGE(PG8_SB(0, 1), b2 + hstep, voffB);
            PG8_WAIT_V(6); PG8_BAR; PG8_MMA(1, 1, At, B1); PG8_BAR;
            PG8_LDB(B0, 1, 0); PG8_SCHED; PG8_LDA(At, 1, 0); PG8_STAGE_A(PG8_SA(0, 1), a2, 1, vgs);
            PG8_WAIT_L(8); PG8_BAR; PG8_WAIT_L(0); PG8_MMA(0, 0, At, B0); PG8_BAR; PG8_SCHED;
            PG8_LDB(B1, 1, 1); PG8_STAGE(PG8_SB(1, 0), b3, voffB);
            PG8_BAR; PG8_WAIT_L(0); PG8_MMA(0, 1, At, B1); PG8_BAR;
            PG8_LDA(At, 1, 1); PG8_STAGE_A(PG8_SA(1, 0), a3, 0, vgs);
            PG8_BAR; PG8_WAIT_L(0); PG8_MMA(1, 0, At, B0); PG8_BAR; PG8_SCHED;
            PG8_STAGE(PG8_SB(1, 1), b3 + hstep, voffB);
            PG8_WAIT_V(6); PG8_BAR; PG8_MMA(1, 1, At, B1); PG8_BAR;
            }
        }
        if constexpr (ALIGN_EPI) { if (wr == 0) PG8_BAR; }
        E(acc, cur, ui, wr, wc, fr, fq, est);
        if (!has_next) break;
#pragma unroll
        for (int a = 0; a < 2; ++a)
#pragma unroll
            for (int b = 0; b < 2; ++b)
#pragma unroll
                for (int m = 0; m < 4; ++m)
#pragma unroll
                    for (int n = 0; n < 2; ++n) acc[a][b][m][n] = (f32x4){0.f, 0.f, 0.f, 0.f};
        cur = nxt; cA = nA; cB = nB; ++ui;
        E.begin(cur, ui, tid, est);
#pragma unroll
        for (int h = 0; h < 2; ++h)
#pragma unroll
            for (int i = 0; i < 2; ++i) vgc[h][i] = vgn[h][i];
        if constexpr (ALIGN_EPI) { if (wr == 1) PG8_BAR; }
    }
    PG8_WAIT_V(0);
    if constexpr (!ALIGN_EPI) { if (wr == 0) PG8_BAR; }
    PG8_BAR;
#undef PG8_SA
#undef PG8_SB
#undef PG8_STAGE
#undef PG8_STAGE_A
#undef PG8_LDA
#undef PG8_LDB
#undef PG8_MMA
#undef PG8_WAIT_V
#undef PG8_WAIT_L
#undef PG8_BAR
#undef PG8_SCHED
#undef PG8_GOFF
}
}

constexpr size_t MiB = 1u << 20;
constexpr size_t WS_CTL = 0, CTL_ZERO_BYTES = 128 * 1024;
constexpr size_t WS_SSQ_A = 1 * MiB, WS_SSQ_F = 2 * MiB, WS_SSQ_ATT = 3 * MiB, WS_SSQ_SSM = 3 * MiB + 512 * 1024;
constexpr size_t WS_ROUTE = 4 * MiB;
constexpr size_t RT_IDX = 0, RT_GATE = 160 * 1024, RT_RINVS = 320 * 1024, RT_POS = 480 * 1024, RT_TOPE = 608 * 1024, RT_TOPG = 736 * 1024, RT_RINVT = 864 * 1024, RT_HIST = 928 * 1024, RT_PEND = 944 * 1024;
constexpr size_t WS_SSMPRE = 6 * MiB, SSMPRE_STRIDE = 9 * MiB;
constexpr size_t WS_WSMALL = 24 * MiB, WSMALL_STRIDE = 5 * MiB, WS_WIN = 0, WS_WGLU = 5 * MiB / 2, WS_WO = 3 * MiB;
constexpr size_t WS_DGU = 34 * MiB, WS_DD = 48 * MiB;
constexpr size_t WS_MOEW = 56 * MiB, WS_XB = 168 * MiB, WS_YS = 56 * MiB, WS_YS2 = WS_YS + (size_t)28672 * 1024 * 2;
constexpr int YS_SPLIT = 28672;
constexpr size_t WS_RA = 200 * MiB, WS_QKVU = WS_RA, WS_MIX = 240 * MiB, WS_YG = 272 * MiB, WS_HD = 288 * MiB, WS_HS = WS_RA;
constexpr size_t WS_UG = WS_HD;
constexpr size_t WS_END = 446 * MiB;
static_assert(WS_YS2 + (size_t)(CAP - YS_SPLIT) * D * 2 <= 124 * MiB && WS_HS + (size_t)CAP * FF * 2 <= WS_END && WS_HD + (size_t)T * FF * 2 <= WS_END, "ws map");
constexpr int CW_BAR = 4096, CW_TAILMAP = 16384;
constexpr size_t WS_SLAB = 124 * MiB;
static_assert(WS_SLAB + (size_t)pg8::KS_MAXSLAB * 256 * 256 * 4 <= 168 * MiB, "slabs");
constexpr size_t WS_WDT = 6 * MiB, WDT_TILEB = (size_t)256 * FF * 2;
constexpr int WDT_E7 = 247;
static_assert(WS_WDT + 7 * 4 * WDT_TILEB <= 55 * MiB && WS_WDT + WDT_E7 * WDT_TILEB >= 438 * MiB, "MoE down weight copies");

constexpr int RING_OFF = 0, RING_BYTES = 131072;
constexpr int LDSCTL_OFF = RING_BYTES, MISC_OFF = LDSCTL_OFF + 320;
constexpr int TAB_OFF = MISC_OFF + 192;
constexpr int LDS_BYTES = 147456;
constexpr int TAB2_OFF = TAB_OFF + 4096, TAB2_UNITS = 11;
static_assert(TAB_OFF % 16 == 0 && TAB2_OFF + TAB2_UNITS * 1024 <= LDS_BYTES, "LDS map");
constexpr int NWAVES = 8;

#define GAS __attribute__((address_space(1)))
#define LAS __attribute__((address_space(3)))
typedef unsigned short bf16;
typedef unsigned v4u __attribute__((ext_vector_type(4)));
typedef float f32x4 __attribute__((ext_vector_type(4)));
typedef GAS unsigned gu32;
#define RLX_AGENT __ATOMIC_RELAXED, __HIP_MEMORY_SCOPE_AGENT
#define LDS_WAIT() asm volatile("s_waitcnt lgkmcnt(0)" ::: "memory")
#define VM_WAIT() asm volatile("s_waitcnt vmcnt(0)" ::: "memory")
__device__ __forceinline__ unsigned f2bf(float f) { unsigned u = __builtin_bit_cast(unsigned, f); return (u + 0x7fffu + ((u >> 16) & 1u)) >> 16; }
__device__ __forceinline__ unsigned pk2(float lo, float hi) { return f2bf(lo) | (f2bf(hi) << 16); }
__device__ __forceinline__ float bf2f(bf16 v) { return __uint_as_float((unsigned)v << 16); }

#define XB_TMO      128
#define XB_XCNT(j)  (256  + 64 * (j))
#define XB_XSUB(j)  (1280 + 64 * (j))
#define XB_XGEN(j)  (2304 + 64 * (j))
#define XB_TOP      3328
#define XB_TOPGEN   3392
#define XCD_BAR_WORDS 3456
#define XB_SPIN_CAP (1u << 22)
__device__ __forceinline__ unsigned xb_ld(unsigned* p)              { return __hip_atomic_load(p, __ATOMIC_RELAXED, __HIP_MEMORY_SCOPE_AGENT); }
__device__ __forceinline__ unsigned xb_add(unsigned* p, unsigned v) { return __hip_atomic_fetch_add(p, v, __ATOMIC_RELAXED, __HIP_MEMORY_SCOPE_AGENT); }
__device__ __forceinline__ unsigned xb_xcc_id() { return (unsigned)__builtin_amdgcn_s_getreg((3 << 11) | 20) & 0xFu; }
#define XB_SPIN(cond, bar) do { unsigned _sp = 0; while (cond) { __builtin_amdgcn_s_sleep(1); \
    if ((++_sp & 255u) == 0u) { if (xb_ld(&(bar)[XB_TMO])) break; if (_sp > XB_SPIN_CAP) { atomicAdd(&(bar)[XB_TMO], 1u); break; } } } } while (0)
struct XcdBarrier { unsigned* bar; unsigned x; volatile LAS unsigned* st; };
__device__ __forceinline__ XcdBarrier xcd_barrier_post(unsigned* bar, volatile LAS unsigned* st) {
    XcdBarrier b; b.bar = bar; b.x = xb_xcc_id(); b.st = st;
    if (threadIdx.x == 0) (void)xb_add(&bar[XB_XCNT(b.x)], 1u);
    return b;
}
__device__ __forceinline__ void xcd_barrier_complete(unsigned* bar, unsigned x, unsigned& nloc, unsigned& nx) {
    const unsigned G = gridDim.x * gridDim.y * gridDim.z;
    unsigned sum, cnt, mine, sp = 0u;
    for (;;) {
        sum = 0u; cnt = 0u; mine = 0u;
#pragma unroll
        for (unsigned j = 0; j < 16; ++j) { const unsigned c = xb_ld(&bar[XB_XCNT(j)]); sum += c; cnt += (c > 0u) ? 1u : 0u; mine = (j == x) ? c : mine; }
        if (sum == G) break;
        __builtin_amdgcn_s_sleep(1);
        if ((++sp & 255u) == 0u) { if (xb_ld(&bar[XB_TMO])) break; if (sp > XB_SPIN_CAP) { atomicAdd(&bar[XB_TMO], 1u); break; } }
    }
    nloc = mine > 0u ? mine : 1u; nx = cnt > 0u ? cnt : 1u;
}
__device__ __forceinline__ void xcd_barrier(const XcdBarrier& b) {
    asm volatile("s_waitcnt vmcnt(0)" ::: "memory");
    __syncthreads();
    if (threadIdx.x == 0) {
        unsigned* bar = b.bar;
        __builtin_amdgcn_s_waitcnt(0);
        unsigned nloc = b.st[0], nx = b.st[1];
        if (nloc == 0u) { xcd_barrier_complete(bar, b.x, nloc, nx); b.st[0] = nloc; b.st[1] = nx; }
        const unsigned old = xb_add(&bar[XB_XSUB(b.x)], 1u);
        const unsigned gen = old / nloc;
        if (old + 1u == (gen + 1u) * nloc) {
            __builtin_amdgcn_fence(__ATOMIC_RELEASE, "agent");
            asm volatile("s_waitcnt vmcnt(0)" ::: "memory");
            const unsigned og = xb_add(&bar[XB_TOP], 1u);
            const unsigned tg = og / nx;
            if (og + 1u == (tg + 1u) * nx) xb_add(&bar[XB_TOPGEN], 1u);
            else XB_SPIN(xb_ld(&bar[XB_TOPGEN]) == tg, bar);
            __builtin_amdgcn_fence(__ATOMIC_ACQUIRE, "agent");
            xb_add(&bar[XB_XGEN(b.x)], 1u);
            asm volatile("s_waitcnt vmcnt(0)" ::: "memory");
        } else {
            XB_SPIN(xb_ld(&bar[XB_XGEN(b.x)]) == gen, bar);
            __builtin_amdgcn_fence(__ATOMIC_ACQUIRE, "agent");
            asm volatile("s_waitcnt vmcnt(0)" ::: "memory");
        }
    }
    __syncthreads();
}

struct Args { const float* in[26]; float* out; unsigned char* ws; int ph_lo, ph_hi; };
struct Frame {
    LAS unsigned char* lds; volatile LAS unsigned* MISC; gu32* ctl;
    int tid, lane, wave, vcu, G;
    unsigned char* ws; float* out;
};
__device__ __forceinline__ float wave_sum(float v) {
#pragma unroll
    for (int o = 1; o < 64; o <<= 1) v += __shfl_xor(v, o);
    return v;
}
__device__ __forceinline__ float wave_max(float v) {
#pragma unroll
    for (int o = 1; o < 64; o <<= 1) v = fmaxf(v, __shfl_xor(v, o));
    return v;
}

constexpr int CKB = 64;
constexpr int CONV_LDS = 64 * 144;
__device__ __forceinline__ void conv_item(const float* srcl, int ldn, int k0, const float* ks, bf16* dst0  , int K, LAS unsigned char* scr, int lane) {
    float v[CKB];
    { const float* q = srcl + (size_t)k0 * ldn;
#pragma unroll
      for (int i = 0; i < CKB; ++i) { if ((i & 7) == 0) asm volatile("" : "+v"(q)); v[i] = __builtin_nontemporal_load(q + (size_t)(i & 7) * ldn); if ((i & 7) == 7) q += (size_t)8 * ldn; } }
    if (ks) {
#pragma unroll
        for (int i = 0; i < CKB; ++i) v[i] *= ks[k0 + i]; }
#pragma unroll
    for (int j = 0; j < CKB / 8; ++j) { v4u o; o.x = pg8::cvt_pk_bf16(v[8 * j], v[8 * j + 1]); o.y = pg8::cvt_pk_bf16(v[8 * j + 2], v[8 * j + 3]); o.z = pg8::cvt_pk_bf16(v[8 * j + 4], v[8 * j + 5]); o.w = pg8::cvt_pk_bf16(v[8 * j + 6], v[8 * j + 7]);
        *(LAS v4u*)(scr + lane * 144 + j * 16) = o; }
    asm volatile("s_waitcnt lgkmcnt(0)" ::: "memory");
#pragma unroll
    for (int i = 0; i < 8; ++i) { const int row = 8 * i + (lane >> 3), ch = lane & 7; const v4u o = *(const LAS v4u*)(scr + row * 144 + ch * 16);
        *(GAS v4u*)(dst0 + (size_t)row * K + ch * 8) = o; }
    asm volatile("s_waitcnt lgkmcnt(0)" ::: "memory");
}
__device__ __forceinline__ void conv_plain(const float* W, int K, int N, const float* ks_lo, const float* ks_hi, bf16* WT, int item, int lane, LAS unsigned char* scr) {
    const int nblk = N / 64, kb = item / nblk, nb = item % nblk, k0 = CKB * kb;
    const float* ks = ks_lo ? (k0 < 512 || !ks_hi ? ks_lo : ks_hi - 512) : nullptr;
    conv_item(W + 64 * nb + lane, N, k0, ks, WT + (size_t)(64 * nb) * K + k0, K, scr, lane);
}
__device__ __forceinline__ void conv_inproj(const float* W, const float* ks, bf16* WT, int item, int lane, LAS unsigned char* scr) {
    const int nblk = INW / 64, kb = item / nblk, db = item % nblk, drow = 64 * db + lane, pn = drow >> 8, bj = (drow >> 7) & 1, wc = (drow >> 5) & 3, i = drow & 31;
    conv_item(W + 256 * pn + 64 * wc + 32 * bj + i, INW, CKB * kb, ks, WT + (size_t)(64 * db) * D + CKB * kb, D, scr, lane);
}
__device__ __forceinline__ void conv_gu(const float* Wg, const float* Wu, const float* ks, bf16* WT, int item, int lane, LAS unsigned char* scr) {
    const int nblk = 2 * FF / 64, kb = item / nblk, db = item % nblk, drow = 64 * db + lane, pn = drow >> 8, bj = (drow >> 7) & 1, r = drow & 127;
    conv_item((bj ? Wu : Wg) + 128 * pn + r, FF, CKB * kb, ks, WT + (size_t)(64 * db) * D + CKB * kb, D, scr, lane);
}

constexpr int IT_IN = (D / CKB) * (INW / 64), IT_GLU = (SW / CKB) * (SW / 64), IT_WO = (D / CKB) * (D / 64), IT_L = IT_IN + IT_GLU + IT_WO;
constexpr int IT_GU = (D / CKB) * (2 * FF / 64), IT_DN = (FF / CKB) * (D / 64);
constexpr int IT_P0 = 2 * IT_L;
constexpr int IT_BG = IT_GU + IT_DN + NE * IT_GU;
#ifndef BGQ
#define BGQ 3000, 0, 2400, 3000, 0, 2400
#endif
constexpr int BG_Q[6] = {BGQ};
constexpr int BG_B1 = BG_Q[0], BG_B2 = BG_B1 + BG_Q[1], BG_B3 = BG_B2 + BG_Q[2], BG_B4 = BG_B3 + BG_Q[3], BG_B5 = BG_B4 + BG_Q[4], BG_B6 = BG_B5 + BG_Q[5];
static_assert(BG_B3 >= IT_GU + IT_DN && BG_B6 <= IT_BG, "dense FFN weights are needed right after slot 3");

__device__ __forceinline__ void p0_convert(Frame& F, const Args& a, int rank, int nranks) {
    LAS unsigned char* scr = F.lds + RING_OFF + F.wave * CONV_LDS;
    const int gw = rank * NWAVES + F.wave, NGW = nranks * NWAVES;
    for (int it = gw; it < IT_P0; it += NGW) {
        const int l = it / IT_L; int r = it - l * IT_L; unsigned char* wb = F.ws + WS_WSMALL + l * WSMALL_STRIDE;
        if (r < IT_IN) { conv_inproj(a.in[2] + (size_t)l * D * INW, a.in[1] + l * D, (bf16*)(wb + WS_WIN), r, F.lane, scr); continue; } r -= IT_IN;
        if (r < IT_GLU) { conv_plain(a.in[14] + (size_t)l * SW * SW, SW, SW, nullptr, nullptr, (bf16*)(wb + WS_WGLU), r, F.lane, scr); continue; } r -= IT_GLU;
        conv_plain(a.in[17] + (size_t)l * D * D, D, D, a.in[15] + l * AW, a.in[16] + l * SW, (bf16*)(wb + WS_WO), r, F.lane, scr);
    }
}
__device__ __forceinline__ void bg_convert(Frame& F, const Args& a, int lo, int hi, int rank, int nranks) {
    if (rank < 0) return;
    LAS unsigned char* scr = F.lds + RING_OFF + F.wave * CONV_LDS;
    for (int it = lo + rank * NWAVES + F.wave; it < hi; it += nranks * NWAVES) {
        int r = it;
        if (r < IT_GU) { conv_gu(a.in[19], a.in[20], a.in[18], (bf16*)(F.ws + WS_DGU), r, F.lane, scr); continue; } r -= IT_GU;
        if (r < IT_DN) { conv_plain(a.in[21], FF, D, nullptr, nullptr, (bf16*)(F.ws + WS_DD), r, F.lane, scr); continue; } r -= IT_DN;
        { const int e = r / IT_GU; r -= e * IT_GU;
          conv_gu(a.in[23] + (size_t)e * D * FF, a.in[24] + (size_t)e * D * FF, a.in[18] + D, (bf16*)(F.ws + WS_MOEW) + (size_t)e * 2 * FF * D, r, F.lane, scr); }
    }
}
__device__ __forceinline__ void moe_wd_convert(Frame& F, const Args& a) {
    LAS unsigned char* scr = F.lds + RING_OFF + F.wave * CONV_LDS;
    const int gw = F.vcu * NWAVES + F.wave, NGW = F.G * NWAVES;
    for (int it = gw; it < NE * IT_DN; it += NGW) { const int e = it / IT_DN, r = it % IT_DN;
        conv_plain(a.in[25] + (size_t)e * FF * D, FF, D, nullptr, nullptr, (bf16*)(F.ws + WS_WDT + (size_t)(e < 7 ? 4 * e : WDT_E7) * WDT_TILEB), r, F.lane, scr); }
}
__device__ __forceinline__ void conv_load2(const float* srcl, int ldn, int k0, float (&v)[CKB]) {
    const float* q = srcl + (size_t)k0 * ldn;
#pragma unroll
    for (int i = 0; i < CKB; ++i) { if ((i & 7) == 0) asm volatile("" : "+v"(q)); v[i] = __builtin_nontemporal_load(q + (size_t)(i & 7) * ldn); if ((i & 7) == 7) q += (size_t)8 * ldn; }
}
__device__ __forceinline__ void conv_store2(float (&v)[CKB], const float* ks, int k0, bf16* dst0, int K, LAS unsigned char* scr, int lane) {
    if (ks) {
#pragma unroll
        for (int i = 0; i < CKB; ++i) v[i] *= ks[k0 + i]; }
#pragma unroll
    for (int j = 0; j < CKB / 8; ++j) { v4u o; o.x = pg8::cvt_pk_bf16(v[8 * j], v[8 * j + 1]); o.y = pg8::cvt_pk_bf16(v[8 * j + 2], v[8 * j + 3]); o.z = pg8::cvt_pk_bf16(v[8 * j + 4], v[8 * j + 5]); o.w = pg8::cvt_pk_bf16(v[8 * j + 6], v[8 * j + 7]);
        *(LAS v4u*)(scr + lane * 144 + j * 16) = o; }
    asm volatile("s_waitcnt lgkmcnt(0)" ::: "memory");
#pragma unroll
    for (int i = 0; i < 8; ++i) { const int row = 8 * i + (lane >> 3), ch = lane & 7; const v4u o = *(const LAS v4u*)(scr + row * 144 + ch * 16);
        *(GAS v4u*)(dst0 + (size_t)row * K + ch * 8) = o; }
    asm volatile("s_waitcnt lgkmcnt(0)" ::: "memory");
}
struct CvI { const float* srcl; const float* ks; bf16* dst0; int ldn, k0, K; };
__device__ __forceinline__ CvI cvi_gu(const float* Wg, const float* Wu, const float* ks, bf16* WT, int item, int lane) {
    const int nblk = 2 * FF / 64, kb = item / nblk, db = item % nblk, drow = 64 * db + lane, pn = drow >> 8, bj = (drow >> 7) & 1, r = drow & 127;
    return CvI{(bj ? Wu : Wg) + 128 * pn + r, ks, WT + (size_t)(64 * db) * D + CKB * kb, FF, CKB * kb, D};
}
__device__ __forceinline__ CvI cvi_plain(const float* W, int K, int N, bf16* WT, int item, int lane) {
    const int nblk = N / 64, kb = item / nblk, nb = item % nblk, k0 = CKB * kb;
    return CvI{W + 64 * nb + lane, nullptr, WT + (size_t)(64 * nb) * K + k0, N, k0, K};
}
template <int WHICH> __device__ __forceinline__ void conv_run2(Frame& F, const Args& a, int first, int step, int hi) {
    LAS unsigned char* scr = F.lds + RING_OFF + F.wave * CONV_LDS;
    auto dec = [&](int it) {
        if (WHICH == 1) { const int e = it / IT_DN, r = it % IT_DN; return cvi_plain(a.in[25] + (size_t)e * FF * D, FF, D, (bf16*)(F.ws + WS_WDT + (size_t)(e < 7 ? 4 * e : WDT_E7) * WDT_TILEB), r, F.lane); }
        int r = it;
        if (r < IT_GU) return cvi_gu(a.in[19], a.in[20], a.in[18], (bf16*)(F.ws + WS_DGU), r, F.lane);
        r -= IT_GU;
        if (r < IT_DN) return cvi_plain(a.in[21], FF, D, (bf16*)(F.ws + WS_DD), r, F.lane);
        r -= IT_DN;
        const int e = r / IT_GU; r -= e * IT_GU;
        return cvi_gu(a.in[23] + (size_t)e * D * FF, a.in[24] + (size_t)e * D * FF, a.in[18] + D, (bf16*)(F.ws + WS_MOEW) + (size_t)e * 2 * FF * D, r, F.lane); };
    if (first >= hi) return;
    static_assert(BG_B6 >= IT_GU + IT_DN, "the left-over background items are all MoE gate|up items (row length FF)");
    constexpr int LDN = WHICH == 1 ? D : FF;
    float va[CKB], vb[CKB];
    CvI ca = dec(first), cb = ca; conv_load2(ca.srcl, LDN, ca.k0, va);
    for (int it = first;; ) {
        const bool nb = it + step < hi; if (nb) { cb = dec(it + step); conv_load2(cb.srcl, LDN, cb.k0, vb); }
        conv_store2(va, ca.ks, ca.k0, ca.dst0, ca.K, scr, F.lane); if (!nb) break; it += step;
        const bool na = it + step < hi; if (na) { ca = dec(it + step); conv_load2(ca.srcl, LDN, ca.k0, va); }
        conv_store2(vb, cb.ks, cb.k0, cb.dst0, cb.K, scr, F.lane); if (!na) break; it += step;
    }
}
__device__ __forceinline__ void p0_xb(Frame& F, const float* x, int rank, int nranks) {
    const int gw = rank * NWAVES + F.wave, NGW = nranks * NWAVES;
    bf16* XB = (bf16*)(F.ws + WS_XB); float* ssq = (float*)(F.ws + WS_SSQ_A);
    for (int m0 = gw * 4; m0 < T; m0 += NGW * 4) {
        f32x4 v[4][4];
#pragma unroll
        for (int r = 0; r < 4; ++r) { const GAS f32x4* xr = (const GAS f32x4*)(x + (size_t)(m0 + r) * D) + F.lane;
#pragma unroll
            for (int j = 0; j < 4; ++j) v[r][j] = __builtin_nontemporal_load(xr + 64 * j); }
#pragma unroll
        for (int r = 0; r < 4; ++r) { float s = 0.f; GAS unsigned long long* o8 = (GAS unsigned long long*)(XB + (size_t)(m0 + r) * D) + F.lane;
#pragma unroll
            for (int j = 0; j < 4; ++j) { const f32x4 w = v[r][j]; s += (w.x * w.x + w.y * w.y) + (w.z * w.z + w.w * w.w);
                o8[64 * j] = (unsigned long long)pk2(w.x, w.y) | ((unsigned long long)pk2(w.z, w.w) << 32); }
            s = wave_sum(s);
            if (F.lane < 16) ssq[(size_t)(m0 + r) * 16 + F.lane] = F.lane == 0 ? s : 0.f; }
    }
}
constexpr size_t SP_TOEP = 0  , SP_PW = 1 * MiB, SP_ACC = 2 * MiB, SP_AC64 = 2 * MiB + 16 * 1024, SP_WSTT = 4 * MiB, SP_WOUTT = 6 * MiB;
constexpr size_t WS_EB = 5 * MiB;
constexpr unsigned EB_TAG = 0x5EED0001u;
__device__ __forceinline__ void ssm_precompute(Frame& F, const Args& a, int l, int g) {
    LAS float* apr = (LAS float*)(F.lds + RING_OFF); LAS float* api = apr + 17 * 64; LAS float* bbr = api + 17 * 64; LAS float* bbi = bbr + 1024; LAS float* cr = bbi + 1024; LAS float* ci = cr + 1024; LAS float* KT = ci + 1024;
    unsigned char* sp = F.ws + WS_SSMPRE + l * SSMPRE_STRIDE;
    bf16* TOEP = (bf16*)(sp + SP_TOEP) + (size_t)g * 8192; bf16* WSTT = (bf16*)(sp + SP_WSTT) + (size_t)g * 32768; bf16* WOUTT = (bf16*)(sp + SP_WOUTT) + (size_t)g * 32768; float* AC = (float*)(sp + SP_ACC) + g * 128;
    const int lg = l * NG + g, tid = F.tid;
    __syncthreads();
    if (tid < 64) { const int n = tid;
        const double lr = a.in[6][lg * 64 + n], li = a.in[7][lg * 64 + n], dt = exp((double)a.in[8][lg]);
        const double mag = exp(lr * dt), ang = li * dt, a1r = mag * cos(ang), a1i = mag * sin(ang);
        double pr = 1.0, pi = 0.0, a16r = 0.0, a16i = 0.0;
        for (int tau = 0; tau <= 16; ++tau) { apr[tau * 64 + n] = (float)pr; api[tau * 64 + n] = (float)pi; if (tau == 16) { a16r = pr; a16i = pi; } const double qr = pr * a1r - pi * a1i, qi = pr * a1i + pi * a1r; pr = qr; pi = qi; }
        { float* PW = (float*)(sp + SP_PW) + (size_t)g * 8192; float* AC64 = (float*)(sp + SP_AC64) + g * 128; double qr = 1.0, qi = 0.0;
          for (int c = 0; c < 64; ++c) { PW[(c * 64 + n) * 2] = (float)qr; PW[(c * 64 + n) * 2 + 1] = (float)qi; const double tr = qr * a16r - qi * a16i, ti = qr * a16i + qi * a16r; qr = tr; qi = ti; }
          AC64[n] = (float)qr; AC64[64 + n] = (float)qi; }
        const double nr = a1r - 1.0, den = lr * lr + li * li, fre = (nr * lr + a1i * li) / den, fim = (a1i * lr - nr * li) / den;
        for (int c = 0; c < 16; ++c) { const double br = a.in[9][(size_t)(lg * 64 + n) * 16 + c], bi = a.in[10][(size_t)(lg * 64 + n) * 16 + c];
            bbr[n * 16 + c] = (float)(fre * br - fim * bi); bbi[n * 16 + c] = (float)(fre * bi + fim * br); }
        AC[n] = apr[16 * 64 + n]; AC[64 + n] = api[16 * 64 + n];
    }
    for (int o = tid; o < 1024; o += 512) { cr[o] = a.in[11][(size_t)lg * 1024 + o]; ci[o] = a.in[12][(size_t)lg * 1024 + o]; }
    __syncthreads();
    {
        const int co = tid >> 5, c = (tid >> 1) & 15, th = tid & 1; float acc8[8];
#pragma unroll
        for (int q = 0; q < 8; ++q) acc8[q] = 0.f;
        for (int n = 0; n < 64; ++n) { const float c_r = cr[co * 64 + n], c_i = ci[co * 64 + n], br = bbr[n * 16 + c], bi = bbi[n * 16 + c];
            const float xr = c_r * br - c_i * bi, xi = c_r * bi + c_i * br;
#pragma unroll
            for (int q = 0; q < 8; ++q) { const int tau = 8 * th + q; acc8[q] += xr * apr[tau * 64 + n] - xi * api[tau * 64 + n]; } }
#pragma unroll
        for (int q = 0; q < 8; ++q) { const int tau = 8 * th + q; float sv = acc8[q]; if (tau == 0 && co == c) sv += a.in[13][l * SW + g * 16 + co]; KT[tau * 256 + co * 16 + c] = sv; }
    }
    __syncthreads();
    for (int o = tid; o < 4096; o += 512) {
        const int col = 224 + (o >> 7), k = (o & 127) * 2, t = col >> 4, co = col & 15, s0 = k >> 4, c0 = k & 15;
        const float v0 = t >= s0 ? KT[(t - s0) * 256 + co * 16 + c0] : 0.f, v1 = t >= s0 ? KT[(t - s0) * 256 + co * 16 + c0 + 1] : 0.f;
        *(unsigned*)(TOEP + (size_t)((((k >> 4) * 64) + ((k >> 3) & 1) * 32 + (col - 224)) * 8 + (k & 7))) = pk2(v0, v1); }
    for (int o = tid; o < 16384; o += 512) {
        const int n2 = o >> 7, k = (o & 127) * 2, n = n2 & 63, sidx = k >> 4, c0 = k & 15; float v[2];
#pragma unroll
        for (int q = 0; q < 2; ++q) { const float pr = apr[(15 - sidx) * 64 + n], pi = api[(15 - sidx) * 64 + n], br = bbr[n * 16 + c0 + q], bi = bbi[n * 16 + c0 + q]; v[q] = (n2 < 64) ? (pr * br - pi * bi) : (pr * bi + pi * br); }
        *(unsigned*)(WSTT + (size_t)(((((n2 >> 5) * 16 + (k >> 4)) * 64) + ((k >> 3) & 1) * 32 + (n2 & 31)) * 8 + (k & 7))) = pk2(v[0], v[1]); }
    for (int o = tid; o < 16384; o += 512) {
        const int col = o >> 6, n = o & 63, tl = col >> 4, co = col & 15;
        const float pr = apr[(tl + 1) * 64 + n], pi = api[(tl + 1) * 64 + n], c_r = cr[co * 64 + n], c_i = ci[co * 64 + n];
        { const int k = 2 * n; *(unsigned*)(WOUTT + (size_t)(((((col >> 5) * 8 + (k >> 4)) * 64) + ((k >> 3) & 1) * 32 + (col & 31)) * 8 + (k & 7))) = pk2(c_r * pr - c_i * pi, -(c_r * pi + c_i * pr)); } }
    __syncthreads();
}

namespace att {
typedef short bf16x8 __attribute__((ext_vector_type(8)));
typedef short s16x4 __attribute__((ext_vector_type(4)));
typedef short v4i16_t __attribute__((ext_vector_type(4)));
typedef float f32x16 __attribute__((ext_vector_type(16)));
typedef unsigned u32x4 __attribute__((ext_vector_type(4)));
typedef __attribute__((address_space(3))) const char* lds_cptr;
constexpr int SLOTB = 8192, BUFB = 6 * SLOTB, LDS_K = 0, LDS_V = 3 * SLOTB, LDS_WS = 2 * BUFB, LDS_OST = LDS_WS + 8 * 64 * 4, LDS_TOTAL = LDS_OST + 8 * 2048;
static_assert(LDS_TOTAL <= RING_BYTES, "attention LDS");
__device__ __forceinline__ int crow(int r, int hi) { return (r & 3) + 8 * (r >> 2) + 4 * hi; }
__device__ __forceinline__ void glds16(const void* gsrc, unsigned lds_dst) { unsigned keep;
    asm volatile("s_mov_b32 %0, m0\n\ts_mov_b32 m0, %2\n\ts_nop 0\n\tglobal_load_lds_dwordx4 %1, off\n\ts_mov_b32 m0, %0" : "=&s"(keep) : "v"(gsrc), "s"(lds_dst) : "memory"); }
typedef float f32x2_t __attribute__((ext_vector_type(2))); typedef __bf16 bf16x2_t __attribute__((ext_vector_type(2)));
__device__ __forceinline__ unsigned cvtpk(float lo, float hi) { f32x2_t v = {lo, hi}; bf16x2_t b = __builtin_convertvector(v, bf16x2_t); return __builtin_bit_cast(unsigned, b); }
__device__ __forceinline__ s16x4 vtr(lds_cptr p) { return __builtin_bit_cast(s16x4, __builtin_amdgcn_ds_read_tr16_b64_v4i16((__attribute__((address_space(3))) v4i16_t*)p)); }
__device__ __forceinline__ float xhalf_max(float m) { auto rr = __builtin_amdgcn_permlane32_swap(__float_as_uint(m), __float_as_uint(m), false, false); return fmaxf(__uint_as_float(rr[0]), __uint_as_float(rr[1])); }
__device__ __forceinline__ float xhalf_sum(float m) { auto rr = __builtin_amdgcn_permlane32_swap(__float_as_uint(m), __float_as_uint(m), false, false); return __uint_as_float(rr[0]) + __uint_as_float(rr[1]); }

struct Ctx { int tid, lane, r32, hi, wid; };
__device__ __forceinline__ void attn_issue(const Ctx& c, int u, int buf, const bf16* QKVU, LAS unsigned char* shm, bf16x8 (&qn)[4]) {
    const int qb = u % (SEQ / 64), kvh = (u / (SEQ / 64)) % NKV, b = u / (NKV * (SEQ / 64));
    const int h = kvh * 4 + (c.wid >> 1), q0 = qb * 64, qw = q0 + 32 * (c.wid & 1);
    const size_t rowbase = (size_t)b * SEQ; const unsigned lds0 = (unsigned)(uintptr_t)shm + buf * BUFB;
#pragma unroll
    for (int j = 0; j < 3; ++j) {
        const int kv0 = q0 - 128 + 64 * j;
        int kr = kv0 + c.lane; kr = kr < 0 ? 0 : kr;
        int vr = kv0 + 16 * (c.wid & 3) + (c.lane >> 2); vr = vr < 0 ? 0 : vr;
        glds16(QKVU + (rowbase + kr) * INW + KOFF + kvh * 64 + c.wid * 8, (unsigned)__builtin_amdgcn_readfirstlane(lds0 + LDS_K + j * SLOTB + c.wid * 1024));
        glds16(QKVU + (rowbase + vr) * INW + VOFF + kvh * 64 + (c.wid >> 2) * 32 + (c.lane & 3) * 8, (unsigned)__builtin_amdgcn_readfirstlane(lds0 + LDS_V + j * SLOTB + c.wid * 1024));
    }
    const bf16* qp = QKVU + (rowbase + qw + c.r32) * INW + QOFF + h * 64 + c.hi * 8;
#pragma unroll
    for (int d0 = 0; d0 < 4; ++d0) qn[d0] = *(const bf16x8*)(qp + d0 * 16);
}
__device__ __forceinline__ void attn_compute(const Ctx& c, int u, int buf, const bf16x8 (&qr)[4], bf16* MIX, float* ssq, const float* sinks, LAS unsigned char* shm0) {
    const int lane = c.lane, r32 = c.r32, hi = c.hi, wid = c.wid;
    const int qb = u % (SEQ / 64), kvh = (u / (SEQ / 64)) % NKV, b = u / (NKV * (SEQ / 64));
    const int h = kvh * 4 + (wid >> 1), qsub = wid & 1, q0 = qb * 64, qw = q0 + 32 * qsub;
    const size_t rowbase = (size_t)b * SEQ;
    LAS unsigned char* shm = shm0 + buf * BUFB;
    const float sink2 = sinks[h] * LOG2E;
    f32x16 p[5];
    const lds_cptr kbase = (lds_cptr)shm + LDS_K + hi * 1024 + r32 * 16;
#pragma unroll
    for (int hb = 0; hb < 5; ++hb) {
        const int G = qsub + hb;
        const lds_cptr kp = kbase + (G >> 1) * SLOTB + (G & 1) * 512;
        f32x16 acc = {};
#pragma unroll
        for (int d0 = 0; d0 < 4; ++d0) { const bf16x8 kf = *(const __attribute__((address_space(3))) bf16x8*)(kp + d0 * 2048); acc = __builtin_amdgcn_mfma_f32_32x32x16_bf16(kf, qr[d0], acc, 0, 0, 0); }
        p[hb] = acc;
    }
    const float NEG = -1.0e30f;
#pragma unroll
    for (int r = 0; r < 16; ++r) { const int cr_ = crow(r, hi); if (!(r32 < cr_)) p[0][r] = NEG; if (!(cr_ <= r32)) p[4][r] = NEG; }
    if (q0 < 128) {
#pragma unroll
        for (int hb = 0; hb < 5; ++hb)
#pragma unroll
            for (int r = 0; r < 16; ++r) { if (qw - 128 + 32 * hb + crow(r, hi) < 0) p[hb][r] = NEG; }
    }
    float m = sink2;
#pragma unroll
    for (int hb = 0; hb < 5; ++hb)
#pragma unroll
        for (int r = 0; r < 16; ++r) m = fmaxf(m, p[hb][r]);
    m = xhalf_max(m);
    float lsum = 0.f;
#pragma unroll
    for (int hb = 0; hb < 5; ++hb)
#pragma unroll
        for (int r = 0; r < 16; ++r) { const float e = __builtin_amdgcn_exp2f(p[hb][r] - m); p[hb][r] = e; lsum += e; }
    lsum = xhalf_sum(lsum) + __builtin_amdgcn_exp2f(sink2 - m);
    f32x16 o[2]; o[0] = f32x16{}; o[1] = f32x16{};
    const lds_cptr vp0 = (lds_cptr)shm + LDS_V + ((lane >> 4) & 1) * 32 + (lane & 3) * 8 + (4 * hi + ((lane & 15) >> 2)) * 64;
#pragma unroll
    for (int hb = 0; hb < 5; ++hb) {
#pragma unroll
        for (int kk = 0; kk < 2; ++kk) {
            const int ko = 32 * (qsub + hb) + 16 * kk, j = ko >> 6, ks = (ko >> 4) & 3;
            u32x4 pw; pw.x = cvtpk(p[hb][8 * kk + 0], p[hb][8 * kk + 1]); pw.y = cvtpk(p[hb][8 * kk + 2], p[hb][8 * kk + 3]); pw.z = cvtpk(p[hb][8 * kk + 4], p[hb][8 * kk + 5]); pw.w = cvtpk(p[hb][8 * kk + 6], p[hb][8 * kk + 7]);
            const bf16x8 pa = __builtin_bit_cast(bf16x8, pw);
#pragma unroll
            for (int d0 = 0; d0 < 2; ++d0) {
                const lds_cptr vp = vp0 + j * SLOTB + d0 * 4096 + ks * 1024;
                const s16x4 lo = vtr(vp), hh = vtr(vp + 512);
                const bf16x8 vf = (bf16x8){lo[0], lo[1], lo[2], lo[3], hh[0], hh[1], hh[2], hh[3]};
                o[d0] = __builtin_amdgcn_mfma_f32_32x32x16_bf16(pa, vf, o[d0], 0, 0, 0);
            }
        }
    }
    LAS float* wsf = (LAS float*)(shm0 + LDS_WS) + wid * 64;
    if (hi == 0) wsf[r32] = lsum;
    asm volatile("s_waitcnt lgkmcnt(0)" ::: "memory");
    float rli[16];
#pragma unroll
    for (int r = 0; r < 16; ++r) rli[r] = __builtin_amdgcn_rcpf(wsf[crow(r, hi)]);
    LAS bf16* stg = (LAS bf16*)(shm0 + LDS_OST) + wid * 1024;
    bf16* Ow = MIX + (rowbase + qw) * D + h * 64;
    float ssrow[2] = {0.f, 0.f};
#pragma unroll
    for (int d0 = 0; d0 < 2; ++d0) {
#pragma unroll
        for (int r = 0; r < 16; ++r) stg[crow(r, hi) * 32 + r32] = (bf16)pg8::cvt_pk_bf16(o[d0][r] * rli[r], 0.f);
        asm volatile("s_waitcnt lgkmcnt(0)" ::: "memory");
#pragma unroll
        for (int i = 0; i < 2; ++i) { const int row = i * 16 + (lane >> 2), ch = lane & 3; const u32x4 v = *(const LAS u32x4*)(stg + row * 32 + ch * 8);
            *(u32x4*)(Ow + (size_t)row * D + d0 * 32 + ch * 8) = v;
            const unsigned w4[4] = {v.x, v.y, v.z, v.w};
#pragma unroll
            for (int k = 0; k < 4; ++k) { const float a = pg8::bf_lo(w4[k]), cc = pg8::bf_hi(w4[k]); ssrow[i] += a * a + cc * cc; } }
        asm volatile("s_waitcnt lgkmcnt(0)" ::: "memory");
    }
#pragma unroll
    for (int i = 0; i < 2; ++i) { float ss = ssrow[i]; ss += __shfl_xor(ss, 1); ss += __shfl_xor(ss, 2); if ((lane & 3) == 0) ssq[(rowbase + qw + i * 16 + (lane >> 2)) * 8 + h] = ss; }
}
}
__device__ __forceinline__ void attn_phase_v1(Frame& F, const Args& a, int l, int first, int count) {
    const int me = (int)blockIdx.x - first; if (me < 0 || me >= count) return;
    const bf16* QKVU = (const bf16*)(F.ws + WS_QKVU); bf16* MIX = (bf16*)(F.ws + WS_MIX); float* ssq = (float*)(F.ws + WS_SSQ_ATT);
    att::Ctx c; { int tid_ = F.tid; asm volatile("" : "+v"(tid_)); c.tid = tid_; c.lane = tid_ & 63; c.r32 = c.lane & 31; c.hi = c.lane >> 5; c.wid = __builtin_amdgcn_readfirstlane(tid_ >> 6); }
    constexpr int NU = BATCH * NKV * (SEQ / 64);
    att::bf16x8 qr[4], qn[4];
    int u = me, it = 0;
    if (u >= NU) return;
    asm volatile("s_waitcnt lgkmcnt(0)\n\ts_barrier" ::: "memory");
    att::attn_issue(c, u, 0, QKVU, F.lds + RING_OFF, qr);
    for (; u < NU; u += count, ++it) {
        const bool has_next = u + count < NU;
        if (has_next) att::attn_issue(c, u + count, (it + 1) & 1, QKVU, F.lds + RING_OFF, qn);
        if (has_next && it > 0) asm volatile("s_waitcnt vmcnt(14)" ::: "memory"); else if (has_next) asm volatile("s_waitcnt vmcnt(10)" ::: "memory"); else asm volatile("s_waitcnt vmcnt(0)" ::: "memory");
        asm volatile("s_barrier" ::: "memory");
        att::attn_compute(c, u, it & 1, qr, MIX, ssq, a.in[5] + l * NH, F.lds + RING_OFF);
        asm volatile("s_waitcnt lgkmcnt(0)\n\ts_barrier" ::: "memory");
#pragma unroll
        for (int d0 = 0; d0 < 4; ++d0) qr[d0] = qn[d0];
    }
}

__device__ __forceinline__ float gelu_tanh(float y) {
    const float t = y * (2.0f * 0.7978845608028654f * LOG2E + (2.0f * 0.7978845608028654f * 0.044715f * LOG2E) * y * y);
    return y - y * __builtin_amdgcn_rcpf(1.0f + __builtin_amdgcn_exp2f(t));
}
namespace ssm {
typedef short bf16x8 __attribute__((ext_vector_type(8)));
typedef float f32x16 __attribute__((ext_vector_type(16)));
constexpr int UST = 528, UBUF = 64 * UST, HST = 272;
constexpr int L_U = 0, L_SL = 2 * UBUF, L_HB = L_SL  , L_TF = L_SL + 64 * 128 * 4, L_END = L_TF + 19 * 1024;
static_assert(L_END <= RING_BYTES, "ssm LDS");
__device__ __forceinline__ int crow(int r, int hi) { return (r & 3) + 8 * (r >> 2) + 4 * hi; }
constexpr int M_U = 0, M_SL = UBUF, M_HB = M_SL + 64 * 128 * 4, M_TF = M_HB + 64 * HST, M_HIN = M_TF + 19 * 1024, M_END = M_HIN + 512;
static_assert(M_END <= RING_BYTES, "ssm LDS (decoupled)");
typedef __attribute__((address_space(1))) unsigned long long gu64s;
__device__ __forceinline__ void ssm_job2(int bg, int sb, int l, unsigned char* ws, LAS unsigned char* shm) {
    int tid_ = threadIdx.x; asm volatile("" : "+v"(tid_));
    const int tid = tid_, lane = tid & 63, r32 = lane & 31, hi = lane >> 5; const int w = __builtin_amdgcn_readfirstlane(tid >> 6);
    const int b = bg / NG, g = bg % NG;
    const bf16* UGp = (const bf16*)(ws + WS_UG); bf16* YG = (bf16*)(ws + WS_YG);
    unsigned char* sp = ws + WS_SSMPRE + l * SSMPRE_STRIDE;
    const bf16* TOEP = (const bf16*)(sp + SP_TOEP) + (size_t)g * 8192; const bf16* WSTT = (const bf16*)(sp + SP_WSTT) + (size_t)g * 32768; const bf16* WOUTT = (const bf16*)(sp + SP_WOUTT) + (size_t)g * 32768;
    const float* AC = (const float*)(sp + SP_ACC) + g * 128; const float* AC64 = (const float*)(sp + SP_AC64) + g * 128; const float* PW = (const float*)(sp + SP_PW) + (size_t)g * 8192;
    gu64s* eb = (gu64s*)(ws + WS_EB) + (size_t)((l * 64 + bg) * 8) * 128;
    const int mt1 = w >> 2, nt1 = w & 3;
    const int J = w < 4 ? w : 11 - w, ns = 2 * J + 2;
    const size_t rowb = (size_t)b * SEQ + (size_t)sb * 1024;
    v4u up[4];
#pragma unroll
    for (int i = 0; i < 4; ++i) { const int pi = tid + 512 * i; up[i] = *(const v4u*)(UGp + ((size_t)g * T + rowb) * GD + (size_t)pi * 8); }
    bf16x8 tfr[2];
#pragma unroll
    for (int i = 0; i < 2; ++i) tfr[i] = *(const bf16x8*)(TOEP + (size_t)((2 * w + i) * 64 + lane) * 8);
    float2 pwv[8];
#pragma unroll
    for (int i = 0; i < 8; ++i) pwv[i] = *(const float2*)(PW + (size_t)(((tid >> 6) + 8 * i) * 64 + (tid & 63)) * 2);
    const float acr = AC[lane], aci = AC[64 + lane], a64r = AC64[lane], a64i = AC64[64 + lane];
    bf16x8 bw1[16], bc[8];
#pragma unroll
    for (int ks = 0; ks < 16; ++ks) bw1[ks] = *(const bf16x8*)(WSTT + (size_t)((nt1 * 16 + ks) * 64 + lane) * 8);
#pragma unroll
    for (int ks = 0; ks < 8; ++ks) bc[ks] = *(const bf16x8*)(WOUTT + (size_t)((J * 8 + ks) * 64 + lane) * 8);
#pragma unroll
    for (int i = 0; i < 4; ++i) { const int pi = tid + 512 * i, row = pi >> 1; *(LAS v4u*)(shm + M_U + (row >> 4) * UST + (row & 15) * 32 + (pi & 1) * 16) = up[i]; }
#pragma unroll
    for (int i = 0; i < 2; ++i) *(LAS bf16x8*)(shm + M_TF + (2 * w + i) * 1024 + lane * 16) = tfr[i];
    if (w < 3) { unsigned z0, z1, z2, z3; asm volatile("v_mov_b32 %0, 0\n\tv_mov_b32 %1, 0\n\tv_mov_b32 %2, 0\n\tv_mov_b32 %3, 0" : "=v"(z0), "=v"(z1), "=v"(z2), "=v"(z3));
        *(LAS v4u*)(shm + M_TF + (16 + w) * 1024 + lane * 16) = (v4u){z0, z1, z2, z3}; }
    asm volatile("s_waitcnt lgkmcnt(0)\n\ts_barrier" ::: "memory");
    const LAS unsigned char* ub = shm + M_U + hi * 16;
    {
        f32x16 acc = {};
#pragma unroll
        for (int ks = 0; ks < 16; ++ks) { const bf16x8 af = *(const LAS bf16x8*)(ub + (32 * mt1 + r32) * UST + ks * 32); acc = __builtin_amdgcn_mfma_f32_32x32x16_bf16(af, bw1[ks], acc, 0, 0, 0); }
        LAS float* sl = (LAS float*)(shm + M_SL);
#pragma unroll
        for (int r = 0; r < 16; ++r) sl[(32 * mt1 + crow(r, hi)) * 128 + 32 * nt1 + r32] = acc[r];
    }
    asm volatile("s_waitcnt lgkmcnt(0)\n\ts_barrier" ::: "memory");
    if (w == 0) {
        LAS float* sl = (LAS float*)(shm + M_SL);
        float pwr[4], pwi[4]; pwr[0] = acr; pwi[0] = aci;
#pragma unroll
        for (int j = 1; j < 4; ++j) { pwr[j] = pwr[j - 1] * acr - pwi[j - 1] * aci; pwi[j] = pwr[j - 1] * aci + pwi[j - 1] * acr; }
        float hr = 0.f, hi_ = 0.f;
        for (int c0 = 0; c0 < 64; c0 += 16) {
            float sr[16], si[16];
#pragma unroll
            for (int i = 0; i < 16; ++i) { sr[i] = sl[(c0 + i) * 128 + lane]; si[i] = sl[(c0 + i) * 128 + 64 + lane]; }
            asm volatile("s_waitcnt lgkmcnt(0)" ::: "memory");
#pragma unroll
            for (int gq = 0; gq < 4; ++gq) {
                float tr[4], ti[4]; tr[0] = sr[4 * gq]; ti[0] = si[4 * gq];
#pragma unroll
                for (int j = 1; j < 4; ++j) { tr[j] = __builtin_fmaf(acr, tr[j - 1], __builtin_fmaf(-aci, ti[j - 1], sr[4 * gq + j])); ti[j] = __builtin_fmaf(acr, ti[j - 1], __builtin_fmaf(aci, tr[j - 1], si[4 * gq + j])); }
                sl[(c0 + 4 * gq) * 128 + lane] = hr; sl[(c0 + 4 * gq) * 128 + 64 + lane] = hi_;
#pragma unroll
                for (int j = 1; j < 4; ++j) { const float xr = __builtin_fmaf(pwr[j - 1], hr, __builtin_fmaf(-pwi[j - 1], hi_, tr[j - 1])), xi = __builtin_fmaf(pwr[j - 1], hi_, __builtin_fmaf(pwi[j - 1], hr, ti[j - 1]));
                    sl[(c0 + 4 * gq + j) * 128 + lane] = xr; sl[(c0 + 4 * gq + j) * 128 + 64 + lane] = xi; }
                const float nr = __builtin_fmaf(pwr[3], hr, __builtin_fmaf(-pwi[3], hi_, tr[3])), ni = __builtin_fmaf(pwr[3], hi_, __builtin_fmaf(pwi[3], hr, ti[3])); hr = nr; hi_ = ni;
            }
        }
        { unsigned tagv; asm volatile("v_mov_b32 %0, %1" : "=v"(tagv) : "s"(EB_TAG));
          __hip_atomic_store(eb + sb * 128 + lane, ((unsigned long long)tagv << 32) | __float_as_uint(hr), __ATOMIC_RELAXED, __HIP_MEMORY_SCOPE_AGENT);
          __hip_atomic_store(eb + sb * 128 + 64 + lane, ((unsigned long long)tagv << 32) | __float_as_uint(hi_), __ATOMIC_RELAXED, __HIP_MEMORY_SCOPE_AGENT); }
        float Hr = 0.f, Hi = 0.f;
        for (int sp_ = 0; sp_ < sb; ++sp_) {
            unsigned long long xr = 0, xi = 0;
            for (unsigned spins = 0;; ++spins) {
                xr = __hip_atomic_load(eb + sp_ * 128 + lane, __ATOMIC_RELAXED, __HIP_MEMORY_SCOPE_AGENT); xi = __hip_atomic_load(eb + sp_ * 128 + 64 + lane, __ATOMIC_RELAXED, __HIP_MEMORY_SCOPE_AGENT);
                const bool ok = (unsigned)(xr >> 32) == EB_TAG && (unsigned)(xi >> 32) == EB_TAG;
                if (__all(ok)) break;
                if (spins > (1u << 20)) break;
                __builtin_amdgcn_s_sleep(2);
            }
            const float er = __uint_as_float((unsigned)xr), ei = __uint_as_float((unsigned)xi);
            const float nr = __builtin_fmaf(a64r, Hr, __builtin_fmaf(-a64i, Hi, er)), ni = __builtin_fmaf(a64r, Hi, __builtin_fmaf(a64i, Hr, ei)); Hr = nr; Hi = ni;
        }
        LAS float* hin = (LAS float*)(shm + M_HIN); hin[lane] = Hr; hin[64 + lane] = Hi;
    }
    f32x16 acc2[2]; acc2[0] = f32x16{}; acc2[1] = f32x16{};
#pragma unroll
    for (int kb = 0; kb < 4; ++kb) { if (4 * kb < ns) {
        bf16x8 bf[4];
#pragma unroll
        for (int q = 0; q < 4; ++q) bf[q] = *(const LAS bf16x8*)(shm + M_TF + (14 - 2 * J + 4 * kb + q) * 1024 + lane * 16);
#pragma unroll
        for (int mt = 0; mt < 2; ++mt) { bf16x8 af[4];
#pragma unroll
            for (int q = 0; q < 4; ++q) af[q] = *(const LAS bf16x8*)(ub + (32 * mt + r32) * UST + (4 * kb + q) * 32);
#pragma unroll
            for (int q = 0; q < 4; ++q) acc2[mt] = __builtin_amdgcn_mfma_f32_32x32x16_bf16(af[q], bf[q], acc2[mt], 0, 0, 0); }
    } }
    asm volatile("s_waitcnt lgkmcnt(0)\n\ts_barrier" ::: "memory");
    {
        const int n = tid & 63, cq = tid >> 6; const LAS float* sl = (const LAS float*)(shm + M_SL); const LAS float* hin = (const LAS float*)(shm + M_HIN);
        const float Hr = hin[n], Hi = hin[64 + n];
#pragma unroll
        for (int i = 0; i < 8; ++i) { const int c = cq + 8 * i; const float2 pw = pwv[i];
            const float xr = sl[c * 128 + n] + pw.x * Hr - pw.y * Hi, xi = sl[c * 128 + 64 + n] + pw.x * Hi + pw.y * Hr;
            *(LAS unsigned*)(shm + M_HB + c * HST + n * 4) = pg8::cvt_pk_bf16(xr, xi); }
    }
    asm volatile("s_waitcnt lgkmcnt(0)\n\ts_barrier" ::: "memory");
#pragma unroll
    for (int ks = 0; ks < 8; ++ks) {
#pragma unroll
        for (int mt = 0; mt < 2; ++mt) { const bf16x8 af = *(const LAS bf16x8*)(shm + M_HB + (32 * mt + r32) * HST + ks * 32 + hi * 16); acc2[mt] = __builtin_amdgcn_mfma_f32_32x32x16_bf16(af, bc[ks], acc2[mt], 0, 0, 0); } }
    {   const int t = 2 * J + (r32 >> 4), co = r32 & 15;
#pragma unroll
        for (int mt = 0; mt < 2; ++mt)
#pragma unroll
            for (int r = 0; r < 16; ++r) { const int chunk = 32 * mt + crow(r, hi);
                YG[(rowb + (size_t)chunk * 16 + t) * SW + 16 * g + co] = (bf16)pg8::cvt_pk_bf16(gelu_tanh(acc2[mt][r]), 0.f); } }
    asm volatile("s_waitcnt lgkmcnt(0)\n\ts_barrier" ::: "memory");
}
}
__device__ __forceinline__ void ssm_phase_v2(Frame& F, int l) {
    for (int j = blockIdx.x; j < BATCH * NG * (SEQ / 1024); j += F.G) ssm::ssm_job2(j % (BATCH * NG), j / (BATCH * NG), l, F.ws, F.lds + RING_OFF);
}

__device__ __forceinline__ void route1(Frame& F, const Args& a) {
    LAS int* hl = (LAS int*)(F.lds + RING_OFF);
    unsigned char* rt = F.ws + WS_ROUTE; int* TOPE = (int*)(rt + RT_TOPE); float* TOPG = (float*)(rt + RT_TOPG); float* RINVT = (float*)(rt + RT_RINVT); int* HIST = (int*)(rt + RT_HIST);
    const float* wr = a.in[22]; const float* gn = a.in[18] + D;
    f32x4 w0[4][4], w1[4][4];
#pragma unroll
    for (int j = 0; j < 4; ++j)
#pragma unroll
        for (int q = 0; q < 4; ++q) { const int k = 4 * (F.lane + 64 * j) + q; const float g = gn[k]; w0[j][q] = *(const f32x4*)(wr + k * 8) * g; w1[j][q] = *(const f32x4*)(wr + k * 8 + 4) * g; }
    for (int blk = blockIdx.x; blk < T / 64; blk += F.G) {
        __syncthreads();
        if (F.tid < 8) hl[F.tid] = 0;
        __syncthreads();
        for (int ib = 0; ib < 8; ib += 2) {
            f32x4 xv4[2][4];
#pragma unroll
            for (int i = 0; i < 2; ++i) { const GAS unsigned long long* xr = (const GAS unsigned long long*)((const bf16*)(F.ws + WS_XB) + (size_t)(blk * 64 + F.wave * 8 + ib + i) * D) + F.lane;
#pragma unroll
                for (int j = 0; j < 4; ++j) { const unsigned long long w = xr[64 * j]; const unsigned lo = (unsigned)w, hi2 = (unsigned)(w >> 32); xv4[i][j] = (f32x4){pg8::bf_lo(lo), pg8::bf_hi(lo), pg8::bf_lo(hi2), pg8::bf_hi(hi2)}; } }
#pragma unroll
            for (int i = 0; i < 2; ++i) {
            const int t = blk * 64 + F.wave * 8 + ib + i;
            f32x4 la = {0.f, 0.f, 0.f, 0.f}, lb = {0.f, 0.f, 0.f, 0.f}; float ss = 0.f;
#pragma unroll
            for (int j = 0; j < 4; ++j) { const f32x4 v = xv4[i][j]; const float xv[4] = {v.x, v.y, v.z, v.w};
#pragma unroll
                for (int q = 0; q < 4; ++q) { ss += xv[q] * xv[q]; la += w0[j][q] * xv[q]; lb += w1[j][q] * xv[q]; } }
            ss = wave_sum(ss);
            float lg[8] = {la.x, la.y, la.z, la.w, lb.x, lb.y, lb.z, lb.w};
#pragma unroll
            for (int e = 0; e < 8; ++e) lg[e] = wave_sum(lg[e]);
            const float rinv = 1.0f / sqrtf(ss * (1.0f / D) + EPS);
            int e1 = 0; float l1 = lg[0];
#pragma unroll
            for (int e = 1; e < 8; ++e) if (lg[e] > l1) { l1 = lg[e]; e1 = e; }
            int e2 = -1; float l2 = -3.0e38f;
#pragma unroll
            for (int e = 0; e < 8; ++e) if (e != e1 && lg[e] > l2) { l2 = lg[e]; e2 = e; }
            const float g2 = 1.0f / (1.0f + __expf((l1 - l2) * rinv)), g1 = 1.0f - g2;
            if (F.lane == 0) { TOPE[t * 2] = e1; TOPE[t * 2 + 1] = e2; TOPG[t * 2] = g1; TOPG[t * 2 + 1] = g2; RINVT[t] = rinv; atomicAdd((int*)&hl[e1], 1); atomicAdd((int*)&hl[e2], 1); }
            }
        }
        __syncthreads();
        if (F.tid < 8) HIST[blk * 8 + F.tid] = hl[F.tid];
    }
    __syncthreads();
}
__device__ __forceinline__ void route2(Frame& F) {
    LAS int* sb = (LAS int*)(F.lds + RING_OFF);
    unsigned char* rt = F.ws + WS_ROUTE; const int* TOPE = (const int*)(rt + RT_TOPE); const float* TOPG = (const float*)(rt + RT_TOPG); const float* RINVT = (const float*)(rt + RT_RINVT); const int* HIST = (const int*)(rt + RT_HIST);
    int* IDX = (int*)(rt + RT_IDX); float* GATE = (float*)(rt + RT_GATE); float* RINVS = (float*)(rt + RT_RINVS); int* POS = (int*)(rt + RT_POS); int* PEND = (int*)(rt + RT_PEND);
    for (int blk = blockIdx.x; blk < T / 64; blk += F.G) {
        __syncthreads();
        if (F.tid < 16) sb[F.tid] = 0;
        __syncthreads();
        if (F.tid < T / 64) {
            const int4 h0 = *(const int4*)(HIST + F.tid * 8), h1 = *(const int4*)(HIST + F.tid * 8 + 4); const int hv[8] = {h0.x, h0.y, h0.z, h0.w, h1.x, h1.y, h1.z, h1.w};
#pragma unroll
            for (int e = 0; e < 8; ++e) { atomicAdd((int*)&sb[e], hv[e]); if (F.tid < blk) atomicAdd((int*)&sb[8 + e], hv[e]); }
        }
        __syncthreads();
        if (F.tid == 0) { int ps = 0; for (int e = 0; e < 8; ++e) { const int pd = (sb[e] + 255) & ~255; sb[16 + e] = ps; sb[24 + e] = pd; ps += pd; if (blk == 0) PEND[e] = ps >> 8; } }
        __syncthreads();
        if (F.wave == 0) {
            const int t = blk * 64 + F.lane; int run[8];
#pragma unroll
            for (int e = 0; e < 8; ++e) run[e] = sb[16 + e] + sb[8 + e];
#pragma unroll
            for (int k = 0; k < 2; ++k) { const int e = TOPE[t * 2 + k]; int slot = 0;
#pragma unroll
                for (int ee = 0; ee < 8; ++ee) { const unsigned long long mk = __ballot(e == ee); const int below = __popcll(mk & ((1ull << F.lane) - 1ull));
                    if (e == ee) slot = run[ee] + below; run[ee] += __popcll(mk); }
                IDX[slot] = t; GATE[slot] = TOPG[t * 2 + k]; RINVS[slot] = RINVT[t]; POS[t * 2 + k] = slot; }
        }
        if (blk == 0) {
            for (int e = 0; e < 8; ++e) { const int s0 = sb[16 + e] + sb[e], s1 = sb[16 + e] + sb[24 + e]; for (int s = s0 + F.tid; s < s1; s += 512) { IDX[s] = 0; GATE[s] = 0.f; RINVS[s] = 0.f; } }
        }
    }
    __syncthreads();
}
__device__ __forceinline__ void moe_combine(Frame& F) {
    const bf16* YS = (const bf16*)(F.ws + WS_YS); const int* POS = (const int*)(F.ws + WS_ROUTE + RT_POS); const float* GATE = (const float*)(F.ws + WS_ROUTE + RT_GATE);
    const unsigned* TM = (const unsigned*)(F.ws + WS_CTL) + CW_TAILMAP; const float* SLAB = (const float*)(F.ws + WS_SLAB);
    const int S = pg8::ks_slices(((const int*)(F.ws + WS_ROUTE + RT_PEND))[7] * (D / 256), F.G);
    const int gw = F.vcu * NWAVES + F.wave, NGW = F.G * NWAVES;
    for (int t = gw; t < T; t += NGW) {
        const int p0 = POS[t * 2], p1 = POS[t * 2 + 1];
        const v4u tm0 = *(const v4u*)(TM + (p0 >> 8) * 4), tm1 = *(const v4u*)(TM + (p1 >> 8) * 4);
        GAS f32x4* xr = (GAS f32x4*)(F.out + (size_t)t * D) + F.lane;
        const GAS unsigned long long* xb = (const GAS unsigned long long*)((const bf16*)(F.ws + WS_XB) + (size_t)t * D) + F.lane;
        const bf16* YS2 = (const bf16*)(F.ws + WS_YS2);
        const GAS unsigned long long* y0 = (const GAS unsigned long long*)(p0 < YS_SPLIT ? YS + (size_t)p0 * D : YS2 + (size_t)(p0 - YS_SPLIT) * D) + F.lane; const GAS unsigned long long* y1 = (const GAS unsigned long long*)(p1 < YS_SPLIT ? YS + (size_t)p1 * D : YS2 + (size_t)(p1 - YS_SPLIT) * D) + F.lane;
        f32x4 v[4]; unsigned long long a0[4], a1[4];
#pragma unroll
        for (int j = 0; j < 4; ++j) { const unsigned long long w = xb[64 * j]; const unsigned lo = (unsigned)w, hi2 = (unsigned)(w >> 32); v[j] = (f32x4){pg8::bf_lo(lo), pg8::bf_hi(lo), pg8::bf_lo(hi2), pg8::bf_hi(hi2)}; a0[j] = y0[64 * j]; a1[j] = y1[64 * j]; }
        const unsigned t0[4] = {tm0.x, tm0.y, tm0.z, tm0.w}, t1[4] = {tm1.x, tm1.y, tm1.z, tm1.w};
#pragma unroll
        for (int j = 0; j < 4; ++j) { f32x4 y = {0.f, 0.f, 0.f, 0.f};
#pragma unroll
            for (int k = 0; k < 2; ++k) { const int p = k ? p1 : p0; const unsigned tm = k ? t1[j] : t0[j]; const unsigned long long aa = k ? a1[j] : a0[j];
                if (tm == 0u) { const unsigned lo = (unsigned)aa, hi = (unsigned)(aa >> 32); y.x += pg8::bf_lo(lo); y.y += pg8::bf_hi(lo); y.z += pg8::bf_lo(hi); y.w += pg8::bf_hi(hi); }
                else {
                    f32x4 a = {0.f, 0.f, 0.f, 0.f}; const float* sp = SLAB + (size_t)(tm - 1u) * S * 65536 + (size_t)(p & 255) * 256 + 4 * F.lane;
                    for (int q = 0; q < S; ++q) a += *(const f32x4*)(sp + (size_t)q * 65536);
                    y += a * GATE[p]; }
            }
            xr[64 * j] = v[j] + y; }
    }
}

__device__ __forceinline__ int wd_quota(int rem, int G) { if (rem == 0) return 0; const int q = (G - rem) * NWAVES * 7; return q < NE * IT_DN ? q : NE * IT_DN; }
constexpr int NPHASE = 19;
__global__ void __launch_bounds__(NWAVES * 64, 2) hymba_fwd(Args args) {
    extern __shared__ __attribute__((aligned(16))) unsigned char lds[];
    Frame F;
    F.lds = (LAS unsigned char*)lds; F.MISC = (volatile LAS unsigned*)(F.lds + MISC_OFF);
    F.tid = threadIdx.x; F.lane = F.tid & 63; F.wave = __builtin_amdgcn_readfirstlane(F.tid >> 6);
    F.G = gridDim.x; { const int bx = blockIdx.x; F.vcu = (F.G % 8 == 0) ? (bx % 8) * (F.G / 8) + bx / 8 : bx; }
    F.ws = args.ws; F.out = args.out; F.ctl = (gu32*)(args.ws + WS_CTL);
    for (int u = F.tid; u < (LDS_BYTES - LDSCTL_OFF) / 4; u += NWAVES * 64) ((LAS unsigned*)(F.lds + LDSCTL_OFF))[u] = 0u;
    __syncthreads();
    const int lo = args.ph_lo, hi = args.ph_hi;
    XcdBarrier bar; bar.bar = (unsigned*)(F.ctl + CW_BAR); bar.x = 0; bar.st = nullptr;
    if (hi - lo > 1) bar = xcd_barrier_post((unsigned*)(F.ctl + CW_BAR), F.MISC + 8);
#ifndef PH_MASK
#define PH_MASK 0x7FFFF
#endif
#define IN(k) (((PH_MASK >> (k)) & 1) && lo <= (k) && (k) < hi)
#define SEAM(k) do { if ((k) + 1 < hi) xcd_barrier(bar); } while (0)
#ifndef PH_TWICE
#define PH_TWICE 0
#endif
#define REP(k) for (int rep_ = 0; rep_ < 1 + ((PH_TWICE >> (k)) & 1); ++rep_)
#define REPSEAM() do { if (rep_ == 0 && hi - lo > 1) xcd_barrier(bar); } while (0)
    unsigned char* ws = args.ws;
#define PH() do { GAS unsigned char* w_ = (GAS unsigned char*)args.ws; GAS float* o_ = (GAS float*)args.out; int t_ = threadIdx.x; asm volatile("" : "+s"(w_), "+s"(o_), "+v"(t_)); F.ws = (unsigned char*)w_; F.out = (float*)o_; F.tid = t_; F.lane = t_ & 63; ws = (unsigned char*)w_; } while (0)
#define XB_ ((bf16*)(ws + WS_XB))
#define QKVU_ ((bf16*)(ws + WS_QKVU))
#define MIX_ ((bf16*)(ws + WS_MIX))
#define YG_ ((bf16*)(ws + WS_YG))
#define SSQ_A_ ((float*)(ws + WS_SSQ_A))
#define SSQ_F_ ((float*)(ws + WS_SSQ_F))
#define SSQ_ATT_ ((float*)(ws + WS_SSQ_ATT))
#define SSQ_SSM_ ((float*)(ws + WS_SSQ_SSM))

    if (IN(0)) REP(0) {
        PH();
        if ((int)blockIdx.x < 2 * NG) ssm_precompute(F, args, (int)blockIdx.x / NG, (int)blockIdx.x % NG);
        else { { v4u* ebz = (v4u*)(ws + WS_EB); for (int i = ((int)blockIdx.x - 2 * NG) * 512 + F.tid; i < 65536; i += (F.G - 2 * NG) * 512) ebz[i] = (v4u){0u, 0u, 0u, 0u}; }
               p0_convert(F, args, (int)blockIdx.x - 2 * NG, F.G - 2 * NG); p0_xb(F, args.in[0], (int)blockIdx.x - 2 * NG, F.G - 2 * NG); }
        SEAM(0);
    }
    for (int l = 0; l < 2; ++l) {
        const int pb = l == 0 ? 1 : 8;
        if (IN(pb)) REP(pb) {
            PH(); unsigned char* wb = ws + WS_WSMALL + l * WSMALL_STRIDE;
            pg8::Gemm g{XB_, (const bf16*)(wb + WS_WIN), nullptr}; pg8::StaticOrder S; S.init(T, INW, F.G, (int)blockIdx.x);
            pg8::EpiInProj E{QKVU_, (bf16*)(ws + WS_UG), SSQ_A_, args.in[3] + l * HD, args.in[4] + l * HD, 0.125f * LOG2E};
            pg8::gemm_phase<pg8::EpiInProj, pg8::StaticOrder, false, D>(F.lds + RING_OFF, g, S, E);
            bg_convert(F, args, l == 0 ? 0 : BG_B3, l == 0 ? BG_B1 : BG_B4, (int)blockIdx.x - 64, F.G - 64);
            SEAM(pb);
        }
        if (IN(pb + 1)) REP(pb + 1) { PH(); ssm_phase_v2(F, l); attn_phase_v1(F, args, l, 0, F.G); bg_convert(F, args, l == 0 ? BG_B1 : BG_B4, l == 0 ? BG_B2 : BG_B5, (int)blockIdx.x, F.G); SEAM(pb + 1); }
        if (IN(pb + 3)) REP(pb + 3) {
            PH(); unsigned char* wb = ws + WS_WSMALL + l * WSMALL_STRIDE;
            pg8::Gemm g{YG_, (const bf16*)(wb + WS_WGLU), nullptr}; pg8::StaticOrder S; S.init(T, SW, F.G, (int)blockIdx.x);
            pg8::EpiGlu E{YG_, MIX_, SSQ_SSM_};
            pg8::gemm_phase<pg8::EpiGlu, pg8::StaticOrder, false, SW>(F.lds + RING_OFF, g, S, E);
            bg_convert(F, args, l == 0 ? BG_B2 : BG_B5, l == 0 ? BG_B3 : BG_B6, (int)blockIdx.x - 128, F.G - 128);
            SEAM(pb + 3);
        }
        if (IN(pb + 4)) REP(pb + 4) {
            PH(); unsigned char* wb = ws + WS_WSMALL + l * WSMALL_STRIDE;
            pg8::Gemm g{MIX_, (const bf16*)(wb + WS_WO), nullptr}; pg8::StaticOrder S; S.init(T, D, F.G, (int)blockIdx.x);
            pg8::EpiRes<true, false> E{nullptr, XB_, SSQ_F_, SSQ_ATT_, SSQ_SSM_, (LAS float*)(F.lds + TAB_OFF)};
            pg8::gemm_phase<pg8::EpiRes<true, false>, pg8::StaticOrder, false, D>(F.lds + RING_OFF, g, S, E);
            SEAM(pb + 4);
        }
    if (l == 0) {
        if (IN(6)) REP(6) {
            PH();
            pg8::Gemm g{XB_, (const bf16*)(ws + WS_DGU), nullptr}; pg8::StaticOrder S; S.init(T, 2 * FF, F.G, (int)blockIdx.x);
            pg8::EpiSwiglu<false> E{(bf16*)(ws + WS_HD), nullptr, (LAS float*)(F.lds + TAB2_OFF)};
            pg8::fill_rinv_tab(S, SSQ_F_, (LAS float*)(F.lds + TAB2_OFF), F.tid, TAB2_UNITS);
            pg8::gemm_phase<pg8::EpiSwiglu<false>, pg8::StaticOrder, false, D>(F.lds + RING_OFF, g, S, E);
            SEAM(6);
        }
        if (IN(7)) REP(7) {
            PH();
            pg8::Gemm g{(const bf16*)(ws + WS_HD), (const bf16*)(ws + WS_DD), nullptr}; pg8::StaticOrder S; S.init(T, D, F.G, (int)blockIdx.x);
            pg8::EpiRes<false, false> E{nullptr, XB_, SSQ_A_, nullptr, nullptr, (LAS float*)(F.lds + TAB_OFF)};
            pg8::gemm_phase<pg8::EpiRes<false, false>, pg8::StaticOrder, false, FF>(F.lds + RING_OFF, g, S, E);
            SEAM(7);
        }
    } else {
        if (IN(13)) REP(13) { PH(); route1(F, args); SEAM(13); }
        if (IN(14)) REP(14) { PH(); route2(F); conv_run2<0>(F, args, BG_B6 + (int)blockIdx.x * NWAVES + F.wave, F.G * NWAVES, IT_BG); SEAM(14); }
        if (IN(15)) REP(15) {
            PH(); unsigned char* rt = ws + WS_ROUTE;
            pg8::Gemm g{XB_, (const bf16*)(ws + WS_MOEW), (const int*)(rt + RT_IDX)}; pg8::MoeOrder S; S.init((const int*)(rt + RT_PEND), 2 * FF, F.G, (int)blockIdx.x);
            pg8::EpiSwiglu<true> E{(bf16*)(ws + WS_HS), (const float*)(rt + RT_RINVS), nullptr};
            pg8::gemm_phase<pg8::EpiSwiglu<true>, pg8::MoeOrder, true, D>(F.lds + RING_OFF, g, S, E);
            { const int rem = S.nwg % F.G, q = wd_quota(rem, F.G);
              if (rem && (int)blockIdx.x >= rem) conv_run2<1>(F, args, ((int)blockIdx.x - rem) * NWAVES + F.wave, (F.G - rem) * NWAVES, q); }
            SEAM(15);
        }
        if (IN(16)) REP(16) { PH(); const int nwgu = ((const int*)(ws + WS_ROUTE + RT_PEND))[7] * (2 * FF / 256), q = wd_quota(nwgu % F.G, F.G);
            if (q < NE * IT_DN) { conv_run2<1>(F, args, q + F.vcu * NWAVES + F.wave, F.G * NWAVES, NE * IT_DN); SEAM(16); } }
        if (IN(17)) REP(17) {
            PH(); unsigned char* rt = ws + WS_ROUTE;
            pg8::Gemm g{(const bf16*)(ws + WS_HS), (const bf16*)(ws + WS_WDT), nullptr}; pg8::MoeOrderSplit<FF / 64> S; S.init((const int*)(rt + RT_PEND), D, F.G, (int)blockIdx.x, WDT_E7);
            pg8::EpiMoeDown E{(bf16*)(ws + WS_YS), (bf16*)(ws + WS_YS2), YS_SPLIT, (const float*)(rt + RT_GATE), (float*)(ws + WS_SLAB), (unsigned*)(ws + WS_CTL) + CW_TAILMAP, S.S};
            pg8::gemm_phase<pg8::EpiMoeDown, pg8::MoeOrderSplit<FF / 64>, false, FF>(F.lds + RING_OFF, g, S, E);
            SEAM(17);
        }
        if (IN(18)) REP(18) { PH(); moe_combine(F); }
    }
    }
#undef IN
#undef SEAM
}

extern "C" void kernel_launch(void* const* d_in, const int* in_sizes, int n_in, void* d_out, int out_size, void* d_ws, size_t ws_size, hipStream_t stream) {
    static int grid = 0;
    if (grid == 0) {
        if (n_in != 26 || in_sizes[0] != T * D || out_size != T * D || ws_size < WS_END) { fprintf(stderr, "kernel_launch: unexpected shapes/workspace (n_in %d, in0 %d, out %d, ws %zu, need %zu); nothing launched\n", n_in, n_in > 0 ? in_sizes[0] : -1, out_size, ws_size, (size_t)WS_END); grid = -1; return; }
        int dev = 0, cus = 0, per_cu = 0;
        if (hipGetDevice(&dev) != hipSuccess || hipDeviceGetAttribute(&cus, hipDeviceAttributeMultiprocessorCount, dev) != hipSuccess) { grid = -1; return; }
        if (hipFuncSetAttribute((const void*)hymba_fwd, hipFuncAttributeMaxDynamicSharedMemorySize, LDS_BYTES) != hipSuccess) { fprintf(stderr, "kernel_launch: hipFuncSetAttribute failed\n"); grid = -1; return; }
        if (hipOccupancyMaxActiveBlocksPerMultiprocessor(&per_cu, (const void*)hymba_fwd, NWAVES * 64, LDS_BYTES) != hipSuccess || per_cu < 1) { fprintf(stderr, "kernel_launch: occupancy query reports %d workgroups per CU\n", per_cu); (void)hipGetLastError(); grid = -1; return; }
        grid = cus;
    }
    if (grid < 0) return;
    (void)hipMemsetAsync((char*)d_ws + WS_CTL, 0, CTL_ZERO_BYTES, stream);
    Args a{};
    for (int i = 0; i < 26; ++i) a.in[i] = (const float*)d_in[i];
    a.out = (float*)d_out; a.ws = (unsigned char*)d_ws;
#if MK_N_LAUNCHES == 1
    a.ph_lo = 0; a.ph_hi = NPHASE;
    hipLaunchKernelGGL(hymba_fwd, dim3(grid), dim3(NWAVES * 64), LDS_BYTES, stream, a);
#else
    for (int p = 0; p < NPHASE; ++p) { a.ph_lo = p; a.ph_hi = p + 1; hipLaunchKernelGGL(hymba_fwd, dim3(grid), dim3(NWAVES * 64), LDS_BYTES, stream, a); }
#endif
}
```

```cpp
#include <hip/hip_runtime.h>
#include <cstdio>
#include <cstdint>

#ifndef MK_N_LAUNCHES
#define MK_N_LAUNCHES 1
#endif

constexpr int BATCH = 2, SEQ = 8192, T = BATCH * SEQ, D = 1024, INW = 1280, FF = 3584, NE = 8;
constexpr int NH = 8, NKV = 2, HD = 64, AW = 512, KVW = 128, SW = 512, NG = 32, GD = 16, NS = 64, WIN = 128;
constexpr int QOFF = 0, KOFF = 512, VOFF = 640, UOFF = 768;
constexpr float EPS = 1e-6f;
constexpr float LOG2E = 1.4426950408889634f;
constexpr int CAP = 2 * T + NE * 256;
constexpr int CN = 16;

namespace pg8 {
#define PG8_LAS __attribute__((address_space(3)))
typedef unsigned short bf16_t;
typedef short bf16x8 __attribute__((ext_vector_type(8)));
typedef float f32x4 __attribute__((ext_vector_type(4)));
typedef float f32x2 __attribute__((ext_vector_type(2)));
typedef unsigned u32x4 __attribute__((ext_vector_type(4)));
typedef unsigned u32x2 __attribute__((ext_vector_type(2)));
constexpr int BM = 256, BK = 64, HALF = 128, HTB = HALF * BK * 2, STAGE_BYTES = 8 * HTB, NXCD = 8, WGM = 8;

__host__ __device__ __forceinline__ int lds_byte(int r, int c) { const int st = (r >> 4) * 2 + (c >> 5), rr = r & 15, cc = c & 31, ob = rr * 64 + cc * 2; return st * 1024 + (ob ^ (((ob >> 9) & 1) << 5)); }
__host__ __device__ __forceinline__ void stage_rc(int b, int& R, int& C) { const int st = b / 1024, sb = b % 1024, swz = sb ^ (((sb >> 9) & 1) << 5); R = (st >> 1) * 16 + swz / 64; C = (st & 1) * 32 + (swz % 64) / 2; }
__host__ __device__ __forceinline__ int perm32(int rho) { const int n = rho >> 4, i = rho & 15; return 8 * (i >> 2) + 4 * n + (i & 3); }

struct Unit { int pm, pn, pb, k0, nk, sl; };
struct Gemm { const bf16_t* A; const bf16_t* Bt; const int* idx; };

struct StaticOrder {
    static constexpr bool KSPLIT = false;
    int nM, nN, nwg, G, c;
    __device__ void init(int M, int N, int G_, int c_) { nM = M / BM; nN = N / BM; nwg = nM * nN; G = G_; c = c_; }
    __device__ bool next(int i, Unit& u) const {
        const long L = (long)i * G + c; if (L >= nwg) return false;
        int wgid = (int)L; { const int q = nwg / NXCD, r = nwg % NXCD, xcd = wgid % NXCD, off = wgid / NXCD; wgid = (xcd < r ? xcd * (q + 1) : r * (q + 1) + (xcd - r) * q) + off; }
        const int nig = WGM * nN, gid = wgid / nig, fm = gid * WGM, gsz = (nM - fm) < WGM ? (nM - fm) : WGM;
        u.pm = fm + ((wgid % nig) % gsz); u.pn = (wgid % nig) / gsz; u.pb = u.pn; return true;
    }
};
struct MoeOrder {
    static constexpr bool KSPLIT = false;
    int nM, nN, nwg, G, c; int pend[8];
    __device__ void init(const int* pendg, int N, int G_, int c_) {
#pragma unroll
        for (int e = 0; e < 8; ++e) pend[e] = __builtin_amdgcn_readfirstlane(pendg[e]);
        nM = pend[7]; nN = N / BM; nwg = nM * nN; G = G_; c = c_; }
    __device__ bool next(int i, Unit& u) const {
        const long L = (long)i * G + c; if (L >= nwg) return false;
        int wgid = (int)L; { const int q = nwg / NXCD, r = nwg % NXCD, xcd = wgid % NXCD, off = wgid / NXCD; wgid = (xcd < r ? xcd * (q + 1) : r * (q + 1) + (xcd - r) * q) + off; }
        const int nig = WGM * nN, gid = wgid / nig, fm = gid * WGM, gsz = (nM - fm) < WGM ? (nM - fm) : WGM;
        u.pm = fm + ((wgid % nig) % gsz); u.pn = (wgid % nig) / gsz;
        int e = 0;
#pragma unroll
        for (int k = 0; k < 7; ++k) e += (pend[k] <= u.pm) ? 1 : 0;
        u.pb = e * nN + u.pn; return true;
    }
};

constexpr int KS_MAXSLAB = 144, KS_MAXS = 8;
__device__ __forceinline__ int ks_slices(int nwg, int G) { const int rem = nwg % G; if (rem == 0) return 1; int S = G / rem; S = S > KS_MAXS ? KS_MAXS : S; if (S * rem > KS_MAXSLAB) S = KS_MAXSLAB / rem; return S < 2 ? 1 : S; }
template <int NT> struct MoeOrderSplit {
    static constexpr bool KSPLIT = true;
    int nM, nN, nwg, G, c, nfull, S, e7tile; int pend[8];
    __device__ void init(const int* pendg, int N, int G_, int c_, int e7tile_) { e7tile = e7tile_;
#pragma unroll
        for (int e = 0; e < 8; ++e) pend[e] = __builtin_amdgcn_readfirstlane(pendg[e]);
        nM = pend[7]; nN = N / BM; nwg = nM * nN; G = G_; c = c_; S = ks_slices(nwg, G); nfull = S > 1 ? (nwg / G) * G : nwg; }
    __device__ bool next(int i, Unit& u) const {
        const long L = (long)i * G + c; int wgid, sl = -1, s = 0;
        if (L < nfull) wgid = (int)L; else { const int j = (int)(L - nfull); if (j >= (nwg - nfull) * S) return false; wgid = nfull + j / S; s = j % S; sl = j; }
        { const int q = nwg / NXCD, r = nwg % NXCD, xcd = wgid % NXCD, off = wgid / NXCD; wgid = (xcd < r ? xcd * (q + 1) : r * (q + 1) + (xcd - r) * q) + off; }
        const int nig = WGM * nN, gid = wgid / nig, fm = gid * WGM, gsz = (nM - fm) < WGM ? (nM - fm) : WGM;
        u.pm = fm + ((wgid % nig) % gsz); u.pn = (wgid % nig) / gsz;
        int e = 0;
#pragma unroll
        for (int k = 0; k < 7; ++k) e += (pend[k] <= u.pm) ? 1 : 0;
        u.pb = (e < 7 ? e * nN : e7tile) + u.pn; u.sl = sl;
        if (sl < 0) { u.k0 = 0; u.nk = NT; } else { const int p0 = (NT / 2) * s / S, p1 = (NT / 2) * (s + 1) / S; u.k0 = 2 * p0; u.nk = 2 * (p1 - p0); }
        return true;
    }
};

__device__ __forceinline__ unsigned cvt_pk_bf16(float lo, float hi) { unsigned r; asm volatile("v_cvt_pk_bf16_f32 %0, %1, %2" : "=v"(r) : "v"(lo), "v"(hi)); return r; }
__device__ __forceinline__ float bf_lo(unsigned w) { return __uint_as_float(w << 16); }
__device__ __forceinline__ float bf_hi(unsigned w) { return __uint_as_float(w & 0xffff0000u); }
__device__ __forceinline__ float sum4(const float* p) { const f32x4 v = *(const f32x4*)p; return (v[0] + v[1]) + (v[2] + v[3]); }
__device__ __forceinline__ float sum16(const float* p) { return (sum4(p) + sum4(p + 4)) + (sum4(p + 8) + sum4(p + 12)); }
__device__ __forceinline__ float sum8(const float* p) { return sum4(p) + sum4(p + 4); }

struct EpiInProj {
    static constexpr bool PERM = true, MID = false; static constexpr int MID_T = 0;
    bf16_t* O; bf16_t* UG; const float* ssq; const float* gq; const float* gk; float qscale;
    struct State {};
    __device__ __forceinline__ void begin(const Unit&, int, int, State&) const {}
    __device__ __forceinline__ void mid(f32x4 (&)[2][2][4][2], const Unit&, int, int, int, int, int, State&) const {}
    __device__ __forceinline__ void operator()(const f32x4 (&acc)[2][2][4][2], const Unit& u, int ui, int wr, int wc, int fr, int fq, const State& est) const {
        const int row0 = u.pm * BM + wr * 64 + fr, tcol0 = u.pn * BM + 64 * wc;
        const int kind = tcol0 < KOFF ? 0 : (tcol0 < VOFF ? 1 : 2);
        f32x4 gv[2][2];
        if (kind < 2) { const float* g = kind == 0 ? gq : gk;
#pragma unroll
            for (int bj = 0; bj < 2; ++bj)
#pragma unroll
                for (int n = 0; n < 2; ++n) gv[bj][n] = *(const f32x4*)(g + 32 * bj + 8 * fq + 4 * n); }
#pragma unroll
        for (int ai = 0; ai < 2; ++ai) {
            float rinv4[4];
#pragma unroll
            for (int m = 0; m < 4; ++m) rinv4[m] = __builtin_amdgcn_rsqf(sum16(ssq + (size_t)(row0 + ai * HALF + m * 16) * 16) * (1.0f / D) + EPS);
            asm volatile("" : "+v"(rinv4[0]), "+v"(rinv4[1]), "+v"(rinv4[2]), "+v"(rinv4[3]));
#pragma unroll
            for (int m = 0; m < 4; ++m) {
                const int row = row0 + ai * HALF + m * 16;
                const float rinv = rinv4[m];
                f32x4 v[2][2];
#pragma unroll
                for (int bj = 0; bj < 2; ++bj)
#pragma unroll
                    for (int n = 0; n < 2; ++n) v[bj][n] = acc[ai][bj][m][n] * rinv;
                if (kind < 2) {
                    float ss = 0.f;
#pragma unroll
                    for (int bj = 0; bj < 2; ++bj)
#pragma unroll
                        for (int n = 0; n < 2; ++n) { const f32x4 x = v[bj][n]; ss += (x[0] * x[0] + x[1] * x[1]) + (x[2] * x[2] + x[3] * x[3]); }
                    ss += __shfl_xor(ss, 16); ss += __shfl_xor(ss, 32);
                    const float hr = __builtin_amdgcn_rsqf(ss * (1.0f / HD) + EPS) * (kind == 0 ? qscale : 1.0f);
#pragma unroll
                    for (int bj = 0; bj < 2; ++bj)
#pragma unroll
                        for (int n = 0; n < 2; ++n) v[bj][n] = v[bj][n] * gv[bj][n] * hr;
                }
                bf16_t* rowp = O + (size_t)row * INW + tcol0 + 8 * fq;
#pragma unroll
                for (int bj = 0; bj < 2; ++bj) { u32x4 w; w.x = cvt_pk_bf16(v[bj][0][0], v[bj][0][1]); w.y = cvt_pk_bf16(v[bj][0][2], v[bj][0][3]); w.z = cvt_pk_bf16(v[bj][1][0], v[bj][1][1]); w.w = cvt_pk_bf16(v[bj][1][2], v[bj][1][3]);
                    if (tcol0 >= UOFF) { const int uc = tcol0 - UOFF + 32 * bj + 8 * fq;
                        *(u32x4*)(UG + ((size_t)(uc >> 4) * T + row) * GD + (uc & 15)) = w; }
                    else *(u32x4*)(rowp + 32 * bj) = w; }
            }
        }
    }
};
struct EpiGlu {
    static constexpr bool PERM = true, MID = false; static constexpr int MID_T = 0;
    const bf16_t* Y; bf16_t* MIX; float* ssq;
    struct State {};
    __device__ __forceinline__ void begin(const Unit&, int, int, State&) const {}
    __device__ __forceinline__ void mid(f32x4 (&)[2][2][4][2], const Unit&, int, int, int, int, int, State&) const {}
    __device__ __forceinline__ void operator()(const f32x4 (&acc)[2][2][4][2], const Unit& u, int ui, int wr, int wc, int fr, int fq, const State& est) const {
        const int row0 = u.pm * BM + wr * 64 + fr, col0 = u.pn * BM + wc * 32 + 8 * fq;
#pragma unroll
        for (int ai = 0; ai < 2; ++ai) {
            u32x4 yall[4][2];
#pragma unroll
            for (int m = 0; m < 4; ++m)
#pragma unroll
                for (int bj = 0; bj < 2; ++bj) yall[m][bj] = *(const u32x4*)(Y + (size_t)(row0 + ai * HALF + m * 16) * SW + col0 + bj * HALF);
#pragma unroll
            for (int m = 0; m < 4; ++m) {
                const int row = row0 + ai * HALF + m * 16; float ss = 0.f;
#pragma unroll
                for (int bj = 0; bj < 2; ++bj) {
                    const u32x4 yw = yall[m][bj];
                    const float y[8] = {bf_lo(yw.x), bf_hi(yw.x), bf_lo(yw.y), bf_hi(yw.y), bf_lo(yw.z), bf_hi(yw.z), bf_lo(yw.w), bf_hi(yw.w)};
                    float s[8];
#pragma unroll
                    for (int n = 0; n < 2; ++n)
#pragma unroll
                        for (int j = 0; j < 4; ++j) { const float g = acc[ai][bj][m][n][j]; const float o = y[4 * n + j] * __builtin_amdgcn_rcpf(1.0f + __builtin_amdgcn_exp2f(-LOG2E * g)); s[4 * n + j] = o; ss += o * o; }
                    u32x4 w; w.x = cvt_pk_bf16(s[0], s[1]); w.y = cvt_pk_bf16(s[2], s[3]); w.z = cvt_pk_bf16(s[4], s[5]); w.w = cvt_pk_bf16(s[6], s[7]);
                    *(u32x4*)(MIX + (size_t)row * D + AW + col0 + bj * HALF) = w;
                }
                ss += __shfl_xor(ss, 16); ss += __shfl_xor(ss, 32);
                if (fq == 0) ssq[(size_t)row * 8 + u.pn * 4 + wc] = ss;
            }
        }
    }
};
template <bool WO, bool RESF32> struct EpiRes {
    static constexpr bool PERM = true, MID = WO; static constexpr int MID_T = 8;
    const float* res; bf16_t* XB; float* ssq_out; const float* ssq_a; const float* ssq_s;
    PG8_LAS float* tab;
    struct State {};
    __device__ __forceinline__ void begin(const Unit& u, int ui, int tid, State&) const {
        if (WO) { if (tid < BM) { const int row = u.pm * BM + tid;
            const float ra = 1.0f / sqrtf(sum8(ssq_a + (size_t)row * 8) * (1.0f / AW) + EPS), rs = 1.0f / sqrtf(sum8(ssq_s + (size_t)row * 8) * (1.0f / SW) + EPS);
            *(PG8_LAS f32x2*)(tab + ((ui & 1) * BM + tid) * 2) = (f32x2){ra / rs, rs}; } }
    }
    __device__ __forceinline__ void mid(f32x4 (&acc)[2][2][4][2], const Unit& u, int ui, int wr, int wc, int fr, int fq, State&) const {
        const int r0 = wr * 64 + fr;
#pragma unroll
        for (int ai = 0; ai < 2; ++ai)
#pragma unroll
            for (int m = 0; m < 4; ++m) {
                const float f = tab[((ui & 1) * BM + r0 + ai * HALF + m * 16) * 2];
#pragma unroll
                for (int bj = 0; bj < 2; ++bj)
#pragma unroll
                    for (int n = 0; n < 2; ++n) acc[ai][bj][m][n] *= f;
            }
    }
    __device__ __forceinline__ void operator()(const f32x4 (&acc)[2][2][4][2], const Unit& u, int ui, int wr, int wc, int fr, int fq, const State& est) const {
        const int r0 = wr * 64 + fr, row0 = u.pm * BM + r0, col0 = u.pn * BM + wc * 32 + 8 * fq;
        constexpr int NB = RESF32 ? 2 : 4;
#pragma unroll
        for (int b0 = 0; b0 < 8; b0 += NB) {
            f32x4 rf[NB][2][2]; u32x4 rb[NB][2];
#pragma unroll
            for (int q = 0; q < NB; ++q) { const int ai = (b0 + q) >> 2, m = (b0 + q) & 3; const size_t off = (size_t)(row0 + ai * HALF + m * 16) * D + col0;
#pragma unroll
                for (int bj = 0; bj < 2; ++bj) { if (RESF32) { rf[q][bj][0] = *(const f32x4*)(res + off + bj * HALF); rf[q][bj][1] = *(const f32x4*)(res + off + bj * HALF + 4); } else rb[q][bj] = *(const u32x4*)(XB + off + bj * HALF); } }
#pragma unroll
            for (int q = 0; q < NB; ++q) { const int ai = (b0 + q) >> 2, m = (b0 + q) & 3, row = row0 + ai * HALF + m * 16; float ss = 0.f;
                float sc = 1.0f; if (WO) sc = tab[((ui & 1) * BM + r0 + ai * HALF + m * 16) * 2 + 1];
#pragma unroll
                for (int bj = 0; bj < 2; ++bj) {
                    f32x4 r0v, r1v;
                    if (RESF32) { r0v = rf[q][bj][0]; r1v = rf[q][bj][1]; }
                    else { const u32x4 w = rb[q][bj]; r0v = (f32x4){bf_lo(w.x), bf_hi(w.x), bf_lo(w.y), bf_hi(w.y)}; r1v = (f32x4){bf_lo(w.z), bf_hi(w.z), bf_lo(w.w), bf_hi(w.w)}; }
                    const f32x4 o0 = r0v + acc[ai][bj][m][0] * sc, o1 = r1v + acc[ai][bj][m][1] * sc;
                    u32x4 w; w.x = cvt_pk_bf16(o0[0], o0[1]); w.y = cvt_pk_bf16(o0[2], o0[3]); w.z = cvt_pk_bf16(o1[0], o1[1]); w.w = cvt_pk_bf16(o1[2], o1[3]);
                    *(u32x4*)(XB + (size_t)row * D + col0 + bj * HALF) = w;
                    ss += ((o0[0] * o0[0] + o0[1] * o0[1]) + (o0[2] * o0[2] + o0[3] * o0[3])) + ((o1[0] * o1[0] + o1[1] * o1[1]) + (o1[2] * o1[2] + o1[3] * o1[3]));
                }
                ss += __shfl_xor(ss, 16); ss += __shfl_xor(ss, 32);
                if (fq == 0) ssq_out[(size_t)row * 16 + u.pn * 4 + wc] = ss;
            }
        }
    }
};
template <bool MOE> struct EpiSwiglu {
    static constexpr bool PERM = true, MID = false; static constexpr int MID_T = 0;
    bf16_t* H; const float* rs;
    PG8_LAS float* tab;
    struct State { float r[MOE ? 8 : 1]; };
    __device__ __forceinline__ void begin(const Unit& u, int ui, int tid, State& st) const {
        if (MOE) { const int wid = tid >> 6, lane = tid & 63, row0 = u.pm * BM + (wid >> 2) * 64 + (lane & 15);
#pragma unroll
            for (int ai = 0; ai < 2; ++ai)
#pragma unroll
                for (int m = 0; m < 4; ++m) st.r[ai * 4 + m] = rs[row0 + ai * HALF + m * 16]; }
    }
    __device__ __forceinline__ void mid(f32x4 (&)[2][2][4][2], const Unit&, int, int, int, int, int, State&) const {}
    __device__ __forceinline__ void operator()(const f32x4 (&acc)[2][2][4][2], const Unit& u, int ui, int wr, int wc, int fr, int fq, const State& est) const {
        const int r0 = wr * 64 + fr, row0 = u.pm * BM + r0, hcol = u.pn * HALF + wc * 32 + 8 * fq;
#pragma unroll
        for (int ai = 0; ai < 2; ++ai)
#pragma unroll
            for (int m = 0; m < 4; ++m) {
                const int row = row0 + ai * HALF + m * 16;
                const float rinv = MOE ? est.r[MOE ? ai * 4 + m : 0] : tab[ui * BM + r0 + ai * HALF + m * 16];
                float h[8];
#pragma unroll
                for (int n = 0; n < 2; ++n)
#pragma unroll
                    for (int j = 0; j < 4; ++j) { const float g = acc[ai][0][m][n][j] * rinv, uu = acc[ai][1][m][n][j] * rinv; h[4 * n + j] = g * __builtin_amdgcn_rcpf(1.0f + __builtin_amdgcn_exp2f(-LOG2E * g)) * uu; }
                u32x4 w; w.x = cvt_pk_bf16(h[0], h[1]); w.y = cvt_pk_bf16(h[2], h[3]); w.z = cvt_pk_bf16(h[4], h[5]); w.w = cvt_pk_bf16(h[6], h[7]);
                *(u32x4*)(H + (size_t)row * FF + hcol) = w;
            }
    }
};
template <class Sched> __device__ __forceinline__ void fill_rinv_tab(const Sched& S, const float* ssq, PG8_LAS float* tab, int tid, int maxu) {
    if (tid < BM) { Unit u;
        for (int i = 0; i < maxu && S.next(i, u); ++i) tab[i * BM + tid] = __builtin_amdgcn_rsqf(sum16(ssq + (size_t)(u.pm * BM + tid) * 16) * (1.0f / D) + EPS); }
    asm volatile("s_waitcnt lgkmcnt(0)\n\ts_barrier" ::: "memory");
}
struct EpiMoeDown {
    static constexpr bool PERM = true, MID = false; static constexpr int MID_T = 0;
    bf16_t* Ys; bf16_t* Ys2; int ysplit; const float* gate; float* slab; unsigned* tailmap; int S;
    struct State {};
    __device__ __forceinline__ void begin(const Unit&, int, int, State&) const {}
    __device__ __forceinline__ void mid(f32x4 (&)[2][2][4][2], const Unit&, int, int, int, int, int, State&) const {}
    __device__ __forceinline__ void operator()(const f32x4 (&acc)[2][2][4][2], const Unit& u, int ui, int wr, int wc, int fr, int fq, const State& est) const {
        if (u.sl >= 0) {
            float* sb = slab + (size_t)u.sl * (BM * BM) + (size_t)(wr * 64 + fr) * BM + wc * 32 + 8 * fq;
#pragma unroll
            for (int ai = 0; ai < 2; ++ai)
#pragma unroll
                for (int m = 0; m < 4; ++m)
#pragma unroll
                    for (int bj = 0; bj < 2; ++bj) { float* q = sb + (size_t)(ai * HALF + m * 16) * BM + bj * HALF; *(f32x4*)q = acc[ai][bj][m][0]; *(f32x4*)(q + 4) = acc[ai][bj][m][1]; }
            if (u.sl % S == 0 && wr == 0 && wc == 0 && fr == 0 && fq == 0) tailmap[u.pm * 4 + u.pn] = 1u + (unsigned)(u.sl / S);
            return;
        }
        const int row0 = u.pm * BM + wr * 64 + fr, col0 = u.pn * BM + wc * 32 + 8 * fq;
        bf16_t* ysb = u.pm * BM < ysplit ? Ys + (size_t)u.pm * BM * D : Ys2 + (size_t)(u.pm * BM - ysplit) * D;
        float g8[2][4];
#pragma unroll
        for (int ai = 0; ai < 2; ++ai)
#pragma unroll
            for (int m = 0; m < 4; ++m) g8[ai][m] = gate[row0 + ai * HALF + m * 16];
#pragma unroll
        for (int ai = 0; ai < 2; ++ai)
#pragma unroll
            for (int m = 0; m < 4; ++m) {
                const int row = row0 + ai * HALF + m * 16; const float g = g8[ai][m];
#pragma unroll
                for (int bj = 0; bj < 2; ++bj) { const f32x4 v0 = acc[ai][bj][m][0] * g, v1 = acc[ai][bj][m][1] * g;
                    u32x4 w; w.x = cvt_pk_bf16(v0[0], v0[1]); w.y = cvt_pk_bf16(v0[2], v0[3]); w.z = cvt_pk_bf16(v1[0], v1[1]); w.w = cvt_pk_bf16(v1[2], v1[3]);
                    *(u32x4*)(ysb + (size_t)(row - u.pm * BM) * D + col0 + bj * HALF) = w; }
            }
    }
};

template <class Epi, class Sched, bool GATHER, int K, bool ALIGN_EPI = true, bool SP2 = true>
__device__ __forceinline__ void gemm_phase(PG8_LAS unsigned char* lds, const Gemm g, const Sched& S, const Epi& E) {
    int tid_ = threadIdx.x; asm volatile("" : "+v"(tid_));
    const int tid = tid_, wid = __builtin_amdgcn_readfirstlane(tid >> 6), lane = tid & 63, wr = wid >> 2, wc = wid & 3, fr = lane & 15, fq = lane >> 4;
    constexpr int nt = K / BK;
    unsigned voffA[2], voffB[2]; int RA[2], CA[2];
#pragma unroll
    for (int i = 0; i < 2; ++i) { int R, C; stage_rc(tid * 16 + i * 8192, R, C); const int Rb = Epi::PERM ? ((R & ~31) + perm32(R & 31)) : R;
        RA[i] = R; CA[i] = C; voffA[i] = (unsigned)(R * K + C) * 2u; voffB[i] = (unsigned)(Rb * K + C) * 2u; }
    constexpr size_t kstep = (size_t)(BK * 2);
    constexpr size_t hstep = (size_t)HALF * K * 2;
    constexpr size_t tstep = 2 * hstep;
    const unsigned ldsw = (unsigned)wid * 1024u;
    const int aoff = lds_byte(wr * 64 + fr, fq * 8), boff = lds_byte(wc * 32 + fr, fq * 8);
#define PG8_SA(b, h) (((b) * 2 + (h)) * HTB)
#define PG8_SB(b, h) ((4 + (b) * 2 + (h)) * HTB)
    const char* const rsA = (const char*)g.A; const char* const rsB = (const char*)g.Bt;
#define PG8_STAGE_R(bufoff, rs, soff, voff) do { _Pragma("unroll") for (int _i = 0; _i < 2; ++_i) \
        __builtin_amdgcn_global_load_lds((const unsigned*)((rs) + (size_t)(unsigned)((voff)[_i] + (unsigned)(soff))), (PG8_LAS unsigned*)(lds + (bufoff) + ldsw + _i * 8192), 16, 0, 0); } while (0)
#define PG8_STAGE(bufoff, soff, voff) PG8_STAGE_R(bufoff, rsB, soff, voff)
#define PG8_STAGE_A(bufoff, soff, h, VG) do { if constexpr (GATHER) { PG8_STAGE_R(bufoff, rsA, soff, VG[h]); } else { PG8_STAGE_R(bufoff, rsA, (soff) + (unsigned)((h) * hstep), voffA); } } while (0)
#define PG8_LDA(dst, b, h) do { _Pragma("unroll") for (int m = 0; m < 4; ++m) _Pragma("unroll") for (int k = 0; k < 2; ++k) dst[m][k] = *(const PG8_LAS bf16x8*)(lds + PG8_SA(b, h) + aoff + m * 2048 + k * 1024); } while (0)
#define PG8_LDB(dst, b, h) do { _Pragma("unroll") for (int n = 0; n < 2; ++n) _Pragma("unroll") for (int k = 0; k < 2; ++k) dst[n][k] = *(const PG8_LAS bf16x8*)(lds + PG8_SB(b, h) + boff + n * 2048 + k * 1024); } while (0)
#define PG8_MMA(ai, bj, At, Bt) do { __builtin_amdgcn_s_setprio(1); _Pragma("unroll") for (int m = 0; m < 4; ++m) _Pragma("unroll") for (int n = 0; n < 2; ++n) _Pragma("unroll") for (int k = 0; k < 2; ++k) \
        acc[ai][bj][m][n] = __builtin_amdgcn_mfma_f32_16x16x32_bf16(Bt[n][k], At[m][k], acc[ai][bj][m][n], 0, 0, 0); __builtin_amdgcn_s_setprio(0); } while (0)
#define PG8_WAIT_V(n) asm volatile("s_waitcnt vmcnt(" #n ")" ::: "memory")
#define PG8_WAIT_L(n) asm volatile("s_waitcnt lgkmcnt(" #n ")" ::: "memory")
#define PG8_BAR __builtin_amdgcn_s_barrier()
#define PG8_SCHED __builtin_amdgcn_sched_barrier(0)
#define PG8_GOFF(dst, U) do { _Pragma("unroll") for (int _h = 0; _h < 2; ++_h) _Pragma("unroll") for (int _i = 0; _i < 2; ++_i) \
        dst[_h][_i] = ((unsigned)g.idx[(U).pm * BM + _h * HALF + RA[_i]] * (unsigned)K + (unsigned)CA[_i]) * 2u; } while (0)
    Unit cur, nxt; int ui = 0;
    if (!S.next(0, cur)) return;
    if constexpr (!Sched::KSPLIT) { cur.k0 = 0; cur.nk = nt; cur.sl = -1; }
    f32x4 acc[2][2][4][2];
#pragma unroll
    for (int a = 0; a < 2; ++a)
#pragma unroll
        for (int b = 0; b < 2; ++b)
#pragma unroll
            for (int m = 0; m < 4; ++m)
#pragma unroll
                for (int n = 0; n < 2; ++n) acc[a][b][m][n] = (f32x4){0.f, 0.f, 0.f, 0.f};
    bf16x8 At[4][2], B0[2][2], B1[2][2];
    unsigned vgc[2][2] = {{0u, 0u}, {0u, 0u}}, vgn[2][2] = {{0u, 0u}, {0u, 0u}};
    unsigned cA = (GATHER ? 0u : (unsigned)cur.pm * (unsigned)tstep) + (unsigned)cur.k0 * (unsigned)kstep, cB = (unsigned)cur.pb * (unsigned)tstep + (unsigned)cur.k0 * (unsigned)kstep;
    if constexpr (GATHER) PG8_GOFF(vgc, cur);
    typename Epi::State est;
    E.begin(cur, 0, tid, est);
    if constexpr (SP2) {
        PG8_STAGE(PG8_SB(0, 0), cB, voffB); PG8_STAGE(PG8_SB(0, 1), cB + hstep, voffB); PG8_STAGE_A(PG8_SA(0, 0), cA, 0, vgc); PG8_STAGE_A(PG8_SA(0, 1), cA, 1, vgc);
        if (wr == 1) PG8_BAR;
        PG8_WAIT_V(2); PG8_BAR;
        PG8_STAGE(PG8_SB(1, 0), cB + kstep, voffB); PG8_STAGE_A(PG8_SA(1, 0), cA + kstep, 0, vgc); PG8_STAGE(PG8_SB(1, 1), cB + hstep + kstep, voffB);
        PG8_WAIT_V(6); PG8_BAR;
    } else {
        PG8_STAGE(PG8_SB(0, 0), cB, voffB); PG8_STAGE_A(PG8_SA(0, 0), cA, 0, vgc); PG8_STAGE(PG8_SB(0, 1), cB + hstep, voffB); PG8_STAGE_A(PG8_SA(0, 1), cA, 1, vgc);
        if (wr == 1) PG8_BAR;
        PG8_WAIT_V(4); PG8_BAR;
        PG8_STAGE(PG8_SB(1, 0), cB + kstep, voffB); PG8_STAGE_A(PG8_SA(1, 0), cA + kstep, 0, vgc); PG8_STAGE(PG8_SB(1, 1), cB + hstep + kstep, voffB);
        PG8_WAIT_V(6); PG8_BAR;
    }
    for (;;) {
        const bool has_next = S.next(ui + 1, nxt);
        if constexpr (!Sched::KSPLIT) { nxt.k0 = 0; nxt.nk = nt; nxt.sl = -1; }
        const unsigned nA = has_next ? (GATHER ? 0u : (unsigned)nxt.pm * (unsigned)tstep) + (unsigned)nxt.k0 * (unsigned)kstep : cA, nB = has_next ? (unsigned)nxt.pb * (unsigned)tstep + (unsigned)nxt.k0 * (unsigned)kstep : cB;
        if constexpr (GATHER) { if (has_next) PG8_GOFF(vgn, nxt); else {
#pragma unroll
            for (int h = 0; h < 2; ++h)
#pragma unroll
                for (int i = 0; i < 2; ++i) vgn[h][i] = vgc[h][i]; } }
        const int nk = cur.nk;
        for (int t = 0; t < nk; t += 2) {
            const bool last = (t == nk - 2);
            if constexpr (Epi::MID) { if (t == Epi::MID_T) E.mid(acc, cur, ui, wr, wc, fr, fq, est); }
            const unsigned a1 = cA + (unsigned)(t + 1) * (unsigned)kstep;
            const unsigned a2 = last ? nA : cA + (unsigned)(t + 2) * (unsigned)kstep, b2 = last ? nB : cB + (unsigned)(t + 2) * (unsigned)kstep;
            const unsigned a3 = a2 + (unsigned)kstep, b3 = b2 + (unsigned)kstep;
            unsigned vgs[2][2];
#pragma unroll
            for (int h = 0; h < 2; ++h)
#pragma unroll
                for (int i = 0; i < 2; ++i) vgs[h][i] = last ? vgn[h][i] : vgc[h][i];
            if constexpr (SP2) {
            PG8_LDB(B0, 0, 0); PG8_LDB(B1, 0, 1); PG8_SCHED; PG8_LDA(At, 0, 0); PG8_STAGE_A(PG8_SA(1, 1), a1, 1, vgc);
            PG8_WAIT_V(8); PG8_WAIT_L(0); PG8_BAR; PG8_MMA(0, 0, At, B0); PG8_MMA(0, 1, At, B1); PG8_BAR; PG8_SCHED;
            PG8_LDA(At, 0, 1); PG8_STAGE(PG8_SB(0, 0), b2, voffB); PG8_STAGE(PG8_SB(0, 1), b2 + hstep, voffB); PG8_STAGE_A(PG8_SA(0, 0), a2, 0, vgs);
            PG8_WAIT_V(8); PG8_WAIT_L(0); PG8_BAR; PG8_MMA(1, 0, At, B0); PG8_MMA(1, 1, At, B1); PG8_BAR; PG8_SCHED;
            PG8_LDB(B0, 1, 0); PG8_LDB(B1, 1, 1); PG8_SCHED; PG8_LDA(At, 1, 0); PG8_STAGE_A(PG8_SA(0, 1), a2, 1, vgs);
            PG8_WAIT_V(8); PG8_WAIT_L(0); PG8_BAR; PG8_MMA(0, 0, At, B0); PG8_MMA(0, 1, At, B1); PG8_BAR; PG8_SCHED;
            PG8_LDA(At, 1, 1); PG8_STAGE(PG8_SB(1, 0), b3, voffB); PG8_STAGE(PG8_SB(1, 1), b3 + hstep, voffB); PG8_STAGE_A(PG8_SA(1, 0), a3, 0, vgs);
            PG8_WAIT_V(8); PG8_WAIT_L(0); PG8_BAR; PG8_MMA(1, 0, At, B0); PG8_MMA(1, 1, At, B1); PG8_BAR; PG8_SCHED;
            } else {
            PG8_LDB(B0, 0, 0); PG8_SCHED; PG8_LDA(At, 0, 0); PG8_STAGE_A(PG8_SA(1, 1), a1, 1, vgc);
            PG8_WAIT_L(8); PG8_BAR; PG8_WAIT_L(0); PG8_MMA(0, 0, At, B0); PG8_BAR; PG8_SCHED;
            PG8_LDB(B1, 0, 1); PG8_STAGE(PG8_SB(0, 0), b2, voffB);
            PG8_BAR; PG8_WAIT_L(0); PG8_MMA(0, 1, At, B1); PG8_BAR;
            PG8_LDA(At, 0, 1); PG8_STAGE_A(PG8_SA(0, 0), a2, 0, vgs);
            PG8_BAR; PG8_WAIT_L(0); PG8_MMA(1, 0, At, B0); PG8_BAR; PG8_SCHED;
            PG8_STAGE(PG8_SB(0, 1), b2 + hstep, voffB);
            PG8_WAIT_V(6); PG8_BAR; PG8_MMA(1, 1, At, B1); PG8_BAR;
            PG8_LDB(B0, 1, 0); PG8_SCHED; PG8_LDA(At, 1, 0); PG8_STAGE_A(PG8_SA(0, 1), a2, 1, vgs);
            PG8_WAIT_L(8); PG8_BAR; PG8_WAIT_L(0); PG8_MMA(0, 0, At, B0); PG8_BAR; PG8_SCHED;
            PG8_LDB(B1, 1, 1); PG8_STAGE(PG8_SB(1, 0), b3, voffB);
            PG8_BAR; PG8_WAIT_L(0); PG8_MMA(0, 1, At, B1); PG8_BAR;
            PG8_LDA(At, 1, 1); PG8_STAGE_A(PG8_SA(1, 0), a3, 0, vgs);
            PG8_BAR; PG8_WAIT_L(0); PG8_MMA(1, 0, At, B0); PG8_BAR; PG8_SCHED;
            PG8_STAGE(PG8_SB(1, 1), b3 + hstep, voffB);
            PG8_WAIT_V(6); PG8_BAR; PG8_MMA(1, 1, At, B1); PG8_BAR;
            }
        }
        if constexpr (ALIGN_EPI) { if (wr == 0) PG8_BAR; }
        E(acc, cur, ui, wr, wc, fr, fq, est);
        if (!has_next) break;
#pragma unroll
        for (int a = 0; a < 2; ++a)
#pragma unroll
            for (int b = 0; b < 2; ++b)
#pragma unroll
                for (int m = 0; m < 4; ++m)
#pragma unroll
                    for (int n = 0; n < 2; ++n) acc[a][b][m][n] = (f32x4){0.f, 0.f, 0.f, 0.f};
        cur = nxt; cA = nA; cB = nB; ++ui;
        E.begin(cur, ui, tid, est);
#pragma unroll
        for (int h = 0; h < 2; ++h)
#pragma unroll
            for (int i = 0; i < 2; ++i) vgc[h][i] = vgn[h][i];
        if constexpr (ALIGN_EPI) { if (wr == 1) PG8_BAR; }
    }
    PG8_WAIT_V(0);
    if constexpr (!ALIGN_EPI) { if (wr == 0) PG8_BAR; }
    PG8_BAR;
#undef PG8_SA
#undef PG8_SB
#undef PG8_STAGE
#undef PG8_STAGE_A
#undef PG8_LDA
#undef PG8_LDB
#undef PG8_MMA
#undef PG8_WAIT_V
#undef PG8_WAIT_L
#undef PG8_BAR
#undef PG8_SCHED
#undef PG8_GOFF
}
}

constexpr size_t MiB = 1u << 20;
constexpr size_t WS_CTL = 0, CTL_ZERO_BYTES = 128 * 1024;
constexpr size_t WS_SSQ_A = 1 * MiB, WS_SSQ_F = 2 * MiB, WS_SSQ_ATT = 3 * MiB, WS_SSQ_SSM = 3 * MiB + 512 * 1024;
constexpr size_t WS_ROUTE = 4 * MiB;
constexpr size_t RT_IDX = 0, RT_GATE = 160 * 1024, RT_RINVS = 320 * 1024, RT_POS = 480 * 1024, RT_TOPE = 608 * 1024, RT_TOPG = 736 * 1024, RT_RINVT = 864 * 1024, RT_HIST = 928 * 1024, RT_PEND = 944 * 1024;
constexpr size_t WS_SSMPRE = 6 * MiB, SSMPRE_STRIDE = 9 * MiB;
constexpr size_t WS_WSMALL = 24 * MiB, WSMALL_STRIDE = 5 * MiB, WS_WIN = 0, WS_WGLU = 5 * MiB / 2, WS_WO = 3 * MiB;
constexpr size_t WS_DGU = 34 * MiB, WS_DD = 48 * MiB;
constexpr size_t WS_MOEW = 56 * MiB, WS_XB = 168 * MiB, WS_YS = 56 * MiB, WS_YS2 = WS_YS + (size_t)28672 * 1024 * 2;
constexpr int YS_SPLIT = 28672;
constexpr size_t WS_RA = 200 * MiB, WS_QKVU = WS_RA, WS_MIX = 240 * MiB, WS_YG = 272 * MiB, WS_HD = 288 * MiB, WS_HS = WS_RA;
constexpr size_t WS_UG = WS_HD;
constexpr size_t WS_END = 446 * MiB;
static_assert(WS_YS2 + (size_t)(CAP - YS_SPLIT) * D * 2 <= 124 * MiB && WS_HS + (size_t)CAP * FF * 2 <= WS_END && WS_HD + (size_t)T * FF * 2 <= WS_END, "ws map");
constexpr int CW_BAR = 4096, CW_TAILMAP = 16384;
constexpr size_t WS_SLAB = 124 * MiB;
static_assert(WS_SLAB + (size_t)pg8::KS_MAXSLAB * 256 * 256 * 4 <= 168 * MiB, "slabs");
constexpr size_t WS_WDT = 6 * MiB, WDT_TILEB = (size_t)256 * FF * 2;
constexpr int WDT_E7 = 247;
static_assert(WS_WDT + 7 * 4 * WDT_TILEB <= 55 * MiB && WS_WDT + WDT_E7 * WDT_TILEB >= 438 * MiB, "MoE down weight copies");

constexpr int RING_OFF = 0, RING_BYTES = 131072;
constexpr int LDSCTL_OFF = RING_BYTES, MISC_OFF = LDSCTL_OFF + 320;
constexpr int TAB_OFF = MISC_OFF + 192;
constexpr int LDS_BYTES = 147456;
constexpr int TAB2_OFF = TAB_OFF + 4096, TAB2_UNITS = 11;
static_assert(TAB_OFF % 16 == 0 && TAB2_OFF + TAB2_UNITS * 1024 <= LDS_BYTES, "LDS map");
constexpr int NWAVES = 8;

#define GAS __attribute__((address_space(1)))
#define LAS __attribute__((address_space(3)))
typedef unsigned short bf16;
typedef unsigned v4u __attribute__((ext_vector_type(4)));
typedef float f32x4 __attribute__((ext_vector_type(4)));
typedef GAS unsigned gu32;
#define RLX_AGENT __ATOMIC_RELAXED, __HIP_MEMORY_SCOPE_AGENT
#define LDS_WAIT() asm volatile("s_waitcnt lgkmcnt(0)" ::: "memory")
#define VM_WAIT() asm volatile("s_waitcnt vmcnt(0)" ::: "memory")
__device__ __forceinline__ unsigned f2bf(float f) { unsigned u = __builtin_bit_cast(unsigned, f); return (u + 0x7fffu + ((u >> 16) & 1u)) >> 16; }
__device__ __forceinline__ unsigned pk2(float lo, float hi) { return f2bf(lo) | (f2bf(hi) << 16); }
__device__ __forceinline__ float bf2f(bf16 v) { return __uint_as_float((unsigned)v << 16); }

#define XB_TMO      128
#define XB_XCNT(j)  (256  + 64 * (j))
#define XB_XSUB(j)  (1280 + 64 * (j))
#define XB_XGEN(j)  (2304 + 64 * (j))
#define XB_TOP      3328
#define XB_TOPGEN   3392
#define XCD_BAR_WORDS 3456
#define XB_SPIN_CAP (1u << 22)
__device__ __forceinline__ unsigned xb_ld(unsigned* p)              { return __hip_atomic_load(p, __ATOMIC_RELAXED, __HIP_MEMORY_SCOPE_AGENT); }
__device__ __forceinline__ unsigned xb_add(unsigned* p, unsigned v) { return __hip_atomic_fetch_add(p, v, __ATOMIC_RELAXED, __HIP_MEMORY_SCOPE_AGENT); }
__device__ __forceinline__ unsigned xb_xcc_id() { return (unsigned)__builtin_amdgcn_s_getreg((3 << 11) | 20) & 0xFu; }
#define XB_SPIN(cond, bar) do { unsigned _sp = 0; while (cond) { __builtin_amdgcn_s_sleep(1); \
    if ((++_sp & 255u) == 0u) { if (xb_ld(&(bar)[XB_TMO])) break; if (_sp > XB_SPIN_CAP) { atomicAdd(&(bar)[XB_TMO], 1u); break; } } } } while (0)
struct XcdBarrier { unsigned* bar; unsigned x; volatile LAS unsigned* st; };
__device__ __forceinline__ XcdBarrier xcd_barrier_post(unsigned* bar, volatile LAS unsigned* st) {
    XcdBarrier b; b.bar = bar; b.x = xb_xcc_id(); b.st = st;
    if (threadIdx.x == 0) (void)xb_add(&bar[XB_XCNT(b.x)], 1u);
    return b;
}
__device__ __forceinline__ void xcd_barrier_complete(unsigned* bar, unsigned x, unsigned& nloc, unsigned& nx) {
    const unsigned G = gridDim.x * gridDim.y * gridDim.z;
    unsigned sum, cnt, mine, sp = 0u;
    for (;;) {
        sum = 0u; cnt = 0u; mine = 0u;
#pragma unroll
        for (unsigned j = 0; j < 16; ++j) { const unsigned c = xb_ld(&bar[XB_XCNT(j)]); sum += c; cnt += (c > 0u) ? 1u : 0u; mine = (j == x) ? c : mine; }
        if (sum == G) break;
        __builtin_amdgcn_s_sleep(1);
        if ((++sp & 255u) == 0u) { if (xb_ld(&bar[XB_TMO])) break; if (sp > XB_SPIN_CAP) { atomicAdd(&bar[XB_TMO], 1u); break; } }
    }
    nloc = mine > 0u ? mine : 1u; nx = cnt > 0u ? cnt : 1u;
}
__device__ __forceinline__ void xcd_barrier(const XcdBarrier& b) {
    asm volatile("s_waitcnt vmcnt(0)" ::: "memory");
    __syncthreads();
    if (threadIdx.x == 0) {
        unsigned* bar = b.bar;
        __builtin_amdgcn_s_waitcnt(0);
        unsigned nloc = b.st[0], nx = b.st[1];
        if (nloc == 0u) { xcd_barrier_complete(bar, b.x, nloc, nx); b.st[0] = nloc; b.st[1] = nx; }
        const unsigned old = xb_add(&bar[XB_XSUB(b.x)], 1u);
        const unsigned gen = old / nloc;
        if (old + 1u == (gen + 1u) * nloc) {
            __builtin_amdgcn_fence(__ATOMIC_RELEASE, "agent");
            asm volatile("s_waitcnt vmcnt(0)" ::: "memory");
            const unsigned og = xb_add(&bar[XB_TOP], 1u);
            const unsigned tg = og / nx;
            if (og + 1u == (tg + 1u) * nx) xb_add(&bar[XB_TOPGEN], 1u);
            else XB_SPIN(xb_ld(&bar[XB_TOPGEN]) == tg, bar);
            __builtin_amdgcn_fence(__ATOMIC_ACQUIRE, "agent");
            xb_add(&bar[XB_XGEN(b.x)], 1u);
            asm volatile("s_waitcnt vmcnt(0)" ::: "memory");
        } else {
            XB_SPIN(xb_ld(&bar[XB_XGEN(b.x)]) == gen, bar);
            __builtin_amdgcn_fence(__ATOMIC_ACQUIRE, "agent");
            asm volatile("s_waitcnt vmcnt(0)" ::: "memory");
        }
    }
    __syncthreads();
}

struct Args { const float* in[26]; float* out; unsigned char* ws; int ph_lo, ph_hi; };
struct Frame {
    LAS unsigned char* lds; volatile LAS unsigned* MISC; gu32* ctl;
    int tid, lane, wave, vcu, G;
    unsigned char* ws; float* out;
};
__device__ __forceinline__ float wave_sum(float v) {
#pragma unroll
    for (int o = 1; o < 64; o <<= 1) v += __shfl_xor(v, o);
    return v;
}
__device__ __forceinline__ float wave_max(float v) {
#pragma unroll
    for (int o = 1; o < 64; o <<= 1) v = fmaxf(v, __shfl_xor(v, o));
    return v;
}

constexpr int CKB = 64;
constexpr int CONV_LDS = 64 * 144;
__device__ __forceinline__ void conv_item(const float* srcl, int ldn, int k0, const float* ks, bf16* dst0  , int K, LAS unsigned char* scr, int lane) {
    float v[CKB];
    { const float* q = srcl + (size_t)k0 * ldn;
#pragma unroll
      for (int i = 0; i < CKB; ++i) { if ((i & 7) == 0) asm volatile("" : "+v"(q)); v[i] = __builtin_nontemporal_load(q + (size_t)(i & 7) * ldn); if ((i & 7) == 7) q += (size_t)8 * ldn; } }
    if (ks) {
#pragma unroll
        for (int i = 0; i < CKB; ++i) v[i] *= ks[k0 + i]; }
#pragma unroll
    for (int j = 0; j < CKB / 8; ++j) { v4u o; o.x = pg8::cvt_pk_bf16(v[8 * j], v[8 * j + 1]); o.y = pg8::cvt_pk_bf16(v[8 * j + 2], v[8 * j + 3]); o.z = pg8::cvt_pk_bf16(v[8 * j + 4], v[8 * j + 5]); o.w = pg8::cvt_pk_bf16(v[8 * j + 6], v[8 * j + 7]);
        *(LAS v4u*)(scr + lane * 144 + j * 16) = o; }
    asm volatile("s_waitcnt lgkmcnt(0)" ::: "memory");
#pragma unroll
    for (int i = 0; i < 8; ++i) { const int row = 8 * i + (lane >> 3), ch = lane & 7; const v4u o = *(const LAS v4u*)(scr + row * 144 + ch * 16);
        *(GAS v4u*)(dst0 + (size_t)row * K + ch * 8) = o; }
    asm volatile("s_waitcnt lgkmcnt(0)" ::: "memory");
}
__device__ __forceinline__ void conv_plain(const float* W, int K, int N, const float* ks_lo, const float* ks_hi, bf16* WT, int item, int lane, LAS unsigned char* scr) {
    const int nblk = N / 64, kb = item / nblk, nb = item % nblk, k0 = CKB * kb;
    const float* ks = ks_lo ? (k0 < 512 || !ks_hi ? ks_lo : ks_hi - 512) : nullptr;
    conv_item(W + 64 * nb + lane, N, k0, ks, WT + (size_t)(64 * nb) * K + k0, K, scr, lane);
}
__device__ __forceinline__ void conv_inproj(const float* W, const float* ks, bf16* WT, int item, int lane, LAS unsigned char* scr) {
    const int nblk = INW / 64, kb = item / nblk, db = item % nblk, drow = 64 * db + lane, pn = drow >> 8, bj = (drow >> 7) & 1, wc = (drow >> 5) & 3, i = drow & 31;
    conv_item(W + 256 * pn + 64 * wc + 32 * bj + i, INW, CKB * kb, ks, WT + (size_t)(64 * db) * D + CKB * kb, D, scr, lane);
}
__device__ __forceinline__ void conv_gu(const float* Wg, const float* Wu, const float* ks, bf16* WT, int item, int lane, LAS unsigned char* scr) {
    const int nblk = 2 * FF / 64, kb = item / nblk, db = item % nblk, drow = 64 * db + lane, pn = drow >> 8, bj = (drow >> 7) & 1, r = drow & 127;
    conv_item((bj ? Wu : Wg) + 128 * pn + r, FF, CKB * kb, ks, WT + (size_t)(64 * db) * D + CKB * kb, D, scr, lane);
}

constexpr int IT_IN = (D / CKB) * (INW / 64), IT_GLU = (SW / CKB) * (SW / 64), IT_WO = (D / CKB) * (D / 64), IT_L = IT_IN + IT_GLU + IT_WO;
constexpr int IT_GU = (D / CKB) * (2 * FF / 64), IT_DN = (FF / CKB) * (D / 64);
constexpr int IT_P0 = 2 * IT_L;
constexpr int IT_BG = IT_GU + IT_DN + NE * IT_GU;
#ifndef BGQ
#define BGQ 3000, 0, 2400, 3000, 0, 2400
#endif
constexpr int BG_Q[6] = {BGQ};
constexpr int BG_B1 = BG_Q[0], BG_B2 = BG_B1 + BG_Q[1], BG_B3 = BG_B2 + BG_Q[2], BG_B4 = BG_B3 + BG_Q[3], BG_B5 = BG_B4 + BG_Q[4], BG_B6 = BG_B5 + BG_Q[5];
static_assert(BG_B3 >= IT_GU + IT_DN && BG_B6 <= IT_BG, "dense FFN weights are needed right after slot 3");

__device__ __forceinline__ void p0_convert(Frame& F, const Args& a, int rank, int nranks) {
    LAS unsigned char* scr = F.lds + RING_OFF + F.wave * CONV_LDS;
    const int gw = rank * NWAVES + F.wave, NGW = nranks * NWAVES;
    for (int it = gw; it < IT_P0; it += NGW) {
        const int l = it / IT_L; int r = it - l * IT_L; unsigned char* wb = F.ws + WS_WSMALL + l * WSMALL_STRIDE;
        if (r < IT_IN) { conv_inproj(a.in[2] + (size_t)l * D * INW, a.in[1] + l * D, (bf16*)(wb + WS_WIN), r, F.lane, scr); continue; } r -= IT_IN;
        if (r < IT_GLU) { conv_plain(a.in[14] + (size_t)l * SW * SW, SW, SW, nullptr, nullptr, (bf16*)(wb + WS_WGLU), r, F.lane, scr); continue; } r -= IT_GLU;
        conv_plain(a.in[17] + (size_t)l * D * D, D, D, a.in[15] + l * AW, a.in[16] + l * SW, (bf16*)(wb + WS_WO), r, F.lane, scr);
    }
}
__device__ __forceinline__ void bg_convert(Frame& F, const Args& a, int lo, int hi, int rank, int nranks) {
    if (rank < 0) return;
    LAS unsigned char* scr = F.lds + RING_OFF + F.wave * CONV_LDS;
    for (int it = lo + rank * NWAVES + F.wave; it < hi; it += nranks * NWAVES) {
        int r = it;
        if (r < IT_GU) { conv_gu(a.in[19], a.in[20], a.in[18], (bf16*)(F.ws + WS_DGU), r, F.lane, scr); continue; } r -= IT_GU;
        if (r < IT_DN) { conv_plain(a.in[21], FF, D, nullptr, nullptr, (bf16*)(F.ws + WS_DD), r, F.lane, scr); continue; } r -= IT_DN;
        { const int e = r / IT_GU; r -= e * IT_GU;
          conv_gu(a.in[23] + (size_t)e * D * FF, a.in[24] + (size_t)e * D * FF, a.in[18] + D, (bf16*)(F.ws + WS_MOEW) + (size_t)e * 2 * FF * D, r, F.lane, scr); }
    }
}
__device__ __forceinline__ void moe_wd_convert(Frame& F, const Args& a) {
    LAS unsigned char* scr = F.lds + RING_OFF + F.wave * CONV_LDS;
    const int gw = F.vcu * NWAVES + F.wave, NGW = F.G * NWAVES;
    for (int it = gw; it < NE * IT_DN; it += NGW) { const int e = it / IT_DN, r = it % IT_DN;
        conv_plain(a.in[25] + (size_t)e * FF * D, FF, D, nullptr, nullptr, (bf16*)(F.ws + WS_WDT + (size_t)(e < 7 ? 4 * e : WDT_E7) * WDT_TILEB), r, F.lane, scr); }
}
__device__ __forceinline__ void conv_load2(const float* srcl, int ldn, int k0, float (&v)[CKB]) {
    const float* q = srcl + (size_t)k0 * ldn;
#pragma unroll
    for (int i = 0; i < CKB; ++i) { if ((i & 7) == 0) asm volatile("" : "+v"(q)); v[i] = __builtin_nontemporal_load(q + (size_t)(i & 7) * ldn); if ((i & 7) == 7) q += (size_t)8 * ldn; }
}
__device__ __forceinline__ void conv_store2(float (&v)[CKB], const float* ks, int k0, bf16* dst0, int K, LAS unsigned char* scr, int lane) {
    if (ks) {
#pragma unroll
        for (int i = 0; i < CKB; ++i) v[i] *= ks[k0 + i]; }
#pragma unroll
    for (int j = 0; j < CKB / 8; ++j) { v4u o; o.x = pg8::cvt_pk_bf16(v[8 * j], v[8 * j + 1]); o.y = pg8::cvt_pk_bf16(v[8 * j + 2], v[8 * j + 3]); o.z = pg8::cvt_pk_bf16(v[8 * j + 4], v[8 * j + 5]); o.w = pg8::cvt_pk_bf16(v[8 * j + 6], v[8 * j + 7]);
        *(LAS v4u*)(scr + lane * 144 + j * 16) = o; }
    asm volatile("s_waitcnt lgkmcnt(0)" ::: "memory");
#pragma unroll
    for (int i = 0; i < 8; ++i) { const int row = 8 * i + (lane >> 3), ch = lane & 7; const v4u o = *(const LAS v4u*)(scr + row * 144 + ch * 16);
        *(GAS v4u*)(dst0 + (size_t)row * K + ch * 8) = o; }
    asm volatile("s_waitcnt lgkmcnt(0)" ::: "memory");
}
struct CvI { const float* srcl; const float* ks; bf16* dst0; int ldn, k0, K; };
__device__ __forceinline__ CvI cvi_gu(const float* Wg, const float* Wu, const float* ks, bf16* WT, int item, int lane) {
    const int nblk = 2 * FF / 64, kb = item / nblk, db = item % nblk, drow = 64 * db + lane, pn = drow >> 8, bj = (drow >> 7) & 1, r = drow & 127;
    return CvI{(bj ? Wu : Wg) + 128 * pn + r, ks, WT + (size_t)(64 * db) * D + CKB * kb, FF, CKB * kb, D};
}
__device__ __forceinline__ CvI cvi_plain(const float* W, int K, int N, bf16* WT, int item, int lane) {
    const int nblk = N / 64, kb = item / nblk, nb = item % nblk, k0 = CKB * kb;
    return CvI{W + 64 * nb + lane, nullptr, WT + (size_t)(64 * nb) * K + k0, N, k0, K};
}
template <int WHICH> __device__ __forceinline__ void conv_run2(Frame& F, const Args& a, int first, int step, int hi) {
    LAS unsigned char* scr = F.lds + RING_OFF + F.wave * CONV_LDS;
    auto dec = [&](int it) {
        if (WHICH == 1) { const int e = it / IT_DN, r = it % IT_DN; return cvi_plain(a.in[25] + (size_t)e * FF * D, FF, D, (bf16*)(F.ws + WS_WDT + (size_t)(e < 7 ? 4 * e : WDT_E7) * WDT_TILEB), r, F.lane); }
        int r = it;
        if (r < IT_GU) return cvi_gu(a.in[19], a.in[20], a.in[18], (bf16*)(F.ws + WS_DGU), r, F.lane);
        r -= IT_GU;
        if (r < IT_DN) return cvi_plain(a.in[21], FF, D, (bf16*)(F.ws + WS_DD), r, F.lane);
        r -= IT_DN;
        const int e = r / IT_GU; r -= e * IT_GU;
        return cvi_gu(a.in[23] + (size_t)e * D * FF, a.in[24] + (size_t)e * D * FF, a.in[18] + D, (bf16*)(F.ws + WS_MOEW) + (size_t)e * 2 * FF * D, r, F.lane); };
    if (first >= hi) return;
    static_assert(BG_B6 >= IT_GU + IT_DN, "the left-over background items are all MoE gate|up items (row length FF)");
    constexpr int LDN = WHICH == 1 ? D : FF;
    float va[CKB], vb[CKB];
    CvI ca = dec(first), cb = ca; conv_load2(ca.srcl, LDN, ca.k0, va);
    for (int it = first;; ) {
        const bool nb = it + step < hi; if (nb) { cb = dec(it + step); conv_load2(cb.srcl, LDN, cb.k0, vb); }
        conv_store2(va, ca.ks, ca.k0, ca.dst0, ca.K, scr, F.lane); if (!nb) break; it += step;
        const bool na = it + step < hi; if (na) { ca = dec(it + step); conv_load2(ca.srcl, LDN, ca.k0, va); }
        conv_store2(vb, cb.ks, cb.k0, cb.dst0, cb.K, scr, F.lane); if (!na) break; it += step;
    }
}
__device__ __forceinline__ void p0_xb(Frame& F, const float* x, int rank, int nranks) {
    const int gw = rank * NWAVES + F.wave, NGW = nranks * NWAVES;
    bf16* XB = (bf16*)(F.ws + WS_XB); float* ssq = (float*)(F.ws + WS_SSQ_A);
    for (int m0 = gw * 4; m0 < T; m0 += NGW * 4) {
        f32x4 v[4][4];
#pragma unroll
        for (int r = 0; r < 4; ++r) { const GAS f32x4* xr = (const GAS f32x4*)(x + (size_t)(m0 + r) * D) + F.lane;
#pragma unroll
            for (int j = 0; j < 4; ++j) v[r][j] = __builtin_nontemporal_load(xr + 64 * j); }
#pragma unroll
        for (int r = 0; r < 4; ++r) { float s = 0.f; GAS unsigned long long* o8 = (GAS unsigned long long*)(XB + (size_t)(m0 + r) * D) + F.lane;
#pragma unroll
            for (int j = 0; j < 4; ++j) { const f32x4 w = v[r][j]; s += (w.x * w.x + w.y * w.y) + (w.z * w.z + w.w * w.w);
                o8[64 * j] = (unsigned long long)pk2(w.x, w.y) | ((unsigned long long)pk2(w.z, w.w) << 32); }
            s = wave_sum(s);
            if (F.lane < 16) ssq[(size_t)(m0 + r) * 16 + F.lane] = F.lane == 0 ? s : 0.f; }
    }
}
constexpr size_t SP_TOEP = 0  , SP_PW = 1 * MiB, SP_ACC = 2 * MiB, SP_AC64 = 2 * MiB + 16 * 1024, SP_WSTT = 4 * MiB, SP_WOUTT = 6 * MiB;
constexpr size_t WS_EB = 5 * MiB;
constexpr unsigned EB_TAG = 0x5EED0001u;
__device__ __forceinline__ void ssm_precompute(Frame& F, const Args& a, int l, int g) {
    LAS float* apr = (LAS float*)(F.lds + RING_OFF); LAS float* api = apr + 17 * 64; LAS float* bbr = api + 17 * 64; LAS float* bbi = bbr + 1024; LAS float* cr = bbi + 1024; LAS float* ci = cr + 1024; LAS float* KT = ci + 1024;
    unsigned char* sp = F.ws + WS_SSMPRE + l * SSMPRE_STRIDE;
    bf16* TOEP = (bf16*)(sp + SP_TOEP) + (size_t)g * 8192; bf16* WSTT = (bf16*)(sp + SP_WSTT) + (size_t)g * 32768; bf16* WOUTT = (bf16*)(sp + SP_WOUTT) + (size_t)g * 32768; float* AC = (float*)(sp + SP_ACC) + g * 128;
    const int lg = l * NG + g, tid = F.tid;
    __syncthreads();
    if (tid < 64) { const int n = tid;
        const double lr = a.in[6][lg * 64 + n], li = a.in[7][lg * 64 + n], dt = exp((double)a.in[8][lg]);
        const double mag = exp(lr * dt), ang = li * dt, a1r = mag * cos(ang), a1i = mag * sin(ang);
        double pr = 1.0, pi = 0.0, a16r = 0.0, a16i = 0.0;
        for (int tau = 0; tau <= 16; ++tau) { apr[tau * 64 + n] = (float)pr; api[tau * 64 + n] = (float)pi; if (tau == 16) { a16r = pr; a16i = pi; } const double qr = pr * a1r - pi * a1i, qi = pr * a1i + pi * a1r; pr = qr; pi = qi; }
        { float* PW = (float*)(sp + SP_PW) + (size_t)g * 8192; float* AC64 = (float*)(sp + SP_AC64) + g * 128; double qr = 1.0, qi = 0.0;
          for (int c = 0; c < 64; ++c) { PW[(c * 64 + n) * 2] = (float)qr; PW[(c * 64 + n) * 2 + 1] = (float)qi; const double tr = qr * a16r - qi * a16i, ti = qr * a16i + qi * a16r; qr = tr; qi = ti; }
          AC64[n] = (float)qr; AC64[64 + n] = (float)qi; }
        const double nr = a1r - 1.0, den = lr * lr + li * li, fre = (nr * lr + a1i * li) / den, fim = (a1i * lr - nr * li) / den;
        for (int c = 0; c < 16; ++c) { const double br = a.in[9][(size_t)(lg * 64 + n) * 16 + c], bi = a.in[10][(size_t)(lg * 64 + n) * 16 + c];
            bbr[n * 16 + c] = (float)(fre * br - fim * bi); bbi[n * 16 + c] = (float)(fre * bi + fim * br); }
        AC[n] = apr[16 * 64 + n]; AC[64 + n] = api[16 * 64 + n];
    }
    for (int o = tid; o < 1024; o += 512) { cr[o] = a.in[11][(size_t)lg * 1024 + o]; ci[o] = a.in[12][(size_t)lg * 1024 + o]; }
    __syncthreads();
    {
        const int co = tid >> 5, c = (tid >> 1) & 15, th = tid & 1; float acc8[8];
#pragma unroll
        for (int q = 0; q < 8; ++q) acc8[q] = 0.f;
        for (int n = 0; n < 64; ++n) { const float c_r = cr[co * 64 + n], c_i = ci[co * 64 + n], br = bbr[n * 16 + c], bi = bbi[n * 16 + c];
            const float xr = c_r * br - c_i * bi, xi = c_r * bi + c_i * br;
#pragma unroll
            for (int q = 0; q < 8; ++q) { const int tau = 8 * th + q; acc8[q] += xr * apr[tau * 64 + n] - xi * api[tau * 64 + n]; } }
#pragma unroll
        for (int q = 0; q < 8; ++q) { const int tau = 8 * th + q; float sv = acc8[q]; if (tau == 0 && co == c) sv += a.in[13][l * SW + g * 16 + co]; KT[tau * 256 + co * 16 + c] = sv; }
    }
    __syncthreads();
    for (int o = tid; o < 4096; o += 512) {
        const int col = 224 + (o >> 7), k = (o & 127) * 2, t = col >> 4, co = col & 15, s0 = k >> 4, c0 = k & 15;
        const float v0 = t >= s0 ? KT[(t - s0) * 256 + co * 16 + c0] : 0.f, v1 = t >= s0 ? KT[(t - s0) * 256 + co * 16 + c0 + 1] : 0.f;
        *(unsigned*)(TOEP + (size_t)((((k >> 4) * 64) + ((k >> 3) & 1) * 32 + (col - 224)) * 8 + (k & 7))) = pk2(v0, v1); }
    for (int o = tid; o < 16384; o += 512) {
        const int n2 = o >> 7, k = (o & 127) * 2, n = n2 & 63, sidx = k >> 4, c0 = k & 15; float v[2];
#pragma unroll
        for (int q = 0; q < 2; ++q) { const float pr = apr[(15 - sidx) * 64 + n], pi = api[(15 - sidx) * 64 + n], br = bbr[n * 16 + c0 + q], bi = bbi[n * 16 + c0 + q]; v[q] = (n2 < 64) ? (pr * br - pi * bi) : (pr * bi + pi * br); }
        *(unsigned*)(WSTT + (size_t)(((((n2 >> 5) * 16 + (k >> 4)) * 64) + ((k >> 3) & 1) * 32 + (n2 & 31)) * 8 + (k & 7))) = pk2(v[0], v[1]); }
    for (int o = tid; o < 16384; o += 512) {
        const int col = o >> 6, n = o & 63, tl = col >> 4, co = col & 15;
        const float pr = apr[(tl + 1) * 64 + n], pi = api[(tl + 1) * 64 + n], c_r = cr[co * 64 + n], c_i = ci[co * 64 + n];
        { const int k = 2 * n; *(unsigned*)(WOUTT + (size_t)(((((col >> 5) * 8 + (k >> 4)) * 64) + ((k >> 3) & 1) * 32 + (col & 31)) * 8 + (k & 7))) = pk2(c_r * pr - c_i * pi, -(c_r * pi + c_i * pr)); } }
    __syncthreads();
}

namespace att {
typedef short bf16x8 __attribute__((ext_vector_type(8)));
typedef short s16x4 __attribute__((ext_vector_type(4)));
typedef short v4i16_t __attribute__((ext_vector_type(4)));
typedef float f32x16 __attribute__((ext_vector_type(16)));
typedef unsigned u32x4 __attribute__((ext_vector_type(4)));
typedef __attribute__((address_space(3))) const char* lds_cptr;
constexpr int SLOTB = 8192, BUFB = 6 * SLOTB, LDS_K = 0, LDS_V = 3 * SLOTB, LDS_WS = 2 * BUFB, LDS_OST = LDS_WS + 8 * 64 * 4, LDS_TOTAL = LDS_OST + 8 * 2048;
static_assert(LDS_TOTAL <= RING_BYTES, "attention LDS");
__device__ __forceinline__ int crow(int r, int hi) { return (r & 3) + 8 * (r >> 2) + 4 * hi; }
__device__ __forceinline__ void glds16(const void* gsrc, unsigned lds_dst) { unsigned keep;
    asm volatile("s_mov_b32 %0, m0\n\ts_mov_b32 m0, %2\n\ts_nop 0\n\tglobal_load_lds_dwordx4 %1, off\n\ts_mov_b32 m0, %0" : "=&s"(keep) : "v"(gsrc), "s"(lds_dst) : "memory"); }
typedef float f32x2_t __attribute__((ext_vector_type(2))); typedef __bf16 bf16x2_t __attribute__((ext_vector_type(2)));
__device__ __forceinline__ unsigned cvtpk(float lo, float hi) { f32x2_t v = {lo, hi}; bf16x2_t b = __builtin_convertvector(v, bf16x2_t); return __builtin_bit_cast(unsigned, b); }
__device__ __forceinline__ s16x4 vtr(lds_cptr p) { return __builtin_bit_cast(s16x4, __builtin_amdgcn_ds_read_tr16_b64_v4i16((__attribute__((address_space(3))) v4i16_t*)p)); }
__device__ __forceinline__ float xhalf_max(float m) { auto rr = __builtin_amdgcn_permlane32_swap(__float_as_uint(m), __float_as_uint(m), false, false); return fmaxf(__uint_as_float(rr[0]), __uint_as_float(rr[1])); }
__device__ __forceinline__ float xhalf_sum(float m) { auto rr = __builtin_amdgcn_permlane32_swap(__float_as_uint(m), __float_as_uint(m), false, false); return __uint_as_float(rr[0]) + __uint_as_float(rr[1]); }

struct Ctx { int tid, lane, r32, hi, wid; };
__device__ __forceinline__ void attn_issue(const Ctx& c, int u, int buf, const bf16* QKVU, LAS unsigned char* shm, bf16x8 (&qn)[4]) {
    const int qb = u % (SEQ / 64), kvh = (u / (SEQ / 64)) % NKV, b = u / (NKV * (SEQ / 64));
    const int h = kvh * 4 + (c.wid >> 1), q0 = qb * 64, qw = q0 + 32 * (c.wid & 1);
    const size_t rowbase = (size_t)b * SEQ; const unsigned lds0 = (unsigned)(uintptr_t)shm + buf * BUFB;
#pragma unroll
    for (int j = 0; j < 3; ++j) {
        const int kv0 = q0 - 128 + 64 * j;
        int kr = kv0 + c.lane; kr = kr < 0 ? 0 : kr;
        int vr = kv0 + 16 * (c.wid & 3) + (c.lane >> 2); vr = vr < 0 ? 0 : vr;
        glds16(QKVU + (rowbase + kr) * INW + KOFF + kvh * 64 + c.wid * 8, (unsigned)__builtin_amdgcn_readfirstlane(lds0 + LDS_K + j * SLOTB + c.wid * 1024));
        glds16(QKVU + (rowbase + vr) * INW + VOFF + kvh * 64 + (c.wid >> 2) * 32 + (c.lane & 3) * 8, (unsigned)__builtin_amdgcn_readfirstlane(lds0 + LDS_V + j * SLOTB + c.wid * 1024));
    }
    const bf16* qp = QKVU + (rowbase + qw + c.r32) * INW + QOFF + h * 64 + c.hi * 8;
#pragma unroll
    for (int d0 = 0; d0 < 4; ++d0) qn[d0] = *(const bf16x8*)(qp + d0 * 16);
}
__device__ __forceinline__ void attn_compute(const Ctx& c, int u, int buf, const bf16x8 (&qr)[4], bf16* MIX, float* ssq, const float* sinks, LAS unsigned char* shm0) {
    const int lane = c.lane, r32 = c.r32, hi = c.hi, wid = c.wid;
    const int qb = u % (SEQ / 64), kvh = (u / (SEQ / 64)) % NKV, b = u / (NKV * (SEQ / 64));
    const int h = kvh * 4 + (wid >> 1), qsub = wid & 1, q0 = qb * 64, qw = q0 + 32 * qsub;
    const size_t rowbase = (size_t)b * SEQ;
    LAS unsigned char* shm = shm0 + buf * BUFB;
    const float sink2 = sinks[h] * LOG2E;
    f32x16 p[5];
    const lds_cptr kbase = (lds_cptr)shm + LDS_K + hi * 1024 + r32 * 16;
#pragma unroll
    for (int hb = 0; hb < 5; ++hb) {
        const int G = qsub + hb;
        const lds_cptr kp = kbase + (G >> 1) * SLOTB + (G & 1) * 512;
        f32x16 acc = {};
#pragma unroll
        for (int d0 = 0; d0 < 4; ++d0) { const bf16x8 kf = *(const __attribute__((address_space(3))) bf16x8*)(kp + d0 * 2048); acc = __builtin_amdgcn_mfma_f32_32x32x16_bf16(kf, qr[d0], acc, 0, 0, 0); }
        p[hb] = acc;
    }
    const float NEG = -1.0e30f;
#pragma unroll
    for (int r = 0; r < 16; ++r) { const int cr_ = crow(r, hi); if (!(r32 < cr_)) p[0][r] = NEG; if (!(cr_ <= r32)) p[4][r] = NEG; }
    if (q0 < 128) {
#pragma unroll
        for (int hb = 0; hb < 5; ++hb)
#pragma unroll
            for (int r = 0; r < 16; ++r) { if (qw - 128 + 32 * hb + crow(r, hi) < 0) p[hb][r] = NEG; }
    }
    float m = sink2;
#pragma unroll
    for (int hb = 0; hb < 5; ++hb)
#pragma unroll
        for (int r = 0; r < 16; ++r) m = fmaxf(m, p[hb][r]);
    m = xhalf_max(m);
    float lsum = 0.f;
#pragma unroll
    for (int hb = 0; hb < 5; ++hb)
#pragma unroll
        for (int r = 0; r < 16; ++r) { const float e = __builtin_amdgcn_exp2f(p[hb][r] - m); p[hb][r] = e; lsum += e; }
    lsum = xhalf_sum(lsum) + __builtin_amdgcn_exp2f(sink2 - m);
    f32x16 o[2]; o[0] = f32x16{}; o[1] = f32x16{};
    const lds_cptr vp0 = (lds_cptr)shm + LDS_V + ((lane >> 4) & 1) * 32 + (lane & 3) * 8 + (4 * hi + ((lane & 15) >> 2)) * 64;
#pragma unroll
    for (int hb = 0; hb < 5; ++hb) {
#pragma unroll
        for (int kk = 0; kk < 2; ++kk) {
            const int ko = 32 * (qsub + hb) + 16 * kk, j = ko >> 6, ks = (ko >> 4) & 3;
            u32x4 pw; pw.x = cvtpk(p[hb][8 * kk + 0], p[hb][8 * kk + 1]); pw.y = cvtpk(p[hb][8 * kk + 2], p[hb][8 * kk + 3]); pw.z = cvtpk(p[hb][8 * kk + 4], p[hb][8 * kk + 5]); pw.w = cvtpk(p[hb][8 * kk + 6], p[hb][8 * kk + 7]);
            const bf16x8 pa = __builtin_bit_cast(bf16x8, pw);
#pragma unroll
            for (int d0 = 0; d0 < 2; ++d0) {
                const lds_cptr vp = vp0 + j * SLOTB + d0 * 4096 + ks * 1024;
                const s16x4 lo = vtr(vp), hh = vtr(vp + 512);
                const bf16x8 vf = (bf16x8){lo[0], lo[1], lo[2], lo[3], hh[0], hh[1], hh[2], hh[3]};
                o[d0] = __builtin_amdgcn_mfma_f32_32x32x16_bf16(pa, vf, o[d0], 0, 0, 0);
            }
        }
    }
    LAS float* wsf = (LAS float*)(shm0 + LDS_WS) + wid * 64;
    if (hi == 0) wsf[r32] = lsum;
    asm volatile("s_waitcnt lgkmcnt(0)" ::: "memory");
    float rli[16];
#pragma unroll
    for (int r = 0; r < 16; ++r) rli[r] = __builtin_amdgcn_rcpf(wsf[crow(r, hi)]);
    LAS bf16* stg = (LAS bf16*)(shm0 + LDS_OST) + wid * 1024;
    bf16* Ow = MIX + (rowbase + qw) * D + h * 64;
    float ssrow[2] = {0.f, 0.f};
#pragma unroll
    for (int d0 = 0; d0 < 2; ++d0) {
#pragma unroll
        for (int r = 0; r < 16; ++r) stg[crow(r, hi) * 32 + r32] = (bf16)pg8::cvt_pk_bf16(o[d0][r] * rli[r], 0.f);
        asm volatile("s_waitcnt lgkmcnt(0)" ::: "memory");
#pragma unroll
        for (int i = 0; i < 2; ++i) { const int row = i * 16 + (lane >> 2), ch = lane & 3; const u32x4 v = *(const LAS u32x4*)(stg + row * 32 + ch * 8);
            *(u32x4*)(Ow + (size_t)row * D + d0 * 32 + ch * 8) = v;
            const unsigned w4[4] = {v.x, v.y, v.z, v.w};
#pragma unroll
            for (int k = 0; k < 4; ++k) { const float a = pg8::bf_lo(w4[k]), cc = pg8::bf_hi(w4[k]); ssrow[i] += a * a + cc * cc; } }
        asm volatile("s_waitcnt lgkmcnt(0)" ::: "memory");
    }
#pragma unroll
    for (int i = 0; i < 2; ++i) { float ss = ssrow[i]; ss += __shfl_xor(ss, 1); ss += __shfl_xor(ss, 2); if ((lane & 3) == 0) ssq[(rowbase + qw + i * 16 + (lane >> 2)) * 8 + h] = ss; }
}
}
__device__ __forceinline__ void attn_phase_v1(Frame& F, const Args& a, int l, int first, int count) {
    const int me = (int)blockIdx.x - first; if (me < 0 || me >= count) return;
    const bf16* QKVU = (const bf16*)(F.ws + WS_QKVU); bf16* MIX = (bf16*)(F.ws + WS_MIX); float* ssq = (float*)(F.ws + WS_SSQ_ATT);
    att::Ctx c; { int tid_ = F.tid; asm volatile("" : "+v"(tid_)); c.tid = tid_; c.lane = tid_ & 63; c.r32 = c.lane & 31; c.hi = c.lane >> 5; c.wid = __builtin_amdgcn_readfirstlane(tid_ >> 6); }
    constexpr int NU = BATCH * NKV * (SEQ / 64);
    att::bf16x8 qr[4], qn[4];
    int u = me, it = 0;
    if (u >= NU) return;
    asm volatile("s_waitcnt lgkmcnt(0)\n\ts_barrier" ::: "memory");
    att::attn_issue(c, u, 0, QKVU, F.lds + RING_OFF, qr);
    for (; u < NU; u += count, ++it) {
        const bool has_next = u + count < NU;
        if (has_next) att::attn_issue(c, u + count, (it + 1) & 1, QKVU, F.lds + RING_OFF, qn);
        if (has_next && it > 0) asm volatile("s_waitcnt vmcnt(14)" ::: "memory"); else if (has_next) asm volatile("s_waitcnt vmcnt(10)" ::: "memory"); else asm volatile("s_waitcnt vmcnt(0)" ::: "memory");
        asm volatile("s_barrier" ::: "memory");
        att::attn_compute(c, u, it & 1, qr, MIX, ssq, a.in[5] + l * NH, F.lds + RING_OFF);
        asm volatile("s_waitcnt lgkmcnt(0)\n\ts_barrier" ::: "memory");
#pragma unroll
        for (int d0 = 0; d0 < 4; ++d0) qr[d0] = qn[d0];
    }
}

__device__ __forceinline__ float gelu_tanh(float y) {
    const float t = y * (2.0f * 0.7978845608028654f * LOG2E + (2.0f * 0.7978845608028654f * 0.044715f * LOG2E) * y * y);
    return y - y * __builtin_amdgcn_rcpf(1.0f + __builtin_amdgcn_exp2f(t));
}
namespace ssm {
typedef short bf16x8 __attribute__((ext_vector_type(8)));
typedef float f32x16 __attribute__((ext_vector_type(16)));
constexpr int UST = 528, UBUF = 64 * UST, HST = 272;
constexpr int L_U = 0, L_SL = 2 * UBUF, L_HB = L_SL  , L_TF = L_SL + 64 * 128 * 4, L_END = L_TF + 19 * 1024;
static_assert(L_END <= RING_BYTES, "ssm LDS");
__device__ __forceinline__ int crow(int r, int hi) { return (r & 3) + 8 * (r >> 2) + 4 * hi; }
constexpr int M_U = 0, M_SL = UBUF, M_HB = M_SL + 64 * 128 * 4, M_TF = M_HB + 64 * HST, M_HIN = M_TF + 19 * 1024, M_END = M_HIN + 512;
static_assert(M_END <= RING_BYTES, "ssm LDS (decoupled)");
typedef __attribute__((address_space(1))) unsigned long long gu64s;
__device__ __forceinline__ void ssm_job2(int bg, int sb, int l, unsigned char* ws, LAS unsigned char* shm) {
    int tid_ = threadIdx.x; asm volatile("" : "+v"(tid_));
    const int tid = tid_, lane = tid & 63, r32 = lane & 31, hi = lane >> 5; const int w = __builtin_amdgcn_readfirstlane(tid >> 6);
    const int b = bg / NG, g = bg % NG;
    const bf16* UGp = (const bf16*)(ws + WS_UG); bf16* YG = (bf16*)(ws + WS_YG);
    unsigned char* sp = ws + WS_SSMPRE + l * SSMPRE_STRIDE;
    const bf16* TOEP = (const bf16*)(sp + SP_TOEP) + (size_t)g * 8192; const bf16* WSTT = (const bf16*)(sp + SP_WSTT) + (size_t)g * 32768; const bf16* WOUTT = (const bf16*)(sp + SP_WOUTT) + (size_t)g * 32768;
    const float* AC = (const float*)(sp + SP_ACC) + g * 128; const float* AC64 = (const float*)(sp + SP_AC64) + g * 128; const float* PW = (const float*)(sp + SP_PW) + (size_t)g * 8192;
    gu64s* eb = (gu64s*)(ws + WS_EB) + (size_t)((l * 64 + bg) * 8) * 128;
    const int mt1 = w >> 2, nt1 = w & 3;
    const int J = w < 4 ? w : 11 - w, ns = 2 * J + 2;
    const size_t rowb = (size_t)b * SEQ + (size_t)sb * 1024;
    v4u up[4];
#pragma unroll
    for (int i = 0; i < 4; ++i) { const int pi = tid + 512 * i; up[i] = *(const v4u*)(UGp + ((size_t)g * T + rowb) * GD + (size_t)pi * 8); }
    bf16x8 tfr[2];
#pragma unroll
    for (int i = 0; i < 2; ++i) tfr[i] = *(const bf16x8*)(TOEP + (size_t)((2 * w + i) * 64 + lane) * 8);
    float2 pwv[8];
#pragma unroll
    for (int i = 0; i < 8; ++i) pwv[i] = *(const float2*)(PW + (size_t)(((tid >> 6) + 8 * i) * 64 + (tid & 63)) * 2);
    const float acr = AC[lane], aci = AC[64 + lane], a64r = AC64[lane], a64i = AC64[64 + lane];
    bf16x8 bw1[16], bc[8];
#pragma unroll
    for (int ks = 0; ks < 16; ++ks) bw1[ks] = *(const bf16x8*)(WSTT + (size_t)((nt1 * 16 + ks) * 64 + lane) * 8);
#pragma unroll
    for (int ks = 0; ks < 8; ++ks) bc[ks] = *(const bf16x8*)(WOUTT + (size_t)((J * 8 + ks) * 64 + lane) * 8);
#pragma unroll
    for (int i = 0; i < 4; ++i) { const int pi = tid + 512 * i, row = pi >> 1; *(LAS v4u*)(shm + M_U + (row >> 4) * UST + (row & 15) * 32 + (pi & 1) * 16) = up[i]; }
#pragma unroll
    for (int i = 0; i < 2; ++i) *(LAS bf16x8*)(shm + M_TF + (2 * w + i) * 1024 + lane * 16) = tfr[i];
    if (w < 3) { unsigned z0, z1, z2, z3; asm volatile("v_mov_b32 %0, 0\n\tv_mov_b32 %1, 0\n\tv_mov_b32 %2, 0\n\tv_mov_b32 %3, 0" : "=v"(z0), "=v"(z1), "=v"(z2), "=v"(z3));
        *(LAS v4u*)(shm + M_TF + (16 + w) * 1024 + lane * 16) = (v4u){z0, z1, z2, z3}; }
    asm volatile("s_waitcnt lgkmcnt(0)\n\ts_barrier" ::: "memory");
    const LAS unsigned char* ub = shm + M_U + hi * 16;
    {
        f32x16 acc = {};
#pragma unroll
        for (int ks = 0; ks < 16; ++ks) { const bf16x8 af = *(const LAS bf16x8*)(ub + (32 * mt1 + r32) * UST + ks * 32); acc = __builtin_amdgcn_mfma_f32_32x32x16_bf16(af, bw1[ks], acc, 0, 0, 0); }
        LAS float* sl = (LAS float*)(shm + M_SL);
#pragma unroll
        for (int r = 0; r < 16; ++r) sl[(32 * mt1 + crow(r, hi)) * 128 + 32 * nt1 + r32] = acc[r];
    }
    asm volatile("s_waitcnt lgkmcnt(0)\n\ts_barrier" ::: "memory");
    if (w == 0) {
        LAS float* sl = (LAS float*)(shm + M_SL);
        float pwr[4], pwi[4]; pwr[0] = acr; pwi[0] = aci;
#pragma unroll
        for (int j = 1; j < 4; ++j) { pwr[j] = pwr[j - 1] * acr - pwi[j - 1] * aci; pwi[j] = pwr[j - 1] * aci + pwi[j - 1] * acr; }
        float hr = 0.f, hi_ = 0.f;
        for (int c0 = 0; c0 < 64; c0 += 16) {
            float sr[16], si[16];
#pragma unroll
            for (int i = 0; i < 16; ++i) { sr[i] = sl[(c0 + i) * 128 + lane]; si[i] = sl[(c0 + i) * 128 + 64 + lane]; }
            asm volatile("s_waitcnt lgkmcnt(0)" ::: "memory");
#pragma unroll
            for (int gq = 0; gq < 4; ++gq) {
                float tr[4], ti[4]; tr[0] = sr[4 * gq]; ti[0] = si[4 * gq];
#pragma unroll
                for (int j = 1; j < 4; ++j) { tr[j] = __builtin_fmaf(acr, tr[j - 1], __builtin_fmaf(-aci, ti[j - 1], sr[4 * gq + j])); ti[j] = __builtin_fmaf(acr, ti[j - 1], __builtin_fmaf(aci, tr[j - 1], si[4 * gq + j])); }
                sl[(c0 + 4 * gq) * 128 + lane] = hr; sl[(c0 + 4 * gq) * 128 + 64 + lane] = hi_;
#pragma unroll
                for (int j = 1; j < 4; ++j) { const float xr = __builtin_fmaf(pwr[j - 1], hr, __builtin_fmaf(-pwi[j - 1], hi_, tr[j - 1])), xi = __builtin_fmaf(pwr[j - 1], hi_, __builtin_fmaf(pwi[j - 1], hr, ti[j - 1]));
                    sl[(c0 + 4 * gq + j) * 128 + lane] = xr; sl[(c0 + 4 * gq + j) * 128 + 64 + lane] = xi; }
                const float nr = __builtin_fmaf(pwr[3], hr, __builtin_fmaf(-pwi[3], hi_, tr[3])), ni = __builtin_fmaf(pwr[3], hi_, __builtin_fmaf(pwi[3], hr, ti[3])); hr = nr; hi_ = ni;
            }
        }
        { unsigned tagv; asm volatile("v_mov_b32 %0, %1" : "=v"(tagv) : "s"(EB_TAG));
          __hip_atomic_store(eb + sb * 128 + lane, ((unsigned long long)tagv << 32) | __float_as_uint(hr), __ATOMIC_RELAXED, __HIP_MEMORY_SCOPE_AGENT);
          __hip_atomic_store(eb + sb * 128 + 64 + lane, ((unsigned long long)tagv << 32) | __float_as_uint(hi_), __ATOMIC_RELAXED, __HIP_MEMORY_SCOPE_AGENT); }
        float Hr = 0.f, Hi = 0.f;
        for (int sp_ = 0; sp_ < sb; ++sp_) {
            unsigned long long xr = 0, xi = 0;
            for (unsigned spins = 0;; ++spins) {
                xr = __hip_atomic_load(eb + sp_ * 128 + lane, __ATOMIC_RELAXED, __HIP_MEMORY_SCOPE_AGENT); xi = __hip_atomic_load(eb + sp_ * 128 + 64 + lane, __ATOMIC_RELAXED, __HIP_MEMORY_SCOPE_AGENT);
                const bool ok = (unsigned)(xr >> 32) == EB_TAG && (unsigned)(xi >> 32) == EB_TAG;
                if (__all(ok)) break;
                if (spins > (1u << 20)) break;
                __builtin_amdgcn_s_sleep(2);
            }
            const float er = __uint_as_float((unsigned)xr), ei = __uint_as_float((unsigned)xi);
            const float nr = __builtin_fmaf(a64r, Hr, __builtin_fmaf(-a64i, Hi, er)), ni = __builtin_fmaf(a64r, Hi, __builtin_fmaf(a64i, Hr, ei)); Hr = nr; Hi = ni;
        }
        LAS float* hin = (LAS float*)(shm + M_HIN); hin[lane] = Hr; hin[64 + lane] = Hi;
    }
    f32x16 acc2[2]; acc2[0] = f32x16{}; acc2[1] = f32x16{};
#pragma unroll
    for (int kb = 0; kb < 4; ++kb) { if (4 * kb < ns) {
        bf16x8 bf[4];
#pragma unroll
        for (int q = 0; q < 4; ++q) bf[q] = *(const LAS bf16x8*)(shm + M_TF + (14 - 2 * J + 4 * kb + q) * 1024 + lane * 16);
#pragma unroll
        for (int mt = 0; mt < 2; ++mt) { bf16x8 af[4];
#pragma unroll
            for (int q = 0; q < 4; ++q) af[q] = *(const LAS bf16x8*)(ub + (32 * mt + r32) * UST + (4 * kb + q) * 32);
#pragma unroll
            for (int q = 0; q < 4; ++q) acc2[mt] = __builtin_amdgcn_mfma_f32_32x32x16_bf16(af[q], bf[q], acc2[mt], 0, 0, 0); }
    } }
    asm volatile("s_waitcnt lgkmcnt(0)\n\ts_barrier" ::: "memory");
    {
        const int n = tid & 63, cq = tid >> 6; const LAS float* sl = (const LAS float*)(shm + M_SL); const LAS float* hin = (const LAS float*)(shm + M_HIN);
        const float Hr = hin[n], Hi = hin[64 + n];
#pragma unroll
        for (int i = 0; i < 8; ++i) { const int c = cq + 8 * i; const float2 pw = pwv[i];
            const float xr = sl[c * 128 + n] + pw.x * Hr - pw.y * Hi, xi = sl[c * 128 + 64 + n] + pw.x * Hi + pw.y * Hr;
            *(LAS unsigned*)(shm + M_HB + c * HST + n * 4) = pg8::cvt_pk_bf16(xr, xi); }
    }
    asm volatile("s_waitcnt lgkmcnt(0)\n\ts_barrier" ::: "memory");
#pragma unroll
    for (int ks = 0; ks < 8; ++ks) {
#pragma unroll
        for (int mt = 0; mt < 2; ++mt) { const bf16x8 af = *(const LAS bf16x8*)(shm + M_HB + (32 * mt + r32) * HST + ks * 32 + hi * 16); acc2[mt] = __builtin_amdgcn_mfma_f32_32x32x16_bf16(af, bc[ks], acc2[mt], 0, 0, 0); } }
    {   const int t = 2 * J + (r32 >> 4), co = r32 & 15;
#pragma unroll
        for (int mt = 0; mt < 2; ++mt)
#pragma unroll
            for (int r = 0; r < 16; ++r) { const int chunk = 32 * mt + crow(r, hi);
                YG[(rowb + (size_t)chunk * 16 + t) * SW + 16 * g + co] = (bf16)pg8::cvt_pk_bf16(gelu_tanh(acc2[mt][r]), 0.f); } }
    asm volatile("s_waitcnt lgkmcnt(0)\n\ts_barrier" ::: "memory");
}
}
__device__ __forceinline__ void ssm_phase_v2(Frame& F, int l) {
    for (int j = blockIdx.x; j < BATCH * NG * (SEQ / 1024); j += F.G) ssm::ssm_job2(j % (BATCH * NG), j / (BATCH * NG), l, F.ws, F.lds + RING_OFF);
}

__device__ __forceinline__ void route1(Frame& F, const Args& a) {
    LAS int* hl = (LAS int*)(F.lds + RING_OFF);
    unsigned char* rt = F.ws + WS_ROUTE; int* TOPE = (int*)(rt + RT_TOPE); float* TOPG = (float*)(rt + RT_TOPG); float* RINVT = (float*)(rt + RT_RINVT); int* HIST = (int*)(rt + RT_HIST);
    const float* wr = a.in[22]; const float* gn = a.in[18] + D;
    f32x4 w0[4][4], w1[4][4];
#pragma unroll
    for (int j = 0; j < 4; ++j)
#pragma unroll
        for (int q = 0; q < 4; ++q) { const int k = 4 * (F.lane + 64 * j) + q; const float g = gn[k]; w0[j][q] = *(const f32x4*)(wr + k * 8) * g; w1[j][q] = *(const f32x4*)(wr + k * 8 + 4) * g; }
    for (int blk = blockIdx.x; blk < T / 64; blk += F.G) {
        __syncthreads();
        if (F.tid < 8) hl[F.tid] = 0;
        __syncthreads();
        for (int ib = 0; ib < 8; ib += 2) {
            f32x4 xv4[2][4];
#pragma unroll
            for (int i = 0; i < 2; ++i) { const GAS unsigned long long* xr = (const GAS unsigned long long*)((const bf16*)(F.ws + WS_XB) + (size_t)(blk * 64 + F.wave * 8 + ib + i) * D) + F.lane;
#pragma unroll
                for (int j = 0; j < 4; ++j) { const unsigned long long w = xr[64 * j]; const unsigned lo = (unsigned)w, hi2 = (unsigned)(w >> 32); xv4[i][j] = (f32x4){pg8::bf_lo(lo), pg8::bf_hi(lo), pg8::bf_lo(hi2), pg8::bf_hi(hi2)}; } }
#pragma unroll
            for (int i = 0; i < 2; ++i) {
            const int t = blk * 64 + F.wave * 8 + ib + i;
            f32x4 la = {0.f, 0.f, 0.f, 0.f}, lb = {0.f, 0.f, 0.f, 0.f}; float ss = 0.f;
#pragma unroll
            for (int j = 0; j < 4; ++j) { const f32x4 v = xv4[i][j]; const float xv[4] = {v.x, v.y, v.z, v.w};
#pragma unroll
                for (int q = 0; q < 4; ++q) { ss += xv[q] * xv[q]; la += w0[j][q] * xv[q]; lb += w1[j][q] * xv[q]; } }
            ss = wave_sum(ss);
            float lg[8] = {la.x, la.y, la.z, la.w, lb.x, lb.y, lb.z, lb.w};
#pragma unroll
            for (int e = 0; e < 8; ++e) lg[e] = wave_sum(lg[e]);
            const float rinv = 1.0f / sqrtf(ss * (1.0f / D) + EPS);
            int e1 = 0; float l1 = lg[0];
#pragma unroll
            for (int e = 1; e < 8; ++e) if (lg[e] > l1) { l1 = lg[e]; e1 = e; }
            int e2 = -1; float l2 = -3.0e38f;
#pragma unroll
            for (int e = 0; e < 8; ++e) if (e != e1 && lg[e] > l2) { l2 = lg[e]; e2 = e; }
            const float g2 = 1.0f / (1.0f + __expf((l1 - l2) * rinv)), g1 = 1.0f - g2;
            if (F.lane == 0) { TOPE[t * 2] = e1; TOPE[t * 2 + 1] = e2; TOPG[t * 2] = g1; TOPG[t * 2 + 1] = g2; RINVT[t] = rinv; atomicAdd((int*)&hl[e1], 1); atomicAdd((int*)&hl[e2], 1); }
            }
        }
        __syncthreads();
        if (F.tid < 8) HIST[blk * 8 + F.tid] = hl[F.tid];
    }
    __syncthreads();
}
__device__ __forceinline__ void route2(Frame& F) {
    LAS int* sb = (LAS int*)(F.lds + RING_OFF);
    unsigned char* rt = F.ws + WS_ROUTE; const int* TOPE = (const int*)(rt + RT_TOPE); const float* TOPG = (const float*)(rt + RT_TOPG); const float* RINVT = (const float*)(rt + RT_RINVT); const int* HIST = (const int*)(rt + RT_HIST);
    int* IDX = (int*)(rt + RT_IDX); float* GATE = (float*)(rt + RT_GATE); float* RINVS = (float*)(rt + RT_RINVS); int* POS = (int*)(rt + RT_POS); int* PEND = (int*)(rt + RT_PEND);
    for (int blk = blockIdx.x; blk < T / 64; blk += F.G) {
        __syncthreads();
        if (F.tid < 16) sb[F.tid] = 0;
        __syncthreads();
        if (F.tid < T / 64) {
            const int4 h0 = *(const int4*)(HIST + F.tid * 8), h1 = *(const int4*)(HIST + F.tid * 8 + 4); const int hv[8] = {h0.x, h0.y, h0.z, h0.w, h1.x, h1.y, h1.z, h1.w};
#pragma unroll
            for (int e = 0; e < 8; ++e) { atomicAdd((int*)&sb[e], hv[e]); if (F.tid < blk) atomicAdd((int*)&sb[8 + e], hv[e]); }
        }
        __syncthreads();
        if (F.tid == 0) { int ps = 0; for (int e = 0; e < 8; ++e) { const int pd = (sb[e] + 255) & ~255; sb[16 + e] = ps; sb[24 + e] = pd; ps += pd; if (blk == 0) PEND[e] = ps >> 8; } }
        __syncthreads();
        if (F.wave == 0) {
            const int t = blk * 64 + F.lane; int run[8];
#pragma unroll
            for (int e = 0; e < 8; ++e) run[e] = sb[16 + e] + sb[8 + e];
#pragma unroll
            for (int k = 0; k < 2; ++k) { const int e = TOPE[t * 2 + k]; int slot = 0;
#pragma unroll
                for (int ee = 0; ee < 8; ++ee) { const unsigned long long mk = __ballot(e == ee); const int below = __popcll(mk & ((1ull << F.lane) - 1ull));
                    if (e == ee) slot = run[ee] + below; run[ee] += __popcll(mk); }
                IDX[slot] = t; GATE[slot] = TOPG[t * 2 + k]; RINVS[slot] = RINVT[t]; POS[t * 2 + k] = slot; }
        }
        if (blk == 0) {
            for (int e = 0; e < 8; ++e) { const int s0 = sb[16 + e] + sb[e], s1 = sb[16 + e] + sb[24 + e]; for (int s = s0 + F.tid; s < s1; s += 512) { IDX[s] = 0; GATE[s] = 0.f; RINVS[s] = 0.f; } }
        }
    }
    __syncthreads();
}
__device__ __forceinline__ void moe_combine(Frame& F) {
    const bf16* YS = (const bf16*)(F.ws + WS_YS); const int* POS = (const int*)(F.ws + WS_ROUTE + RT_POS); const float* GATE = (const float*)(F.ws + WS_ROUTE + RT_GATE);
    const unsigned* TM = (const unsigned*)(F.ws + WS_CTL) + CW_TAILMAP; const float* SLAB = (const float*)(F.ws + WS_SLAB);
    const int S = pg8::ks_slices(((const int*)(F.ws + WS_ROUTE + RT_PEND))[7] * (D / 256), F.G);
    const int gw = F.vcu * NWAVES + F.wave, NGW = F.G * NWAVES;
    for (int t = gw; t < T; t += NGW) {
        const int p0 = POS[t * 2], p1 = POS[t * 2 + 1];
        const v4u tm0 = *(const v4u*)(TM + (p0 >> 8) * 4), tm1 = *(const v4u*)(TM + (p1 >> 8) * 4);
        GAS f32x4* xr = (GAS f32x4*)(F.out + (size_t)t * D) + F.lane;
        const GAS unsigned long long* xb = (const GAS unsigned long long*)((const bf16*)(F.ws + WS_XB) + (size_t)t * D) + F.lane;
        const bf16* YS2 = (const bf16*)(F.ws + WS_YS2);
        const GAS unsigned long long* y0 = (const GAS unsigned long long*)(p0 < YS_SPLIT ? YS + (size_t)p0 * D : YS2 + (size_t)(p0 - YS_SPLIT) * D) + F.lane; const GAS unsigned long long* y1 = (const GAS unsigned long long*)(p1 < YS_SPLIT ? YS + (size_t)p1 * D : YS2 + (size_t)(p1 - YS_SPLIT) * D) + F.lane;
        f32x4 v[4]; unsigned long long a0[4], a1[4];
#pragma unroll
        for (int j = 0; j < 4; ++j) { const unsigned long long w = xb[64 * j]; const unsigned lo = (unsigned)w, hi2 = (unsigned)(w >> 32); v[j] = (f32x4){pg8::bf_lo(lo), pg8::bf_hi(lo), pg8::bf_lo(hi2), pg8::bf_hi(hi2)}; a0[j] = y0[64 * j]; a1[j] = y1[64 * j]; }
        const unsigned t0[4] = {tm0.x, tm0.y, tm0.z, tm0.w}, t1[4] = {tm1.x, tm1.y, tm1.z, tm1.w};
#pragma unroll
        for (int j = 0; j < 4; ++j) { f32x4 y = {0.f, 0.f, 0.f, 0.f};
#pragma unroll
            for (int k = 0; k < 2; ++k) { const int p = k ? p1 : p0; const unsigned tm = k ? t1[j] : t0[j]; const unsigned long long aa = k ? a1[j] : a0[j];
                if (tm == 0u) { const unsigned lo = (unsigned)aa, hi = (unsigned)(aa >> 32); y.x += pg8::bf_lo(lo); y.y += pg8::bf_hi(lo); y.z += pg8::bf_lo(hi); y.w += pg8::bf_hi(hi); }
                else {
                    f32x4 a = {0.f, 0.f, 0.f, 0.f}; const float* sp = SLAB + (size_t)(tm - 1u) * S * 65536 + (size_t)(p & 255) * 256 + 4 * F.lane;
                    for (int q = 0; q < S; ++q) a += *(const f32x4*)(sp + (size_t)q * 65536);
                    y += a * GATE[p]; }
            }
            xr[64 * j] = v[j] + y; }
    }
}

__device__ __forceinline__ int wd_quota(int rem, int G) { if (rem == 0) return 0; const int q = (G - rem) * NWAVES * 7; return q < NE * IT_DN ? q : NE * IT_DN; }
constexpr int NPHASE = 19;
__global__ void __launch_bounds__(NWAVES * 64, 2) hymba_fwd(Args args) {
    extern __shared__ __attribute__((aligned(16))) unsigned char lds[];
    Frame F;
    F.lds = (LAS unsigned char*)lds; F.MISC = (volatile LAS unsigned*)(F.lds + MISC_OFF);
    F.tid = threadIdx.x; F.lane = F.tid & 63; F.wave = __builtin_amdgcn_readfirstlane(F.tid >> 6);
    F.G = gridDim.x; { const int bx = blockIdx.x; F.vcu = (F.G % 8 == 0) ? (bx % 8) * (F.G / 8) + bx / 8 : bx; }
    F.ws = args.ws; F.out = args.out; F.ctl = (gu32*)(args.ws + WS_CTL);
    for (int u = F.tid; u < (LDS_BYTES - LDSCTL_OFF) / 4; u += NWAVES * 64) ((LAS unsigned*)(F.lds + LDSCTL_OFF))[u] = 0u;
    __syncthreads();
    const int lo = args.ph_lo, hi = args.ph_hi;
    XcdBarrier bar; bar.bar = (unsigned*)(F.ctl + CW_BAR); bar.x = 0; bar.st = nullptr;
    if (hi - lo > 1) bar = xcd_barrier_post((unsigned*)(F.ctl + CW_BAR), F.MISC + 8);
#ifndef PH_MASK
#define PH_MASK 0x7FFFF
#endif
#define IN(k) (((PH_MASK >> (k)) & 1) && lo <= (k) && (k) < hi)
#define SEAM(k) do { if ((k) + 1 < hi) xcd_barrier(bar); } while (0)
#ifndef PH_TWICE
#define PH_TWICE 0
#endif
#define REP(k) for (int rep_ = 0; rep_ < 1 + ((PH_TWICE >> (k)) & 1); ++rep_)
#define REPSEAM() do { if (rep_ == 0 && hi - lo > 1) xcd_barrier(bar); } while (0)
    unsigned char* ws = args.ws;
#define PH() do { GAS unsigned char* w_ = (GAS unsigned char*)args.ws; GAS float* o_ = (GAS float*)args.out; int t_ = threadIdx.x; asm volatile("" : "+s"(w_), "+s"(o_), "+v"(t_)); F.ws = (unsigned char*)w_; F.out = (float*)o_; F.tid = t_; F.lane = t_ & 63; ws = (unsigned char*)w_; } while (0)
#define XB_ ((bf16*)(ws + WS_XB))
#define QKVU_ ((bf16*)(ws + WS_QKVU))
#define MIX_ ((bf16*)(ws + WS_MIX))
#define YG_ ((bf16*)(ws + WS_YG))
#define SSQ_A_ ((float*)(ws + WS_SSQ_A))
#define SSQ_F_ ((float*)(ws + WS_SSQ_F))
#define SSQ_ATT_ ((float*)(ws + WS_SSQ_ATT))
#define SSQ_SSM_ ((float*)(ws + WS_SSQ_SSM))

    if (IN(0)) REP(0) {
        PH();
        if ((int)blockIdx.x < 2 * NG) ssm_precompute(F, args, (int)blockIdx.x / NG, (int)blockIdx.x % NG);
        else { { v4u* ebz = (v4u*)(ws + WS_EB); for (int i = ((int)blockIdx.x - 2 * NG) * 512 + F.tid; i < 65536; i += (F.G - 2 * NG) * 512) ebz[i] = (v4u){0u, 0u, 0u, 0u}; }
               p0_convert(F, args, (int)blockIdx.x - 2 * NG, F.G - 2 * NG); p0_xb(F, args.in[0], (int)blockIdx.x - 2 * NG, F.G - 2 * NG); }
        SEAM(0);
    }
    for (int l = 0; l < 2; ++l) {
        const int pb = l == 0 ? 1 : 8;
        if (IN(pb)) REP(pb) {
            PH(); unsigned char* wb = ws + WS_WSMALL + l * WSMALL_STRIDE;
            pg8::Gemm g{XB_, (const bf16*)(wb + WS_WIN), nullptr}; pg8::StaticOrder S; S.init(T, INW, F.G, (int)blockIdx.x);
            pg8::EpiInProj E{QKVU_, (bf16*)(ws + WS_UG), SSQ_A_, args.in[3] + l * HD, args.in[4] + l * HD, 0.125f * LOG2E};
            pg8::gemm_phase<pg8::EpiInProj, pg8::StaticOrder, false, D>(F.lds + RING_OFF, g, S, E);
            bg_convert(F, args, l == 0 ? 0 : BG_B3, l == 0 ? BG_B1 : BG_B4, (int)blockIdx.x - 64, F.G - 64);
            SEAM(pb);
        }
        if (IN(pb + 1)) REP(pb + 1) { PH(); ssm_phase_v2(F, l); attn_phase_v1(F, args, l, 0, F.G); bg_convert(F, args, l == 0 ? BG_B1 : BG_B4, l == 0 ? BG_B2 : BG_B5, (int)blockIdx.x, F.G); SEAM(pb + 1); }
        if (IN(pb + 3)) REP(pb + 3) {
            PH(); unsigned char* wb = ws + WS_WSMALL + l * WSMALL_STRIDE;
            pg8::Gemm g{YG_, (const bf16*)(wb + WS_WGLU), nullptr}; pg8::StaticOrder S; S.init(T, SW, F.G, (int)blockIdx.x);
            pg8::EpiGlu E{YG_, MIX_, SSQ_SSM_};
            pg8::gemm_phase<pg8::EpiGlu, pg8::StaticOrder, false, SW>(F.lds + RING_OFF, g, S, E);
            bg_convert(F, args, l == 0 ? BG_B2 : BG_B5, l == 0 ? BG_B3 : BG_B6, (int)blockIdx.x - 128, F.G - 128);
            SEAM(pb + 3);
        }
        if (IN(pb + 4)) REP(pb + 4) {
            PH(); unsigned char* wb = ws + WS_WSMALL + l * WSMALL_STRIDE;
            pg8::Gemm g{MIX_, (const bf16*)(wb + WS_WO), nullptr}; pg8::StaticOrder S; S.init(T, D, F.G, (int)blockIdx.x);
            pg8::EpiRes<true, false> E{nullptr, XB_, SSQ_F_, SSQ_ATT_, SSQ_SSM_, (LAS float*)(F.lds + TAB_OFF)};
            pg8::gemm_phase<pg8::EpiRes<true, false>, pg8::StaticOrder, false, D>(F.lds + RING_OFF, g, S, E);
            SEAM(pb + 4);
        }
    if (l == 0) {
        if (IN(6)) REP(6) {
            PH();
            pg8::Gemm g{XB_, (const bf16*)(ws + WS_DGU), nullptr}; pg8::StaticOrder S; S.init(T, 2 * FF, F.G, (int)blockIdx.x);
            pg8::EpiSwiglu<false> E{(bf16*)(ws + WS_HD), nullptr, (LAS float*)(F.lds + TAB2_OFF)};
            pg8::fill_rinv_tab(S, SSQ_F_, (LAS float*)(F.lds + TAB2_OFF), F.tid, TAB2_UNITS);
            pg8::gemm_phase<pg8::EpiSwiglu<false>, pg8::StaticOrder, false, D>(F.lds + RING_OFF, g, S, E);
            SEAM(6);
        }
        if (IN(7)) REP(7) {
            PH();
            pg8::Gemm g{(const bf16*)(ws + WS_HD), (const bf16*)(ws + WS_DD), nullptr}; pg8::StaticOrder S; S.init(T, D, F.G, (int)blockIdx.x);
            pg8::EpiRes<false, false> E{nullptr, XB_, SSQ_A_, nullptr, nullptr, (LAS float*)(F.lds + TAB_OFF)};
            pg8::gemm_phase<pg8::EpiRes<false, false>, pg8::StaticOrder, false, FF>(F.lds + RING_OFF, g, S, E);
            SEAM(7);
        }
    } else {
        if (IN(13)) REP(13) { PH(); route1(F, args); SEAM(13); }
        if (IN(14)) REP(14) { PH(); route2(F); conv_run2<0>(F, args, BG_B6 + (int)blockIdx.x * NWAVES + F.wave, F.G * NWAVES, IT_BG); SEAM(14); }
        if (IN(15)) REP(15) {
            PH(); unsigned char* rt = ws + WS_ROUTE;
            pg8::Gemm g{XB_, (const bf16*)(ws + WS_MOEW), (const int*)(rt + RT_IDX)}; pg8::MoeOrder S; S.init((const int*)(rt + RT_PEND), 2 * FF, F.G, (int)blockIdx.x);
            pg8::EpiSwiglu<true> E{(bf16*)(ws + WS_HS), (const float*)(rt + RT_RINVS), nullptr};
            pg8::gemm_phase<pg8::EpiSwiglu<true>, pg8::MoeOrder, true, D>(F.lds + RING_OFF, g, S, E);
            { const int rem = S.nwg % F.G, q = wd_quota(rem, F.G);
              if (rem && (int)blockIdx.x >= rem) conv_run2<1>(F, args, ((int)blockIdx.x - rem) * NWAVES + F.wave, (F.G - rem) * NWAVES, q); }
            SEAM(15);
        }
        if (IN(16)) REP(16) { PH(); const int nwgu = ((const int*)(ws + WS_ROUTE + RT_PEND))[7] * (2 * FF / 256), q = wd_quota(nwgu % F.G, F.G);
            if (q < NE * IT_DN) { conv_run2<1>(F, args, q + F.vcu * NWAVES + F.wave, F.G * NWAVES, NE * IT_DN); SEAM(16); } }
        if (IN(17)) REP(17) {
            PH(); unsigned char* rt = ws + WS_ROUTE;
            pg8::Gemm g{(const bf16*)(ws + WS_HS), (const bf16*)(ws + WS_WDT), nullptr}; pg8::MoeOrderSplit<FF / 64> S; S.init((const int*)(rt + RT_PEND), D, F.G, (int)blockIdx.x, WDT_E7);
            pg8::EpiMoeDown E{(bf16*)(ws + WS_YS), (bf16*)(ws + WS_YS2), YS_SPLIT, (const float*)(rt + RT_GATE), (float*)(ws + WS_SLAB), (unsigned*)(ws + WS_CTL) + CW_TAILMAP, S.S};
            pg8::gemm_phase<pg8::EpiMoeDown, pg8::MoeOrderSplit<FF / 64>, false, FF>(F.lds + RING_OFF, g, S, E);
            SEAM(17);
        }
        if (IN(18)) REP(18) { PH(); moe_combine(F); }
    }
    }
#undef IN
#undef SEAM
}

extern "C" void kernel_launch(void* const* d_in, const int* in_sizes, int n_in, void* d_out, int out_size, void* d_ws, size_t ws_size, hipStream_t stream) {
    static int grid = 0;
    if (grid == 0) {
        if (n_in != 26 || in_sizes[0] != T * D || out_size != T * D || ws_size < WS_END) { fprintf(stderr, "kernel_launch: unexpected shapes/workspace (n_in %d, in0 %d, out %d, ws %zu, need %zu); nothing launched\n", n_in, n_in > 0 ? in_sizes[0] : -1, out_size, ws_size, (size_t)WS_END); grid = -1; return; }
        int dev = 0, cus = 0, per_cu = 0;
        if (hipGetDevice(&dev) != hipSuccess || hipDeviceGetAttribute(&cus, hipDeviceAttributeMultiprocessorCount, dev) != hipSuccess) { grid = -1; return; }
        if (hipFuncSetAttribute((const void*)hymba_fwd, hipFuncAttributeMaxDynamicSharedMemorySize, LDS_BYTES) != hipSuccess) { fprintf(stderr, "kernel_launch: hipFuncSetAttribute failed\n"); grid = -1; return; }
        if (hipOccupancyMaxActiveBlocksPerMultiprocessor(&per_cu, (const void*)hymba_fwd, NWAVES * 64, LDS_BYTES) != hipSuccess || per_cu < 1) { fprintf(stderr, "kernel_launch: occupancy query reports %d workgroups per CU\n", per_cu); (void)hipGetLastError(); grid = -1; return; }
        grid = cus;
    }
    if (grid < 0) return;
    (void)hipMemsetAsync((char*)d_ws + WS_CTL, 0, CTL_ZERO_BYTES, stream);
    Args a{};
    for (int i = 0; i < 26; ++i) a.in[i] = (const float*)d_in[i];
    a.out = (float*)d_out; a.ws = (unsigned char*)d_ws;
#if MK_N_LAUNCHES == 1
    a.ph_lo = 0; a.ph_hi = NPHASE;
    hipLaunchKernelGGL(hymba_fwd, dim3(grid), dim3(NWAVES * 64), LDS_BYTES, stream, a);
#else
    for (int p = 0; p < NPHASE; ++p) { a.ph_lo = p; a.ph_hi = p + 1; hipLaunchKernelGGL(hymba_fwd, dim3(grid), dim3(NWAVES * 64), LDS_BYTES, stream, a); }
#endif
}
```

```cpp
#include <hip/hip_runtime.h>
#include <cstdio>
#include <cstdint>

#ifndef MK_N_LAUNCHES
#define MK_N_LAUNCHES 1
#endif

constexpr int BATCH = 2, SEQ = 8192, T = BATCH * SEQ, D = 1024, INW = 1280, FF = 3584, NE = 8;
constexpr int NH = 8, NKV = 2, HD = 64, AW = 512, KVW = 128, SW = 512, NG = 32, GD = 16, NS = 64, WIN = 128;
constexpr int QOFF = 0, KOFF = 512, VOFF = 640, UOFF = 768;
constexpr float EPS = 1e-6f;
constexpr float LOG2E = 1.4426950408889634f;
constexpr int CAP = 2 * T + NE * 256;
constexpr int CN = 16;

namespace pg8 {
#define PG8_LAS __attribute__((address_space(3)))
typedef unsigned short bf16_t;
typedef short bf16x8 __attribute__((ext_vector_type(8)));
typedef float f32x4 __attribute__((ext_vector_type(4)));
typedef float f32x2 __attribute__((ext_vector_type(2)));
typedef unsigned u32x4 __attribute__((ext_vector_type(4)));
typedef unsigned u32x2 __attribute__((ext_vector_type(2)));
constexpr int BM = 256, BK = 64, HALF = 128, HTB = HALF * BK * 2, STAGE_BYTES = 8 * HTB, NXCD = 8, WGM = 8;

__host__ __device__ __forceinline__ int lds_byte(int r, int c) { const int st = (r >> 4) * 2 + (c >> 5), rr = r & 15, cc = c & 31, ob = rr * 64 + cc * 2; return st * 1024 + (ob ^ (((ob >> 9) & 1) << 5)); }
__host__ __device__ __forceinline__ void stage_rc(int b, int& R, int& C) { const int st = b / 1024, sb = b % 1024, swz = sb ^ (((sb >> 9) & 1) << 5); R = (st >> 1) * 16 + swz / 64; C = (st & 1) * 32 + (swz % 64) / 2; }
__host__ __device__ __forceinline__ int perm32(int rho) { const int n = rho >> 4, i = rho & 15; return 8 * (i >> 2) + 4 * n + (i & 3); }

struct Unit { int pm, pn, pb, k0, nk, sl; };
struct Gemm { const bf16_t* A; const bf16_t* Bt; const int* idx; };

struct StaticOrder {
    static constexpr bool KSPLIT = false;
    int nM, nN, nwg, G, c;
    __device__ void init(int M, int N, int G_, int c_) { nM = M / BM; nN = N / BM; nwg = nM * nN; G = G_; c = c_; }
    __device__ bool next(int i, Unit& u) const {
        const long L = (long)i * G + c; if (L >= nwg) return false;
        int wgid = (int)L; { const int q = nwg / NXCD, r = nwg % NXCD, xcd = wgid % NXCD, off = wgid / NXCD; wgid = (xcd < r ? xcd * (q + 1) : r * (q + 1) + (xcd - r) * q) + off; }
        const int nig = WGM * nN, gid = wgid / nig, fm = gid * WGM, gsz = (nM - fm) < WGM ? (nM - fm) : WGM;
        u.pm = fm + ((wgid % nig) % gsz); u.pn = (wgid % nig) / gsz; u.pb = u.pn; return true;
    }
};
struct MoeOrder {
    static constexpr bool KSPLIT = false;
    int nM, nN, nwg, G, c; int pend[8];
    __device__ void init(const int* pendg, int N, int G_, int c_) {
#pragma unroll
        for (int e = 0; e < 8; ++e) pend[e] = __builtin_amdgcn_readfirstlane(pendg[e]);
        nM = pend[7]; nN = N / BM; nwg = nM * nN; G = G_; c = c_; }
    __device__ bool next(int i, Unit& u) const {
        const long L = (long)i * G + c; if (L >= nwg) return false;
        int wgid = (int)L; { const int q = nwg / NXCD, r = nwg % NXCD, xcd = wgid % NXCD, off = wgid / NXCD; wgid = (xcd < r ? xcd * (q + 1) : r * (q + 1) + (xcd - r) * q) + off; }
        const int nig = WGM * nN, gid = wgid / nig, fm = gid * WGM, gsz = (nM - fm) < WGM ? (nM - fm) : WGM;
        u.pm = fm + ((wgid % nig) % gsz); u.pn = (wgid % nig) / gsz;
        int e = 0;
#pragma unroll
        for (int k = 0; k < 7; ++k) e += (pend[k] <= u.pm) ? 1 : 0;
        u.pb = e * nN + u.pn; return true;
    }
};

constexpr int KS_MAXSLAB = 144, KS_MAXS = 8;
__device__ __forceinline__ int ks_slices(int nwg, int G) { const int rem = nwg % G; if (rem == 0) return 1; int S = G / rem; S = S > KS_MAXS ? KS_MAXS : S; if (S * rem > KS_MAXSLAB) S = KS_MAXSLAB / rem; return S < 2 ? 1 : S; }
template <int NT> struct MoeOrderSplit {
    static constexpr bool KSPLIT = true;
    int nM, nN, nwg, G, c, nfull, S, e7tile; int pend[8];
    __device__ void init(const int* pendg, int N, int G_, int c_, int e7tile_) { e7tile = e7tile_;
#pragma unroll
        for (int e = 0; e < 8; ++e) pend[e] = __builtin_amdgcn_readfirstlane(pendg[e]);
        nM = pend[7]; nN = N / BM; nwg = nM * nN; G = G_; c = c_; S = ks_slices(nwg, G); nfull = S > 1 ? (nwg / G) * G : nwg; }
    __device__ bool next(int i, Unit& u) const {
        const long L = (long)i * G + c; int wgid, sl = -1, s = 0;
        if (L < nfull) wgid = (int)L; else { const int j = (int)(L - nfull); if (j >= (nwg - nfull) * S) return false; wgid = nfull + j / S; s = j % S; sl = j; }
        { const int q = nwg / NXCD, r = nwg % NXCD, xcd = wgid % NXCD, off = wgid / NXCD; wgid = (xcd < r ? xcd * (q + 1) : r * (q + 1) + (xcd - r) * q) + off; }
        const int nig = WGM * nN, gid = wgid / nig, fm = gid * WGM, gsz = (nM - fm) < WGM ? (nM - fm) : WGM;
        u.pm = fm + ((wgid % nig) % gsz); u.pn = (wgid % nig) / gsz;
        int e = 0;
#pragma unroll
        for (int k = 0; k < 7; ++k) e += (pend[k] <= u.pm) ? 1 : 0;
        u.pb = (e < 7 ? e * nN : e7tile) + u.pn; u.sl = sl;
        if (sl < 0) { u.k0 = 0; u.nk = NT; } else { const int p0 = (NT / 2) * s / S, p1 = (NT / 2) * (s + 1) / S; u.k0 = 2 * p0; u.nk = 2 * (p1 - p0); }
        return true;
    }
};

__device__ __forceinline__ unsigned cvt_pk_bf16(float lo, float hi) { unsigned r; asm volatile("v_cvt_pk_bf16_f32 %0, %1, %2" : "=v"(r) : "v"(lo), "v"(hi)); return r; }
__device__ __forceinline__ float bf_lo(unsigned w) { return __uint_as_float(w << 16); }
__device__ __forceinline__ float bf_hi(unsigned w) { return __uint_as_float(w & 0xffff0000u); }
__device__ __forceinline__ float sum4(const float* p) { const f32x4 v = *(const f32x4*)p; return (v[0] + v[1]) + (v[2] + v[3]); }
__device__ __forceinline__ float sum16(const float* p) { return (sum4(p) + sum4(p + 4)) + (sum4(p + 8) + sum4(p + 12)); }
__device__ __forceinline__ float sum8(const float* p) { return sum4(p) + sum4(p + 4); }

struct EpiInProj {
    static constexpr bool PERM = true, MID = false; static constexpr int MID_T = 0;
    bf16_t* O; bf16_t* UG; const float* ssq; const float* gq; const float* gk; float qscale;
    struct State {};
    __device__ __forceinline__ void begin(const Unit&, int, int, State&) const {}
    __device__ __forceinline__ void mid(f32x4 (&)[2][2][4][2], const Unit&, int, int, int, int, int, State&) const {}
    __device__ __forceinline__ void operator()(const f32x4 (&acc)[2][2][4][2], const Unit& u, int ui, int wr, int wc, int fr, int fq, const State& est) const {
        const int row0 = u.pm * BM + wr * 64 + fr, tcol0 = u.pn * BM + 64 * wc;
        const int kind = tcol0 < KOFF ? 0 : (tcol0 < VOFF ? 1 : 2);
        f32x4 gv[2][2];
        if (kind < 2) { const float* g = kind == 0 ? gq : gk;
#pragma unroll
            for (int bj = 0; bj < 2; ++bj)
#pragma unroll
                for (int n = 0; n < 2; ++n) gv[bj][n] = *(const f32x4*)(g + 32 * bj + 8 * fq + 4 * n); }
#pragma unroll
        for (int ai = 0; ai < 2; ++ai) {
            float rinv4[4];
#pragma unroll
            for (int m = 0; m < 4; ++m) rinv4[m] = __builtin_amdgcn_rsqf(sum16(ssq + (size_t)(row0 + ai * HALF + m * 16) * 16) * (1.0f / D) + EPS);
            asm volatile("" : "+v"(rinv4[0]), "+v"(rinv4[1]), "+v"(rinv4[2]), "+v"(rinv4[3]));
#pragma unroll
            for (int m = 0; m < 4; ++m) {
                const int row = row0 + ai * HALF + m * 16;
                const float rinv = rinv4[m];
                f32x4 v[2][2];
#pragma unroll
                for (int bj = 0; bj < 2; ++bj)
#pragma unroll
                    for (int n = 0; n < 2; ++n) v[bj][n] = acc[ai][bj][m][n] * rinv;
                if (kind < 2) {
                    float ss = 0.f;
#pragma unroll
                    for (int bj = 0; bj < 2; ++bj)
#pragma unroll
                        for (int n = 0; n < 2; ++n) { const f32x4 x = v[bj][n]; ss += (x[0] * x[0] + x[1] * x[1]) + (x[2] * x[2] + x[3] * x[3]); }
                    ss += __shfl_xor(ss, 16); ss += __shfl_xor(ss, 32);
                    const float hr = __builtin_amdgcn_rsqf(ss * (1.0f / HD) + EPS) * (kind == 0 ? qscale : 1.0f);
#pragma unroll
                    for (int bj = 0; bj < 2; ++bj)
#pragma unroll
                        for (int n = 0; n < 2; ++n) v[bj][n] = v[bj][n] * gv[bj][n] * hr;
                }
                bf16_t* rowp = O + (size_t)row * INW + tcol0 + 8 * fq;
#pragma unroll
                for (int bj = 0; bj < 2; ++bj) { u32x4 w; w.x = cvt_pk_bf16(v[bj][0][0], v[bj][0][1]); w.y = cvt_pk_bf16(v[bj][0][2], v[bj][0][3]); w.z = cvt_pk_bf16(v[bj][1][0], v[bj][1][1]); w.w = cvt_pk_bf16(v[bj][1][2], v[bj][1][3]);
                    if (tcol0 >= UOFF) { const int uc = tcol0 - UOFF + 32 * bj + 8 * fq;
                        *(u32x4*)(UG + ((size_t)(uc >> 4) * T + row) * GD + (uc & 15)) = w; }
                    else *(u32x4*)(rowp + 32 * bj) = w; }
            }
        }
    }
};
struct EpiGlu {
    static constexpr bool PERM = true, MID = false; static constexpr int MID_T = 0;
    const bf16_t* Y; bf16_t* MIX; float* ssq;
    struct State {};
    __device__ __forceinline__ void begin(const Unit&, int, int, State&) const {}
    __device__ __forceinline__ void mid(f32x4 (&)[2][2][4][2], const Unit&, int, int, int, int, int, State&) const {}
    __device__ __forceinline__ void operator()(const f32x4 (&acc)[2][2][4][2], const Unit& u, int ui, int wr, int wc, int fr, int fq, const State& est) const {
        const int row0 = u.pm * BM + wr * 64 + fr, col0 = u.pn * BM + wc * 32 + 8 * fq;
#pragma unroll
        for (int ai = 0; ai < 2; ++ai) {
            u32x4 yall[4][2];
#pragma unroll
            for (int m = 0; m < 4; ++m)
#pragma unroll
                for (int bj = 0; bj < 2; ++bj) yall[m][bj] = *(const u32x4*)(Y + (size_t)(row0 + ai * HALF + m * 16) * SW + col0 + bj * HALF);
#pragma unroll
            for (int m = 0; m < 4; ++m) {
                const int row = row0 + ai * HALF + m * 16; float ss = 0.f;
#pragma unroll
                for (int bj = 0; bj < 2; ++bj) {
                    const u32x4 yw = yall[m][bj];
                    const float y[8] = {bf_lo(yw.x), bf_hi(yw.x), bf_lo(yw.y), bf_hi(yw.y), bf_lo(yw.z), bf_hi(yw.z), bf_lo(yw.w), bf_hi(yw.w)};
                    float s[8];
#pragma unroll
                    for (int n = 0; n < 2; ++n)
#pragma unroll
                        for (int j = 0; j < 4; ++j) { const float g = acc[ai][bj][m][n][j]; const float o = y[4 * n + j] * __builtin_amdgcn_rcpf(1.0f + __builtin_amdgcn_exp2f(-LOG2E * g)); s[4 * n + j] = o; ss += o * o; }
                    u32x4 w; w.x = cvt_pk_bf16(s[0], s[1]); w.y = cvt_pk_bf16(s[2], s[3]); w.z = cvt_pk_bf16(s[4], s[5]); w.w = cvt_pk_bf16(s[6], s[7]);
                    *(u32x4*)(MIX + (size_t)row * D + AW + col0 + bj * HALF) = w;
                }
                ss += __shfl_xor(ss, 16); ss += __shfl_xor(ss, 32);
                if (fq == 0) ssq[(size_t)row * 8 + u.pn * 4 + wc] = ss;
            }
        }
    }
};
template <bool WO, bool RESF32> struct EpiRes {
    static constexpr bool PERM = true, MID = WO; static constexpr int MID_T = 8;
    const float* res; bf16_t* XB; float* ssq_out; const float* ssq_a; const float* ssq_s;
    PG8_LAS float* tab;
    struct State {};
    __device__ __forceinline__ void begin(const Unit& u, int ui, int tid, State&) const {
        if (WO) { if (tid < BM) { const int row = u.pm * BM + tid;
            const float ra = 1.0f / sqrtf(sum8(ssq_a + (size_t)row * 8) * (1.0f / AW) + EPS), rs = 1.0f / sqrtf(sum8(ssq_s + (size_t)row * 8) * (1.0f / SW) + EPS);
            *(PG8_LAS f32x2*)(tab + ((ui & 1) * BM + tid) * 2) = (f32x2){ra / rs, rs}; } }
    }
    __device__ __forceinline__ void mid(f32x4 (&acc)[2][2][4][2], const Unit& u, int ui, int wr, int wc, int fr, int fq, State&) const {
        const int r0 = wr * 64 + fr;
#pragma unroll
        for (int ai = 0; ai < 2; ++ai)
#pragma unroll
            for (int m = 0; m < 4; ++m) {
                const float f = tab[((ui & 1) * BM + r0 + ai * HALF + m * 16) * 2];
#pragma unroll
                for (int bj = 0; bj < 2; ++bj)
#pragma unroll
                    for (int n = 0; n < 2; ++n) acc[ai][bj][m][n] *= f;
            }
    }
    __device__ __forceinline__ void operator()(const f32x4 (&acc)[2][2][4][2], const Unit& u, int ui, int wr, int wc, int fr, int fq, const State& est) const {
        const int r0 = wr * 64 + fr, row0 = u.pm * BM + r0, col0 = u.pn * BM + wc * 32 + 8 * fq;
        constexpr int NB = RESF32 ? 2 : 4;
#pragma unroll
        for (int b0 = 0; b0 < 8; b0 += NB) {
            f32x4 rf[NB][2][2]; u32x4 rb[NB][2];
#pragma unroll
            for (int q = 0; q < NB; ++q) { const int ai = (b0 + q) >> 2, m = (b0 + q) & 3; const size_t off = (size_t)(row0 + ai * HALF + m * 16) * D + col0;
#pragma unroll
                for (int bj = 0; bj < 2; ++bj) { if (RESF32) { rf[q][bj][0] = *(const f32x4*)(res + off + bj * HALF); rf[q][bj][1] = *(const f32x4*)(res + off + bj * HALF + 4); } else rb[q][bj] = *(const u32x4*)(XB + off + bj * HALF); } }
#pragma unroll
            for (int q = 0; q < NB; ++q) { const int ai = (b0 + q) >> 2, m = (b0 + q) & 3, row = row0 + ai * HALF + m * 16; float ss = 0.f;
                float sc = 1.0f; if (WO) sc = tab[((ui & 1) * BM + r0 + ai * HALF + m * 16) * 2 + 1];
#pragma unroll
                for (int bj = 0; bj < 2; ++bj) {
                    f32x4 r0v, r1v;
                    if (RESF32) { r0v = rf[q][bj][0]; r1v = rf[q][bj][1]; }
                    else { const u32x4 w = rb[q][bj]; r0v = (f32x4){bf_lo(w.x), bf_hi(w.x), bf_lo(w.y), bf_hi(w.y)}; r1v = (f32x4){bf_lo(w.z), bf_hi(w.z), bf_lo(w.w), bf_hi(w.w)}; }
                    const f32x4 o0 = r0v + acc[ai][bj][m][0] * sc, o1 = r1v + acc[ai][bj][m][1] * sc;
                    u32x4 w; w.x = cvt_pk_bf16(o0[0], o0[1]); w.y = cvt_pk_bf16(o0[2], o0[3]); w.z = cvt_pk_bf16(o1[0], o1[1]); w.w = cvt_pk_bf16(o1[2], o1[3]);
                    *(u32x4*)(XB + (size_t)row * D + col0 + bj * HALF) = w;
                    ss += ((o0[0] * o0[0] + o0[1] * o0[1]) + (o0[2] * o0[2] + o0[3] * o0[3])) + ((o1[0] * o1[0] + o1[1] * o1[1]) + (o1[2] * o1[2] + o1[3] * o1[3]));
                }
                ss += __shfl_xor(ss, 16); ss += __shfl_xor(ss, 32);
                if (fq == 0) ssq_out[(size_t)row * 16 + u.pn * 4 + wc] = ss;
            }
        }
    }
};
template <bool MOE> struct EpiSwiglu {
    static constexpr bool PERM = true, MID = false; static constexpr int MID_T = 0;
    bf16_t* H; const float* rs;
    PG8_LAS float* tab;
    struct State { float r[MOE ? 8 : 1]; };
    __device__ __forceinline__ void begin(const Unit& u, int ui, int tid, State& st) const {
        if (MOE) { const int wid = tid >> 6, lane = tid & 63, row0 = u.pm * BM + (wid >> 2) * 64 + (lane & 15);
#pragma unroll
            for (int ai = 0; ai < 2; ++ai)
#pragma unroll
                for (int m = 0; m < 4; ++m) st.r[ai * 4 + m] = rs[row0 + ai * HALF + m * 16]; }
    }
    __device__ __forceinline__ void mid(f32x4 (&)[2][2][4][2], const Unit&, int, int, int, int, int, State&) const {}
    __device__ __forceinline__ void operator()(const f32x4 (&acc)[2][2][4][2], const Unit& u, int ui, int wr, int wc, int fr, int fq, const State& est) const {
        const int r0 = wr * 64 + fr, row0 = u.pm * BM + r0, hcol = u.pn * HALF + wc * 32 + 8 * fq;
#pragma unroll
        for (int ai = 0; ai < 2; ++ai)
#pragma unroll
            for (int m = 0; m < 4; ++m) {
                const int row = row0 + ai * HALF + m * 16;
                const float rinv = MOE ? est.r[MOE ? ai * 4 + m : 0] : tab[ui * BM + r0 + ai * HALF + m * 16];
                float h[8];
#pragma unroll
                for (int n = 0; n < 2; ++n)
#pragma unroll
                    for (int j = 0; j < 4; ++j) { const float g = acc[ai][0][m][n][j] * rinv, uu = acc[ai][1][m][n][j] * rinv; h[4 * n + j] = g * __builtin_amdgcn_rcpf(1.0f + __builtin_amdgcn_exp2f(-LOG2E * g)) * uu; }
                u32x4 w; w.x = cvt_pk_bf16(h[0], h[1]); w.y = cvt_pk_bf16(h[2], h[3]); w.z = cvt_pk_bf16(h[4], h[5]); w.w = cvt_pk_bf16(h[6], h[7]);
                *(u32x4*)(H + (size_t)row * FF + hcol) = w;
            }
    }
};
template <class Sched> __device__ __forceinline__ void fill_rinv_tab(const Sched& S, const float* ssq, PG8_LAS float* tab, int tid, int maxu) {
    if (tid < BM) { Unit u;
        for (int i = 0; i < maxu && S.next(i, u); ++i) tab[i * BM + tid] = __builtin_amdgcn_rsqf(sum16(ssq + (size_t)(u.pm * BM + tid) * 16) * (1.0f / D) + EPS); }
    asm volatile("s_waitcnt lgkmcnt(0)\n\ts_barrier" ::: "memory");
}
struct EpiMoeDown {
    static constexpr bool PERM = true, MID = false; static constexpr int MID_T = 0;
    bf16_t* Ys; bf16_t* Ys2; int ysplit; const float* gate; float* slab; unsigned* tailmap; int S;
    struct State {};
    __device__ __forceinline__ void begin(const Unit&, int, int, State&) const {}
    __device__ __forceinline__ void mid(f32x4 (&)[2][2][4][2], const Unit&, int, int, int, int, int, State&) const {}
    __device__ __forceinline__ void operator()(const f32x4 (&acc)[2][2][4][2], const Unit& u, int ui, int wr, int wc, int fr, int fq, const State& est) const {
        if (u.sl >= 0) {
            float* sb = slab + (size_t)u.sl * (BM * BM) + (size_t)(wr * 64 + fr) * BM + wc * 32 + 8 * fq;
#pragma unroll
            for (int ai = 0; ai < 2; ++ai)
#pragma unroll
                for (int m = 0; m < 4; ++m)
#pragma unroll
                    for (int bj = 0; bj < 2; ++bj) { float* q = sb + (size_t)(ai * HALF + m * 16) * BM + bj * HALF; *(f32x4*)q = acc[ai][bj][m][0]; *(f32x4*)(q + 4) = acc[ai][bj][m][1]; }
            if (u.sl % S == 0 && wr == 0 && wc == 0 && fr == 0 && fq == 0) tailmap[u.pm * 4 + u.pn] = 1u + (unsigned)(u.sl / S);
            return;
        }
        const int row0 = u.pm * BM + wr * 64 + fr, col0 = u.pn * BM + wc * 32 + 8 * fq;
        bf16_t* ysb = u.pm * BM < ysplit ? Ys + (size_t)u.pm * BM * D : Ys2 + (size_t)(u.pm * BM - ysplit) * D;
        float g8[2][4];
#pragma unroll
        for (int ai = 0; ai < 2; ++ai)
#pragma unroll
            for (int m = 0; m < 4; ++m) g8[ai][m] = gate[row0 + ai * HALF + m * 16];
#pragma unroll
        for (int ai = 0; ai < 2; ++ai)
#pragma unroll
            for (int m = 0; m < 4; ++m) {
                const int row = row0 + ai * HALF + m * 16; const float g = g8[ai][m];
#pragma unroll
                for (int bj = 0; bj < 2; ++bj) { const f32x4 v0 = acc[ai][bj][m][0] * g, v1 = acc[ai][bj][m][1] * g;
                    u32x4 w; w.x = cvt_pk_bf16(v0[0], v0[1]); w.y = cvt_pk_bf16(v0[2], v0[3]); w.z = cvt_pk_bf16(v1[0], v1[1]); w.w = cvt_pk_bf16(v1[2], v1[3]);
                    *(u32x4*)(ysb + (size_t)(row - u.pm * BM) * D + col0 + bj * HALF) = w; }
            }
    }
};

template <class Epi, class Sched, bool GATHER, int K, bool ALIGN_EPI = true, bool SP2 = true>
__device__ __forceinline__ void gemm_phase(PG8_LAS unsigned char* lds, const Gemm g, const Sched& S, const Epi& E) {
    int tid_ = threadIdx.x; asm volatile("" : "+v"(tid_));
    const int tid = tid_, wid = __builtin_amdgcn_readfirstlane(tid >> 6), lane = tid & 63, wr = wid >> 2, wc = wid & 3, fr = lane & 15, fq = lane >> 4;
    constexpr int nt = K / BK;
    unsigned voffA[2], voffB[2]; int RA[2], CA[2];
#pragma unroll
    for (int i = 0; i < 2; ++i) { int R, C; stage_rc(tid * 16 + i * 8192, R, C); const int Rb = Epi::PERM ? ((R & ~31) + perm32(R & 31)) : R;
        RA[i] = R; CA[i] = C; voffA[i] = (unsigned)(R * K + C) * 2u; voffB[i] = (unsigned)(Rb * K + C) * 2u; }
    constexpr size_t kstep = (size_t)(BK * 2);
    constexpr size_t hstep = (size_t)HALF * K * 2;
    constexpr size_t tstep = 2 * hstep;
    const unsigned ldsw = (unsigned)wid * 1024u;
    const int aoff = lds_byte(wr * 64 + fr, fq * 8), boff = lds_byte(wc * 32 + fr, fq * 8);
#define PG8_SA(b, h) (((b) * 2 + (h)) * HTB)
#define PG8_SB(b, h) ((4 + (b) * 2 + (h)) * HTB)
    const char* const rsA = (const char*)g.A; const char* const rsB = (const char*)g.Bt;
#define PG8_STAGE_R(bufoff, rs, soff, voff) do { _Pragma("unroll") for (int _i = 0; _i < 2; ++_i) \
        __builtin_amdgcn_global_load_lds((const unsigned*)((rs) + (size_t)(unsigned)((voff)[_i] + (unsigned)(soff))), (PG8_LAS unsigned*)(lds + (bufoff) + ldsw + _i * 8192), 16, 0, 0); } while (0)
#define PG8_STAGE(bufoff, soff, voff) PG8_STAGE_R(bufoff, rsB, soff, voff)
#define PG8_STAGE_A(bufoff, soff, h, VG) do { if constexpr (GATHER) { PG8_STAGE_R(bufoff, rsA, soff, VG[h]); } else { PG8_STAGE_R(bufoff, rsA, (soff) + (unsigned)((h) * hstep), voffA); } } while (0)
#define PG8_LDA(dst, b, h) do { _Pragma("unroll") for (int m = 0; m < 4; ++m) _Pragma("unroll") for (int k = 0; k < 2; ++k) dst[m][k] = *(const PG8_LAS bf16x8*)(lds + PG8_SA(b, h) + aoff + m * 2048 + k * 1024); } while (0)
#define PG8_LDB(dst, b, h) do { _Pragma("unroll") for (int n = 0; n < 2; ++n) _Pragma("unroll") for (int k = 0; k < 2; ++k) dst[n][k] = *(const PG8_LAS bf16x8*)(lds + PG8_SB(b, h) + boff + n * 2048 + k * 1024); } while (0)
#define PG8_MMA(ai, bj, At, Bt) do { __builtin_amdgcn_s_setprio(1); _Pragma("unroll") for (int m = 0; m < 4; ++m) _Pragma("unroll") for (int n = 0; n < 2; ++n) _Pragma("unroll") for (int k = 0; k < 2; ++k) \
        acc[ai][bj][m][n] = __builtin_amdgcn_mfma_f32_16x16x32_bf16(Bt[n][k], At[m][k], acc[ai][bj][m][n], 0, 0, 0); __builtin_amdgcn_s_setprio(0); } while (0)
#define PG8_WAIT_V(n) asm volatile("s_waitcnt vmcnt(" #n ")" ::: "memory")
#define PG8_WAIT_L(n) asm volatile("s_waitcnt lgkmcnt(" #n ")" ::: "memory")
#define PG8_BAR __builtin_amdgcn_s_barrier()
#define PG8_SCHED __builtin_amdgcn_sched_barrier(0)
#define PG8_GOFF(dst, U) do { _Pragma("unroll") for (int _h = 0; _h < 2; ++_h) _Pragma("unroll") for (int _i = 0; _i < 2; ++_i) \
        dst[_h][_i] = ((unsigned)g.idx[(U).pm * BM + _h * HALF + RA[_i]] * (unsigned)K + (unsigned)CA[_i]) * 2u; } while (0)
    Unit cur, nxt; int ui = 0;
    if (!S.next(0, cur)) return;
    if constexpr (!Sched::KSPLIT) { cur.k0 = 0; cur.nk = nt; cur.sl = -1; }
    f32x4 acc[2][2][4][2];
#pragma unroll
    for (int a = 0; a < 2; ++a)
#pragma unroll
        for (int b = 0; b < 2; ++b)
#pragma unroll
            for (int m = 0; m < 4; ++m)
#pragma unroll
                for (int n = 0; n < 2; ++n) acc[a][b][m][n] = (f32x4){0.f, 0.f, 0.f, 0.f};
    bf16x8 At[4][2], B0[2][2], B1[2][2];
    unsigned vgc[2][2] = {{0u, 0u}, {0u, 0u}}, vgn[2][2] = {{0u, 0u}, {0u, 0u}};
    unsigned cA = (GATHER ? 0u : (unsigned)cur.pm * (unsigned)tstep) + (unsigned)cur.k0 * (unsigned)kstep, cB = (unsigned)cur.pb * (unsigned)tstep + (unsigned)cur.k0 * (unsigned)kstep;
    if constexpr (GATHER) PG8_GOFF(vgc, cur);
    typename Epi::State est;
    E.begin(cur, 0, tid, est);
    if constexpr (SP2) {
        PG8_STAGE(PG8_SB(0, 0), cB, voffB); PG8_STAGE(PG8_SB(0, 1), cB + hstep, voffB); PG8_STAGE_A(PG8_SA(0, 0), cA, 0, vgc); PG8_STAGE_A(PG8_SA(0, 1), cA, 1, vgc);
        if (wr == 1) PG8_BAR;
        PG8_WAIT_V(2); PG8_BAR;
        PG8_STAGE(PG8_SB(1, 0), cB + kstep, voffB); PG8_STAGE_A(PG8_SA(1, 0), cA + kstep, 0, vgc); PG8_STAGE(PG8_SB(1, 1), cB + hstep + kstep, voffB);
        PG8_WAIT_V(6); PG8_BAR;
    } else {
        PG8_STAGE(PG8_SB(0, 0), cB, voffB); PG8_STAGE_A(PG8_SA(0, 0), cA, 0, vgc); PG8_STAGE(PG8_SB(0, 1), cB + hstep, voffB); PG8_STAGE_A(PG8_SA(0, 1), cA, 1, vgc);
        if (wr == 1) PG8_BAR;
        PG8_WAIT_V(4); PG8_BAR;
        PG8_STAGE(PG8_SB(1, 0), cB + kstep, voffB); PG8_STAGE_A(PG8_SA(1, 0), cA + kstep, 0, vgc); PG8_STAGE(PG8_SB(1, 1), cB + hstep + kstep, voffB);
        PG8_WAIT_V(6); PG8_BAR;
    }
    for (;;) {
        const bool has_next = S.next(ui + 1, nxt);
        if constexpr (!Sched::KSPLIT) { nxt.k0 = 0; nxt.nk = nt; nxt.sl = -1; }
        const unsigned nA = has_next ? (GATHER ? 0u : (unsigned)nxt.pm * (unsigned)tstep) + (unsigned)nxt.k0 * (unsigned)kstep : cA, nB = has_next ? (unsigned)nxt.pb * (unsigned)tstep + (unsigned)nxt.k0 * (unsigned)kstep : cB;
        if constexpr (GATHER) { if (has_next) PG8_GOFF(vgn, nxt); else {
#pragma unroll
            for (int h = 0; h < 2; ++h)
#pragma unroll
                for (int i = 0; i < 2; ++i) vgn[h][i] = vgc[h][i]; } }
        const int nk = cur.nk;
        for (int t = 0; t < nk; t += 2) {
            const bool last = (t == nk - 2);
            if constexpr (Epi::MID) { if (t == Epi::MID_T) E.mid(acc, cur, ui, wr, wc, fr, fq, est); }
            const unsigned a1 = cA + (unsigned)(t + 1) * (unsigned)kstep;
            const unsigned a2 = last ? nA : cA + (unsigned)(t + 2) * (unsigned)kstep, b2 = last ? nB : cB + (unsigned)(t + 2) * (unsigned)kstep;
            const unsigned a3 = a2 + (unsigned)kstep, b3 = b2 + (unsigned)kstep;
            unsigned vgs[2][2];
#pragma unroll
            for (int h = 0; h < 2; ++h)
#pragma unroll
                for (int i = 0; i < 2; ++i) vgs[h][i] = last ? vgn[h][i] : vgc[h][i];
            if constexpr (SP2) {
            PG8_LDB(B0, 0, 0); PG8_LDB(B1, 0, 1); PG8_SCHED; PG8_LDA(At, 0, 0); PG8_STAGE_A(PG8_SA(1, 1), a1, 1, vgc);
            PG8_WAIT_V(8); PG8_WAIT_L(0); PG8_BAR; PG8_MMA(0, 0, At, B0); PG8_MMA(0, 1, At, B1); PG8_BAR; PG8_SCHED;
            PG8_LDA(At, 0, 1); PG8_STAGE(PG8_SB(0, 0), b2, voffB); PG8_STAGE(PG8_SB(0, 1), b2 + hstep, voffB); PG8_STAGE_A(PG8_SA(0, 0), a2, 0, vgs);
            PG8_WAIT_V(8); PG8_WAIT_L(0); PG8_BAR; PG8_MMA(1, 0, At, B0); PG8_MMA(1, 1, At, B1); PG8_BAR; PG8_SCHED;
            PG8_LDB(B0, 1, 0); PG8_LDB(B1, 1, 1); PG8_SCHED; PG8_LDA(At, 1, 0); PG8_STAGE_A(PG8_SA(0, 1), a2, 1, vgs);
            PG8_WAIT_V(8); PG8_WAIT_L(0); PG8_BAR; PG8_MMA(0, 0, At, B0); PG8_MMA(0, 1, At, B1); PG8_BAR; PG8_SCHED;
            PG8_LDA(At, 1, 1); PG8_STAGE(PG8_SB(1, 0), b3, voffB); PG8_STAGE(PG8_SB(1, 1), b3 + hstep, voffB); PG8_STAGE_A(PG8_SA(1, 0), a3, 0, vgs);
            PG8_WAIT_V(8); PG8_WAIT_L(0); PG8_BAR; PG8_MMA(1, 0, At, B0); PG8_MMA(1, 1, At, B1); PG8_BAR; PG8_SCHED;
            } else {
            PG8_LDB(B0, 0, 0); PG8_SCHED; PG8_LDA(At, 0, 0); PG8_STAGE_A(PG8_SA(1, 1), a1, 1, vgc);
            PG8_WAIT_L(8); PG8_BAR; PG8_WAIT_L(0); PG8_MMA(0, 0, At, B0); PG8_BAR; PG8_SCHED;
            PG8_LDB(B1, 0, 1); PG8_STAGE(PG8_SB(0, 0), b2, voffB);
            PG8_BAR; PG8_WAIT_L(0); PG8_MMA(0, 1, At, B1); PG8_BAR;
            PG8_LDA(At, 0, 1); PG8_STAGE_A(PG8_SA(0, 0), a2, 0, vgs);
            PG8_BAR; PG8_WAIT_L(0); PG8_MMA(1, 0, At, B0); PG8_BAR; PG8_SCHED;
            PG8_STAGE(PG8_SB(0, 1), b2 + hstep, voffB);
            PG8_WAIT_V(6); PG8_BAR; PG8_MMA(1, 1, At, B1); PG8_BAR;
            PG8_LDB(B0, 1, 0); PG8_SCHED; PG8_LDA(At, 1, 0); PG8_STAGE_A(PG8_SA(0, 1), a2, 1, vgs);
            PG8_WAIT_L(8); PG8_BAR; PG8_WAIT_L(0); PG8_MMA(0, 0, At, B0); PG8_BAR; PG8_SCHED;
            PG8_LDB(B1, 1, 1); PG8_STAGE(PG8_SB(1, 0), b3, voffB);
            PG8_BAR; PG8_WAIT_L(0); PG8_MMA(0, 1, At, B1); PG8_BAR;
            PG8_LDA(At, 1, 1); PG8_STAGE_A(PG8_SA(1, 0), a3, 0, vgs);
            PG8_BAR; PG8_WAIT_L(0); PG8_MMA(1, 0, At, B0); PG8_BAR; PG8_SCHED;
            PG8_STAGE(PG8_SB(1, 1), b3 + hstep, voffB);
            PG8_WAIT_V(6); PG8_BAR; PG8_MMA(1, 1, At, B1); PG8_BAR;
            }
        }
        if constexpr (ALIGN_EPI) { if (wr == 0) PG8_BAR; }
        E(acc, cur, ui, wr, wc, fr, fq, est);
        if (!has_next) break;
#pragma unroll
        for (int a = 0; a < 2; ++a)
#pragma unroll
            for (int b = 0; b < 2; ++b)
#pragma unroll
                for (int m = 0; m < 4; ++m)
#pragma unroll
                    for (int n = 0; n < 2; ++n) acc[a][b][m][n] = (f32x4){0.f, 0.f, 0.f, 0.f};
        cur = nxt; cA = nA; cB = nB; ++ui;
        E.begin(cur, ui, tid, est);
#pragma unroll
        for (int h = 0; h < 2; ++h)
#pragma unroll
            for (int i = 0; i < 2; ++i) vgc[h][i] = vgn[h][i];
        if constexpr (ALIGN_EPI) { if (wr == 1) PG8_BAR; }
    }
    PG8_WAIT_V(0);
    if constexpr (!ALIGN_EPI) { if (wr == 0) PG8_BAR; }
    PG8_BAR;
#undef PG8_SA
#undef PG8_SB
#undef PG8_STAGE
#undef PG8_STAGE_A
#undef PG8_LDA
#undef PG8_LDB
#undef PG8_MMA
#undef PG8_WAIT_V
#undef PG8_WAIT_L
#undef PG8_BAR
#undef PG8_SCHED
#undef PG8_GOFF
}
}

constexpr size_t MiB = 1u << 20;
constexpr size_t WS_CTL = 0, CTL_ZERO_BYTES = 128 * 1024;
constexpr size_t WS_SSQ_A = 1 * MiB, WS_SSQ_F = 2 * MiB, WS_SSQ_ATT = 3 * MiB, WS_SSQ_SSM = 3 * MiB + 512 * 1024;
constexpr size_t WS_ROUTE = 4 * MiB;
constexpr size_t RT_IDX = 0, RT_GATE = 160 * 1024, RT_RINVS = 320 * 1024, RT_POS = 480 * 1024, RT_TOPE = 608 * 1024, RT_TOPG = 736 * 1024, RT_RINVT = 864 * 1024, RT_HIST = 928 * 1024, RT_PEND = 944 * 1024;
constexpr size_t WS_SSMPRE = 6 * MiB, SSMPRE_STRIDE = 9 * MiB;
constexpr size_t WS_WSMALL = 24 * MiB, WSMALL_STRIDE = 5 * MiB, WS_WIN = 0, WS_WGLU = 5 * MiB / 2, WS_WO = 3 * MiB;
constexpr size_t WS_DGU = 34 * MiB, WS_DD = 48 * MiB;
constexpr size_t WS_MOEW = 56 * MiB, WS_XB = 168 * MiB, WS_YS = 56 * MiB, WS_YS2 = WS_YS + (size_t)28672 * 1024 * 2;
constexpr int YS_SPLIT = 28672;
constexpr size_t WS_RA = 200 * MiB, WS_QKVU = WS_RA, WS_MIX = 240 * MiB, WS_YG = 272 * MiB, WS_HD = 288 * MiB, WS_HS = WS_RA;
constexpr size_t WS_UG = WS_HD;
constexpr size_t WS_END = 446 * MiB;
static_assert(WS_YS2 + (size_t)(CAP - YS_SPLIT) * D * 2 <= 124 * MiB && WS_HS + (size_t)CAP * FF * 2 <= WS_END && WS_HD + (size_t)T * FF * 2 <= WS_END, "ws map");
constexpr int CW_BAR = 4096, CW_TAILMAP = 16384;
constexpr size_t WS_SLAB = 124 * MiB;
static_assert(WS_SLAB + (size_t)pg8::KS_MAXSLAB * 256 * 256 * 4 <= 168 * MiB, "slabs");
constexpr size_t WS_WDT = 6 * MiB, WDT_TILEB = (size_t)256 * FF * 2;
constexpr int WDT_E7 = 247;
static_assert(WS_WDT + 7 * 4 * WDT_TILEB <= 55 * MiB && WS_WDT + WDT_E7 * WDT_TILEB >= 438 * MiB, "MoE down weight copies");

constexpr int RING_OFF = 0, RING_BYTES = 131072;
constexpr int LDSCTL_OFF = RING_BYTES, MISC_OFF = LDSCTL_OFF + 320;
constexpr int TAB_OFF = MISC_OFF + 192;
constexpr int LDS_BYTES = 147456;
constexpr int TAB2_OFF = TAB_OFF + 4096, TAB2_UNITS = 11;
static_assert(TAB_OFF % 16 == 0 && TAB2_OFF + TAB2_UNITS * 1024 <= LDS_BYTES, "LDS map");
constexpr int NWAVES = 8;

#define GAS __attribute__((address_space(1)))
#define LAS __attribute__((address_space(3)))
typedef unsigned short bf16;
typedef unsigned v4u __attribute__((ext_vector_type(4)));
typedef float f32x4 __attribute__((ext_vector_type(4)));
typedef GAS unsigned gu32;
#define RLX_AGENT __ATOMIC_RELAXED, __HIP_MEMORY_SCOPE_AGENT
#define LDS_WAIT() asm volatile("s_waitcnt lgkmcnt(0)" ::: "memory")
#define VM_WAIT() asm volatile("s_waitcnt vmcnt(0)" ::: "memory")
__device__ __forceinline__ unsigned f2bf(float f) { unsigned u = __builtin_bit_cast(unsigned, f); return (u + 0x7fffu + ((u >> 16) & 1u)) >> 16; }
__device__ __forceinline__ unsigned pk2(float lo, float hi) { return f2bf(lo) | (f2bf(hi) << 16); }
__device__ __forceinline__ float bf2f(bf16 v) { return __uint_as_float((unsigned)v << 16); }

#define XB_TMO      128
#define XB_XCNT(j)  (256  + 64 * (j))
#define XB_XSUB(j)  (1280 + 64 * (j))
#define XB_XGEN(j)  (2304 + 64 * (j))
#define XB_TOP      3328
#define XB_TOPGEN   3392
#define XCD_BAR_WORDS 3456
#define XB_SPIN_CAP (1u << 22)
__device__ __forceinline__ unsigned xb_ld(unsigned* p)              { return __hip_atomic_load(p, __ATOMIC_RELAXED, __HIP_MEMORY_SCOPE_AGENT); }
__device__ __forceinline__ unsigned xb_add(unsigned* p, unsigned v) { return __hip_atomic_fetch_add(p, v, __ATOMIC_RELAXED, __HIP_MEMORY_SCOPE_AGENT); }
__device__ __forceinline__ unsigned xb_xcc_id() { return (unsigned)__builtin_amdgcn_s_getreg((3 << 11) | 20) & 0xFu; }
#define XB_SPIN(cond, bar) do { unsigned _sp = 0; while (cond) { __builtin_amdgcn_s_sleep(1); \
    if ((++_sp & 255u) == 0u) { if (xb_ld(&(bar)[XB_TMO])) break; if (_sp > XB_SPIN_CAP) { atomicAdd(&(bar)[XB_TMO], 1u); break; } } } } while (0)
struct XcdBarrier { unsigned* bar; unsigned x; volatile LAS unsigned* st; };
__device__ __forceinline__ XcdBarrier xcd_barrier_post(unsigned* bar, volatile LAS unsigned* st) {
    XcdBarrier b; b.bar = bar; b.x = xb_xcc_id(); b.st = st;
    if (threadIdx.x == 0) (void)xb_add(&bar[XB_XCNT(b.x)], 1u);
    return b;
}
__device__ __forceinline__ void xcd_barrier_complete(unsigned* bar, unsigned x, unsigned& nloc, unsigned& nx) {
    const unsigned G = gridDim.x * gridDim.y * gridDim.z;
    unsigned sum, cnt, mine, sp = 0u;
    for (;;) {
        sum = 0u; cnt = 0u; mine = 0u;
#pragma unroll
        for (unsigned j = 0; j < 16; ++j) { const unsigned c = xb_ld(&bar[XB_XCNT(j)]); sum += c; cnt += (c > 0u) ? 1u : 0u; mine = (j == x) ? c : mine; }
        if (sum == G) break;
        __builtin_amdgcn_s_sleep(1);
        if ((++sp & 255u) == 0u) { if (xb_ld(&bar[XB_TMO])) break; if (sp > XB_SPIN_CAP) { atomicAdd(&bar[XB_TMO], 1u); break; } }
    }
    nloc = mine > 0u ? mine : 1u; nx = cnt > 0u ? cnt : 1u;
}
__device__ __forceinline__ void xcd_barrier(const XcdBarrier& b) {
    asm volatile("s_waitcnt vmcnt(0)" ::: "memory");
    __syncthreads();
    if (threadIdx.x == 0) {
        unsigned* bar = b.bar;
        __builtin_amdgcn_s_waitcnt(0);
        unsigned nloc = b.st[0], nx = b.st[1];
        if (nloc == 0u) { xcd_barrier_complete(bar, b.x, nloc, nx); b.st[0] = nloc; b.st[1] = nx; }
        const unsigned old = xb_add(&bar[XB_XSUB(b.x)], 1u);
        const unsigned gen = old / nloc;
        if (old + 1u == (gen + 1u) * nloc) {
            __builtin_amdgcn_fence(__ATOMIC_RELEASE, "agent");
            asm volatile("s_waitcnt vmcnt(0)" ::: "memory");
            const unsigned og = xb_add(&bar[XB_TOP], 1u);
            const unsigned tg = og / nx;
            if (og + 1u == (tg + 1u) * nx) xb_add(&bar[XB_TOPGEN], 1u);
            else XB_SPIN(xb_ld(&bar[XB_TOPGEN]) == tg, bar);
            __builtin_amdgcn_fence(__ATOMIC_ACQUIRE, "agent");
            xb_add(&bar[XB_XGEN(b.x)], 1u);
            asm volatile("s_waitcnt vmcnt(0)" ::: "memory");
        } else {
            XB_SPIN(xb_ld(&bar[XB_XGEN(b.x)]) == gen, bar);
            __builtin_amdgcn_fence(__ATOMIC_ACQUIRE, "agent");
            asm volatile("s_waitcnt vmcnt(0)" ::: "memory");
        }
    }
    __syncthreads();
}

struct Args { const float* in[26]; float* out; unsigned char* ws; int ph_lo, ph_hi; };
struct Frame {
    LAS unsigned char* lds; volatile LAS unsigned* MISC; gu32* ctl;
    int tid, lane, wave, vcu, G;
    unsigned char* ws; float* out;
};
__device__ __forceinline__ float wave_sum(float v) {
#pragma unroll
    for (int o = 1; o < 64; o <<= 1) v += __shfl_xor(v, o);
    return v;
}
__device__ __forceinline__ float wave_max(float v) {
#pragma unroll
    for (int o = 1; o < 64; o <<= 1) v = fmaxf(v, __shfl_xor(v, o));
    return v;
}

constexpr int CKB = 64;
constexpr int CONV_LDS = 64 * 144;
__device__ __forceinline__ void conv_item(const float* srcl, int ldn, int k0, const float* ks, bf16* dst0  , int K, LAS unsigned char* scr, int lane) {
    float v[CKB];
    { const float* q = srcl + (size_t)k0 * ldn;
#pragma unroll
      for (int i = 0; i < CKB; ++i) { if ((i & 7) == 0) asm volatile("" : "+v"(q)); v[i] = __builtin_nontemporal_load(q + (size_t)(i & 7) * ldn); if ((i & 7) == 7) q += (size_t)8 * ldn; } }
    if (ks) {
#pragma unroll
        for (int i = 0; i < CKB; ++i) v[i] *= ks[k0 + i]; }
#pragma unroll
    for (int j = 0; j < CKB / 8; ++j) { v4u o; o.x = pg8::cvt_pk_bf16(v[8 * j], v[8 * j + 1]); o.y = pg8::cvt_pk_bf16(v[8 * j + 2], v[8 * j + 3]); o.z = pg8::cvt_pk_bf16(v[8 * j + 4], v[8 * j + 5]); o.w = pg8::cvt_pk_bf16(v[8 * j + 6], v[8 * j + 7]);
        *(LAS v4u*)(scr + lane * 144 + j * 16) = o; }
    asm volatile("s_waitcnt lgkmcnt(0)" ::: "memory");
#pragma unroll
    for (int i = 0; i < 8; ++i) { const int row = 8 * i + (lane >> 3), ch = lane & 7; const v4u o = *(const LAS v4u*)(scr + row * 144 + ch * 16);
        *(GAS v4u*)(dst0 + (size_t)row * K + ch * 8) = o; }
    asm volatile("s_waitcnt lgkmcnt(0)" ::: "memory");
}
__device__ __forceinline__ void conv_plain(const float* W, int K, int N, const float* ks_lo, const float* ks_hi, bf16* WT, int item, int lane, LAS unsigned char* scr) {
    const int nblk = N / 64, kb = item / nblk, nb = item % nblk, k0 = CKB * kb;
    const float* ks = ks_lo ? (k0 < 512 || !ks_hi ? ks_lo : ks_hi - 512) : nullptr;
    conv_item(W + 64 * nb + lane, N, k0, ks, WT + (size_t)(64 * nb) * K + k0, K, scr, lane);
}
__device__ __forceinline__ void conv_inproj(const float* W, const float* ks, bf16* WT, int item, int lane, LAS unsigned char* scr) {
    const int nblk = INW / 64, kb = item / nblk, db = item % nblk, drow = 64 * db + lane, pn = drow >> 8, bj = (drow >> 7) & 1, wc = (drow >> 5) & 3, i = drow & 31;
    conv_item(W + 256 * pn + 64 * wc + 32 * bj + i, INW, CKB * kb, ks, WT + (size_t)(64 * db) * D + CKB * kb, D, scr, lane);
}
__device__ __forceinline__ void conv_gu(const float* Wg, const float* Wu, const float* ks, bf16* WT, int item, int lane, LAS unsigned char* scr) {
    const int nblk = 2 * FF / 64, kb = item / nblk, db = item % nblk, drow = 64 * db + lane, pn = drow >> 8, bj = (drow >> 7) & 1, r = drow & 127;
    conv_item((bj ? Wu : Wg) + 128 * pn + r, FF, CKB * kb, ks, WT + (size_t)(64 * db) * D + CKB * kb, D, scr, lane);
}

constexpr int IT_IN = (D / CKB) * (INW / 64), IT_GLU = (SW / CKB) * (SW / 64), IT_WO = (D / CKB) * (D / 64), IT_L = IT_IN + IT_GLU + IT_WO;
constexpr int IT_GU = (D / CKB) * (2 * FF / 64), IT_DN = (FF / CKB) * (D / 64);
constexpr int IT_P0 = 2 * IT_L;
constexpr int IT_BG = IT_GU + IT_DN + NE * IT_GU;
#ifndef BGQ
#define BGQ 2000, 0, 2900, 3000, 0, 2900
#endif
constexpr int BG_Q[6] = {BGQ};
constexpr int BG_B1 = BG_Q[0], BG_B2 = BG_B1 + BG_Q[1], BG_B3 = BG_B2 + BG_Q[2], BG_B4 = BG_B3 + BG_Q[3], BG_B5 = BG_B4 + BG_Q[4], BG_B6 = BG_B5 + BG_Q[5];
static_assert(BG_B3 >= IT_GU + IT_DN && BG_B6 <= IT_BG, "dense FFN weights are needed right after slot 3");

__device__ __forceinline__ void p0_convert(Frame& F, const Args& a, int rank, int nranks, int lo, int hi) {
    LAS unsigned char* scr = F.lds + RING_OFF + F.wave * CONV_LDS;
    const int gw = rank * NWAVES + F.wave, NGW = nranks * NWAVES;
    for (int it = lo + gw; it < hi; it += NGW) {
        const int l = it / IT_L; int r = it - l * IT_L; unsigned char* wb = F.ws + WS_WSMALL + l * WSMALL_STRIDE;
        if (r < IT_IN) { conv_inproj(a.in[2] + (size_t)l * D * INW, a.in[1] + l * D, (bf16*)(wb + WS_WIN), r, F.lane, scr); continue; } r -= IT_IN;
        if (r < IT_GLU) { conv_plain(a.in[14] + (size_t)l * SW * SW, SW, SW, nullptr, nullptr, (bf16*)(wb + WS_WGLU), r, F.lane, scr); continue; } r -= IT_GLU;
        conv_plain(a.in[17] + (size_t)l * D * D, D, D, a.in[15] + l * AW, a.in[16] + l * SW, (bf16*)(wb + WS_WO), r, F.lane, scr);
    }
}
__device__ __forceinline__ void bg_convert(Frame& F, const Args& a, int lo, int hi, int rank, int nranks) {
    if (rank < 0) return;
    LAS unsigned char* scr = F.lds + RING_OFF + F.wave * CONV_LDS;
    for (int it = lo + rank * NWAVES + F.wave; it < hi; it += nranks * NWAVES) {
        int r = it;
        if (r < IT_GU) { conv_gu(a.in[19], a.in[20], a.in[18], (bf16*)(F.ws + WS_DGU), r, F.lane, scr); continue; } r -= IT_GU;
        if (r < IT_DN) { conv_plain(a.in[21], FF, D, nullptr, nullptr, (bf16*)(F.ws + WS_DD), r, F.lane, scr); continue; } r -= IT_DN;
        { const int e = r / IT_GU; r -= e * IT_GU;
          conv_gu(a.in[23] + (size_t)e * D * FF, a.in[24] + (size_t)e * D * FF, a.in[18] + D, (bf16*)(F.ws + WS_MOEW) + (size_t)e * 2 * FF * D, r, F.lane, scr); }
    }
}
__device__ __forceinline__ void moe_wd_convert(Frame& F, const Args& a) {
    LAS unsigned char* scr = F.lds + RING_OFF + F.wave * CONV_LDS;
    const int gw = F.vcu * NWAVES + F.wave, NGW = F.G * NWAVES;
    for (int it = gw; it < NE * IT_DN; it += NGW) { const int e = it / IT_DN, r = it % IT_DN;
        conv_plain(a.in[25] + (size_t)e * FF * D, FF, D, nullptr, nullptr, (bf16*)(F.ws + WS_WDT + (size_t)(e < 7 ? 4 * e : WDT_E7) * WDT_TILEB), r, F.lane, scr); }
}
__device__ __forceinline__ void conv_load2(const float* srcl, int ldn, int k0, float (&v)[CKB]) {
    const float* q = srcl + (size_t)k0 * ldn;
#pragma unroll
    for (int i = 0; i < CKB; ++i) { if ((i & 7) == 0) asm volatile("" : "+v"(q)); v[i] = __builtin_nontemporal_load(q + (size_t)(i & 7) * ldn); if ((i & 7) == 7) q += (size_t)8 * ldn; }
}
__device__ __forceinline__ void conv_store2(float (&v)[CKB], const float* ks, int k0, bf16* dst0, int K, LAS unsigned char* scr, int lane) {
    if (ks) {
#pragma unroll
        for (int i = 0; i < CKB; ++i) v[i] *= ks[k0 + i]; }
#pragma unroll
    for (int j = 0; j < CKB / 8; ++j) { v4u o; o.x = pg8::cvt_pk_bf16(v[8 * j], v[8 * j + 1]); o.y = pg8::cvt_pk_bf16(v[8 * j + 2], v[8 * j + 3]); o.z = pg8::cvt_pk_bf16(v[8 * j + 4], v[8 * j + 5]); o.w = pg8::cvt_pk_bf16(v[8 * j + 6], v[8 * j + 7]);
        *(LAS v4u*)(scr + lane * 144 + j * 16) = o; }
    asm volatile("s_waitcnt lgkmcnt(0)" ::: "memory");
#pragma unroll
    for (int i = 0; i < 8; ++i) { const int row = 8 * i + (lane >> 3), ch = lane & 7; const v4u o = *(const LAS v4u*)(scr + row * 144 + ch * 16);
        *(GAS v4u*)(dst0 + (size_t)row * K + ch * 8) = o; }
    asm volatile("s_waitcnt lgkmcnt(0)" ::: "memory");
}
struct CvI { const float* srcl; const float* ks; bf16* dst0; int ldn, k0, K; };
__device__ __forceinline__ CvI cvi_gu(const float* Wg, const float* Wu, const float* ks, bf16* WT, int item, int lane) {
    const int nblk = 2 * FF / 64, kb = item / nblk, db = item % nblk, drow = 64 * db + lane, pn = drow >> 8, bj = (drow >> 7) & 1, r = drow & 127;
    return CvI{(bj ? Wu : Wg) + 128 * pn + r, ks, WT + (size_t)(64 * db) * D + CKB * kb, FF, CKB * kb, D};
}
__device__ __forceinline__ CvI cvi_plain(const float* W, int K, int N, bf16* WT, int item, int lane) {
    const int nblk = N / 64, kb = item / nblk, nb = item % nblk, k0 = CKB * kb;
    return CvI{W + 64 * nb + lane, nullptr, WT + (size_t)(64 * nb) * K + k0, N, k0, K};
}
template <int WHICH> __device__ __forceinline__ void conv_run2(Frame& F, const Args& a, int first, int step, int hi) {
    LAS unsigned char* scr = F.lds + RING_OFF + F.wave * CONV_LDS;
    auto dec = [&](int it) {
        if (WHICH == 1) { const int e = it / IT_DN, r = it % IT_DN; return cvi_plain(a.in[25] + (size_t)e * FF * D, FF, D, (bf16*)(F.ws + WS_WDT + (size_t)(e < 7 ? 4 * e : WDT_E7) * WDT_TILEB), r, F.lane); }
        int r = it;
        if (r < IT_GU) return cvi_gu(a.in[19], a.in[20], a.in[18], (bf16*)(F.ws + WS_DGU), r, F.lane);
        r -= IT_GU;
        if (r < IT_DN) return cvi_plain(a.in[21], FF, D, (bf16*)(F.ws + WS_DD), r, F.lane);
        r -= IT_DN;
        const int e = r / IT_GU; r -= e * IT_GU;
        return cvi_gu(a.in[23] + (size_t)e * D * FF, a.in[24] + (size_t)e * D * FF, a.in[18] + D, (bf16*)(F.ws + WS_MOEW) + (size_t)e * 2 * FF * D, r, F.lane); };
    if (first >= hi) return;
    static_assert(BG_B6 >= IT_GU + IT_DN, "the left-over background items are all MoE gate|up items (row length FF)");
    constexpr int LDN = WHICH == 1 ? D : FF;
    float va[CKB], vb[CKB];
    CvI ca = dec(first), cb = ca; conv_load2(ca.srcl, LDN, ca.k0, va);
    for (int it = first;; ) {
        const bool nb = it + step < hi; if (nb) { cb = dec(it + step); conv_load2(cb.srcl, LDN, cb.k0, vb); }
        conv_store2(va, ca.ks, ca.k0, ca.dst0, ca.K, scr, F.lane); if (!nb) break; it += step;
        const bool na = it + step < hi; if (na) { ca = dec(it + step); conv_load2(ca.srcl, LDN, ca.k0, va); }
        conv_store2(vb, cb.ks, cb.k0, cb.dst0, cb.K, scr, F.lane); if (!na) break; it += step;
    }
}
__device__ __forceinline__ void p0_xb(Frame& F, const float* x, int rank, int nranks) {
    const int gw = rank * NWAVES + F.wave, NGW = nranks * NWAVES;
    bf16* XB = (bf16*)(F.ws + WS_XB); float* ssq = (float*)(F.ws + WS_SSQ_A);
    for (int m0 = gw * 4; m0 < T; m0 += NGW * 4) {
        f32x4 v[4][4];
#pragma unroll
        for (int r = 0; r < 4; ++r) { const GAS f32x4* xr = (const GAS f32x4*)(x + (size_t)(m0 + r) * D) + F.lane;
#pragma unroll
            for (int j = 0; j < 4; ++j) v[r][j] = __builtin_nontemporal_load(xr + 64 * j); }
#pragma unroll
        for (int r = 0; r < 4; ++r) { float s = 0.f; GAS unsigned long long* o8 = (GAS unsigned long long*)(XB + (size_t)(m0 + r) * D) + F.lane;
#pragma unroll
            for (int j = 0; j < 4; ++j) { const f32x4 w = v[r][j]; s += (w.x * w.x + w.y * w.y) + (w.z * w.z + w.w * w.w);
                o8[64 * j] = (unsigned long long)pk2(w.x, w.y) | ((unsigned long long)pk2(w.z, w.w) << 32); }
            s = wave_sum(s);
            if (F.lane < 16) ssq[(size_t)(m0 + r) * 16 + F.lane] = F.lane == 0 ? s : 0.f; }
    }
}
constexpr size_t SP_TOEP = 0  , SP_PW = 1 * MiB, SP_ACC = 2 * MiB, SP_AC64 = 2 * MiB + 16 * 1024, SP_WSTT = 4 * MiB, SP_WOUTT = 6 * MiB;
constexpr size_t WS_EB = 5 * MiB;
constexpr unsigned EB_TAG = 0x5EED0001u;
__device__ __forceinline__ void ssm_precompute(Frame& F, const Args& a, int l, int g) {
    LAS float* apr = (LAS float*)(F.lds + RING_OFF); LAS float* api = apr + 17 * 64; LAS float* bbr = api + 17 * 64; LAS float* bbi = bbr + 1024; LAS float* cr = bbi + 1024; LAS float* ci = cr + 1024; LAS float* KT = ci + 1024;
    unsigned char* sp = F.ws + WS_SSMPRE + l * SSMPRE_STRIDE;
    bf16* TOEP = (bf16*)(sp + SP_TOEP) + (size_t)g * 8192; bf16* WSTT = (bf16*)(sp + SP_WSTT) + (size_t)g * 32768; bf16* WOUTT = (bf16*)(sp + SP_WOUTT) + (size_t)g * 32768; float* AC = (float*)(sp + SP_ACC) + g * 128;
    const int lg = l * NG + g, tid = F.tid;
    __syncthreads();
    if (tid < 64) { const int n = tid;
        const double lr = a.in[6][lg * 64 + n], li = a.in[7][lg * 64 + n], dt = exp((double)a.in[8][lg]);
        const double mag = exp(lr * dt), ang = li * dt, a1r = mag * cos(ang), a1i = mag * sin(ang);
        double pr = 1.0, pi = 0.0, a16r = 0.0, a16i = 0.0;
        for (int tau = 0; tau <= 16; ++tau) { apr[tau * 64 + n] = (float)pr; api[tau * 64 + n] = (float)pi; if (tau == 16) { a16r = pr; a16i = pi; } const double qr = pr * a1r - pi * a1i, qi = pr * a1i + pi * a1r; pr = qr; pi = qi; }
        { float* PW = (float*)(sp + SP_PW) + (size_t)g * 8192; float* AC64 = (float*)(sp + SP_AC64) + g * 128; double qr = 1.0, qi = 0.0;
          for (int c = 0; c < 64; ++c) { PW[(c * 64 + n) * 2] = (float)qr; PW[(c * 64 + n) * 2 + 1] = (float)qi; const double tr = qr * a16r - qi * a16i, ti = qr * a16i + qi * a16r; qr = tr; qi = ti; }
          AC64[n] = (float)qr; AC64[64 + n] = (float)qi; }
        const double nr = a1r - 1.0, den = lr * lr + li * li, fre = (nr * lr + a1i * li) / den, fim = (a1i * lr - nr * li) / den;
        for (int c = 0; c < 16; ++c) { const double br = a.in[9][(size_t)(lg * 64 + n) * 16 + c], bi = a.in[10][(size_t)(lg * 64 + n) * 16 + c];
            bbr[n * 16 + c] = (float)(fre * br - fim * bi); bbi[n * 16 + c] = (float)(fre * bi + fim * br); }
        AC[n] = apr[16 * 64 + n]; AC[64 + n] = api[16 * 64 + n];
    }
    for (int o = tid; o < 1024; o += 512) { cr[o] = a.in[11][(size_t)lg * 1024 + o]; ci[o] = a.in[12][(size_t)lg * 1024 + o]; }
    __syncthreads();
    {
        const int co = tid >> 5, c = (tid >> 1) & 15, th = tid & 1; float acc8[8];
#pragma unroll
        for (int q = 0; q < 8; ++q) acc8[q] = 0.f;
        for (int n = 0; n < 64; ++n) { const float c_r = cr[co * 64 + n], c_i = ci[co * 64 + n], br = bbr[n * 16 + c], bi = bbi[n * 16 + c];
            const float xr = c_r * br - c_i * bi, xi = c_r * bi + c_i * br;
#pragma unroll
            for (int q = 0; q < 8; ++q) { const int tau = 8 * th + q; acc8[q] += xr * apr[tau * 64 + n] - xi * api[tau * 64 + n]; } }
#pragma unroll
        for (int q = 0; q < 8; ++q) { const int tau = 8 * th + q; float sv = acc8[q]; if (tau == 0 && co == c) sv += a.in[13][l * SW + g * 16 + co]; KT[tau * 256 + co * 16 + c] = sv; }
    }
    __syncthreads();
    for (int o = tid; o < 4096; o += 512) {
        const int col = 224 + (o >> 7), k = (o & 127) * 2, t = col >> 4, co = col & 15, s0 = k >> 4, c0 = k & 15;
        const float v0 = t >= s0 ? KT[(t - s0) * 256 + co * 16 + c0] : 0.f, v1 = t >= s0 ? KT[(t - s0) * 256 + co * 16 + c0 + 1] : 0.f;
        *(unsigned*)(TOEP + (size_t)((((k >> 4) * 64) + ((k >> 3) & 1) * 32 + (col - 224)) * 8 + (k & 7))) = pk2(v0, v1); }
    for (int o = tid; o < 16384; o += 512) {
        const int n2 = o >> 7, k = (o & 127) * 2, n = n2 & 63, sidx = k >> 4, c0 = k & 15; float v[2];
#pragma unroll
        for (int q = 0; q < 2; ++q) { const float pr = apr[(15 - sidx) * 64 + n], pi = api[(15 - sidx) * 64 + n], br = bbr[n * 16 + c0 + q], bi = bbi[n * 16 + c0 + q]; v[q] = (n2 < 64) ? (pr * br - pi * bi) : (pr * bi + pi * br); }
        *(unsigned*)(WSTT + (size_t)(((((n2 >> 5) * 16 + (k >> 4)) * 64) + ((k >> 3) & 1) * 32 + (n2 & 31)) * 8 + (k & 7))) = pk2(v[0], v[1]); }
    for (int o = tid; o < 16384; o += 512) {
        const int col = o >> 6, n = o & 63, tl = col >> 4, co = col & 15;
        const float pr = apr[(tl + 1) * 64 + n], pi = api[(tl + 1) * 64 + n], c_r = cr[co * 64 + n], c_i = ci[co * 64 + n];
        { const int k = 2 * n; *(unsigned*)(WOUTT + (size_t)(((((col >> 5) * 8 + (k >> 4)) * 64) + ((k >> 3) & 1) * 32 + (col & 31)) * 8 + (k & 7))) = pk2(c_r * pr - c_i * pi, -(c_r * pi + c_i * pr)); } }
    __syncthreads();
}

namespace att {
typedef short bf16x8 __attribute__((ext_vector_type(8)));
typedef short s16x4 __attribute__((ext_vector_type(4)));
typedef short v4i16_t __attribute__((ext_vector_type(4)));
typedef float f32x16 __attribute__((ext_vector_type(16)));
typedef unsigned u32x4 __attribute__((ext_vector_type(4)));
typedef __attribute__((address_space(3))) const char* lds_cptr;
constexpr int SLOTB = 8192, BUFB = 6 * SLOTB, LDS_K = 0, LDS_V = 3 * SLOTB, LDS_WS = 2 * BUFB, LDS_OST = LDS_WS + 8 * 64 * 4, LDS_TOTAL = LDS_OST + 8 * 2048;
static_assert(LDS_TOTAL <= RING_BYTES, "attention LDS");
__device__ __forceinline__ int crow(int r, int hi) { return (r & 3) + 8 * (r >> 2) + 4 * hi; }
__device__ __forceinline__ void glds16(const void* gsrc, unsigned lds_dst) { unsigned keep;
    asm volatile("s_mov_b32 %0, m0\n\ts_mov_b32 m0, %2\n\ts_nop 0\n\tglobal_load_lds_dwordx4 %1, off\n\ts_mov_b32 m0, %0" : "=&s"(keep) : "v"(gsrc), "s"(lds_dst) : "memory"); }
typedef float f32x2_t __attribute__((ext_vector_type(2))); typedef __bf16 bf16x2_t __attribute__((ext_vector_type(2)));
__device__ __forceinline__ unsigned cvtpk(float lo, float hi) { f32x2_t v = {lo, hi}; bf16x2_t b = __builtin_convertvector(v, bf16x2_t); return __builtin_bit_cast(unsigned, b); }
__device__ __forceinline__ s16x4 vtr(lds_cptr p) { return __builtin_bit_cast(s16x4, __builtin_amdgcn_ds_read_tr16_b64_v4i16((__attribute__((address_space(3))) v4i16_t*)p)); }
__device__ __forceinline__ float xhalf_max(float m) { auto rr = __builtin_amdgcn_permlane32_swap(__float_as_uint(m), __float_as_uint(m), false, false); return fmaxf(__uint_as_float(rr[0]), __uint_as_float(rr[1])); }
__device__ __forceinline__ float xhalf_sum(float m) { auto rr = __builtin_amdgcn_permlane32_swap(__float_as_uint(m), __float_as_uint(m), false, false); return __uint_as_float(rr[0]) + __uint_as_float(rr[1]); }

struct Ctx { int tid, lane, r32, hi, wid; };
__device__ __forceinline__ void attn_issue(const Ctx& c, int u, int buf, const bf16* QKVU, LAS unsigned char* shm, bf16x8 (&qn)[4]) {
    const int qb = u % (SEQ / 64), kvh = (u / (SEQ / 64)) % NKV, b = u / (NKV * (SEQ / 64));
    const int h = kvh * 4 + (c.wid >> 1), q0 = qb * 64, qw = q0 + 32 * (c.wid & 1);
    const size_t rowbase = (size_t)b * SEQ; const unsigned lds0 = (unsigned)(uintptr_t)shm + buf * BUFB;
#pragma unroll
    for (int j = 0; j < 3; ++j) {
        const int kv0 = q0 - 128 + 64 * j;
        int kr = kv0 + c.lane; kr = kr < 0 ? 0 : kr;
        int vr = kv0 + 16 * (c.wid & 3) + (c.lane >> 2); vr = vr < 0 ? 0 : vr;
        glds16(QKVU + (rowbase + kr) * INW + KOFF + kvh * 64 + c.wid * 8, (unsigned)__builtin_amdgcn_readfirstlane(lds0 + LDS_K + j * SLOTB + c.wid * 1024));
        glds16(QKVU + (rowbase + vr) * INW + VOFF + kvh * 64 + (c.wid >> 2) * 32 + (c.lane & 3) * 8, (unsigned)__builtin_amdgcn_readfirstlane(lds0 + LDS_V + j * SLOTB + c.wid * 1024));
    }
    const bf16* qp = QKVU + (rowbase + qw + c.r32) * INW + QOFF + h * 64 + c.hi * 8;
#pragma unroll
    for (int d0 = 0; d0 < 4; ++d0) qn[d0] = *(const bf16x8*)(qp + d0 * 16);
}
__device__ __forceinline__ void attn_compute(const Ctx& c, int u, int buf, const bf16x8 (&qr)[4], bf16* MIX, float* ssq, const float* sinks, LAS unsigned char* shm0) {
    const int lane = c.lane, r32 = c.r32, hi = c.hi, wid = c.wid;
    const int qb = u % (SEQ / 64), kvh = (u / (SEQ / 64)) % NKV, b = u / (NKV * (SEQ / 64));
    const int h = kvh * 4 + (wid >> 1), qsub = wid & 1, q0 = qb * 64, qw = q0 + 32 * qsub;
    const size_t rowbase = (size_t)b * SEQ;
    LAS unsigned char* shm = shm0 + buf * BUFB;
    const float sink2 = sinks[h] * LOG2E;
    f32x16 p[5];
    const lds_cptr kbase = (lds_cptr)shm + LDS_K + hi * 1024 + r32 * 16;
#pragma unroll
    for (int hb = 0; hb < 5; ++hb) {
        const int G = qsub + hb;
        const lds_cptr kp = kbase + (G >> 1) * SLOTB + (G & 1) * 512;
        f32x16 acc = {};
#pragma unroll
        for (int d0 = 0; d0 < 4; ++d0) { const bf16x8 kf = *(const __attribute__((address_space(3))) bf16x8*)(kp + d0 * 2048); acc = __builtin_amdgcn_mfma_f32_32x32x16_bf16(kf, qr[d0], acc, 0, 0, 0); }
        p[hb] = acc;
    }
    const float NEG = -1.0e30f;
#pragma unroll
    for (int r = 0; r < 16; ++r) { const int cr_ = crow(r, hi); if (!(r32 < cr_)) p[0][r] = NEG; if (!(cr_ <= r32)) p[4][r] = NEG; }
    if (q0 < 128) {
#pragma unroll
        for (int hb = 0; hb < 5; ++hb)
#pragma unroll
            for (int r = 0; r < 16; ++r) { if (qw - 128 + 32 * hb + crow(r, hi) < 0) p[hb][r] = NEG; }
    }
    float m = sink2;
#pragma unroll
    for (int hb = 0; hb < 5; ++hb)
#pragma unroll
        for (int r = 0; r < 16; ++r) m = fmaxf(m, p[hb][r]);
    m = xhalf_max(m);
    float lsum = 0.f;
#pragma unroll
    for (int hb = 0; hb < 5; ++hb)
#pragma unroll
        for (int r = 0; r < 16; ++r) { const float e = __builtin_amdgcn_exp2f(p[hb][r] - m); p[hb][r] = e; lsum += e; }
    lsum = xhalf_sum(lsum) + __builtin_amdgcn_exp2f(sink2 - m);
    f32x16 o[2]; o[0] = f32x16{}; o[1] = f32x16{};
    const lds_cptr vp0 = (lds_cptr)shm + LDS_V + ((lane >> 4) & 1) * 32 + (lane & 3) * 8 + (4 * hi + ((lane & 15) >> 2)) * 64;
#pragma unroll
    for (int hb = 0; hb < 5; ++hb) {
#pragma unroll
        for (int kk = 0; kk < 2; ++kk) {
            const int ko = 32 * (qsub + hb) + 16 * kk, j = ko >> 6, ks = (ko >> 4) & 3;
            u32x4 pw; pw.x = cvtpk(p[hb][8 * kk + 0], p[hb][8 * kk + 1]); pw.y = cvtpk(p[hb][8 * kk + 2], p[hb][8 * kk + 3]); pw.z = cvtpk(p[hb][8 * kk + 4], p[hb][8 * kk + 5]); pw.w = cvtpk(p[hb][8 * kk + 6], p[hb][8 * kk + 7]);
            const bf16x8 pa = __builtin_bit_cast(bf16x8, pw);
#pragma unroll
            for (int d0 = 0; d0 < 2; ++d0) {
                const lds_cptr vp = vp0 + j * SLOTB + d0 * 4096 + ks * 1024;
                const s16x4 lo = vtr(vp), hh = vtr(vp + 512);
                const bf16x8 vf = (bf16x8){lo[0], lo[1], lo[2], lo[3], hh[0], hh[1], hh[2], hh[3]};
                o[d0] = __builtin_amdgcn_mfma_f32_32x32x16_bf16(pa, vf, o[d0], 0, 0, 0);
            }
        }
    }
    LAS float* wsf = (LAS float*)(shm0 + LDS_WS) + wid * 64;
    if (hi == 0) wsf[r32] = lsum;
    asm volatile("s_waitcnt lgkmcnt(0)" ::: "memory");
    float rli[16];
#pragma unroll
    for (int r = 0; r < 16; ++r) rli[r] = __builtin_amdgcn_rcpf(wsf[crow(r, hi)]);
    LAS bf16* stg = (LAS bf16*)(shm0 + LDS_OST) + wid * 1024;
    bf16* Ow = MIX + (rowbase + qw) * D + h * 64;
    float ssrow[2] = {0.f, 0.f};
#pragma unroll
    for (int d0 = 0; d0 < 2; ++d0) {
#pragma unroll
        for (int r = 0; r < 16; ++r) stg[crow(r, hi) * 32 + r32] = (bf16)pg8::cvt_pk_bf16(o[d0][r] * rli[r], 0.f);
        asm volatile("s_waitcnt lgkmcnt(0)" ::: "memory");
#pragma unroll
        for (int i = 0; i < 2; ++i) { const int row = i * 16 + (lane >> 2), ch = lane & 3; const u32x4 v = *(const LAS u32x4*)(stg + row * 32 + ch * 8);
            *(u32x4*)(Ow + (size_t)row * D + d0 * 32 + ch * 8) = v;
            const unsigned w4[4] = {v.x, v.y, v.z, v.w};
#pragma unroll
            for (int k = 0; k < 4; ++k) { const float a = pg8::bf_lo(w4[k]), cc = pg8::bf_hi(w4[k]); ssrow[i] += a * a + cc * cc; } }
        asm volatile("s_waitcnt lgkmcnt(0)" ::: "memory");
    }
#pragma unroll
    for (int i = 0; i < 2; ++i) { float ss = ssrow[i]; ss += __shfl_xor(ss, 1); ss += __shfl_xor(ss, 2); if ((lane & 3) == 0) ssq[(rowbase + qw + i * 16 + (lane >> 2)) * 8 + h] = ss; }
}
}
__device__ __forceinline__ void attn_phase_v1(Frame& F, const Args& a, int l, int first, int count) {
    const int me = (int)blockIdx.x - first; if (me < 0 || me >= count) return;
    const bf16* QKVU = (const bf16*)(F.ws + WS_QKVU); bf16* MIX = (bf16*)(F.ws + WS_MIX); float* ssq = (float*)(F.ws + WS_SSQ_ATT);
    att::Ctx c; { int tid_ = F.tid; asm volatile("" : "+v"(tid_)); c.tid = tid_; c.lane = tid_ & 63; c.r32 = c.lane & 31; c.hi = c.lane >> 5; c.wid = __builtin_amdgcn_readfirstlane(tid_ >> 6); }
    constexpr int NU = BATCH * NKV * (SEQ / 64);
    att::bf16x8 qr[4], qn[4];
    int u = me, it = 0;
    if (u >= NU) return;
    asm volatile("s_waitcnt lgkmcnt(0)\n\ts_barrier" ::: "memory");
    att::attn_issue(c, u, 0, QKVU, F.lds + RING_OFF, qr);
    for (; u < NU; u += count, ++it) {
        const bool has_next = u + count < NU;
        if (has_next) att::attn_issue(c, u + count, (it + 1) & 1, QKVU, F.lds + RING_OFF, qn);
        if (has_next && it > 0) asm volatile("s_waitcnt vmcnt(14)" ::: "memory"); else if (has_next) asm volatile("s_waitcnt vmcnt(10)" ::: "memory"); else asm volatile("s_waitcnt vmcnt(0)" ::: "memory");
        asm volatile("s_barrier" ::: "memory");
        att::attn_compute(c, u, it & 1, qr, MIX, ssq, a.in[5] + l * NH, F.lds + RING_OFF);
        asm volatile("s_waitcnt lgkmcnt(0)\n\ts_barrier" ::: "memory");
#pragma unroll
        for (int d0 = 0; d0 < 4; ++d0) qr[d0] = qn[d0];
    }
}

__device__ __forceinline__ float gelu_tanh(float y) {
    const float t = y * (2.0f * 0.7978845608028654f * LOG2E + (2.0f * 0.7978845608028654f * 0.044715f * LOG2E) * y * y);
    return y - y * __builtin_amdgcn_rcpf(1.0f + __builtin_amdgcn_exp2f(t));
}
namespace ssm {
typedef short bf16x8 __attribute__((ext_vector_type(8)));
typedef float f32x16 __attribute__((ext_vector_type(16)));
constexpr int UST = 528, UBUF = 64 * UST, HST = 272;
constexpr int L_U = 0, L_SL = 2 * UBUF, L_HB = L_SL  , L_TF = L_SL + 64 * 128 * 4, L_END = L_TF + 19 * 1024;
static_assert(L_END <= RING_BYTES, "ssm LDS");
__device__ __forceinline__ int crow(int r, int hi) { return (r & 3) + 8 * (r >> 2) + 4 * hi; }
constexpr int M_U = 0, M_SL = UBUF, M_HB = M_SL + 64 * 128 * 4, M_TF = M_HB + 64 * HST, M_HIN = M_TF + 19 * 1024, M_END = M_HIN + 512;
static_assert(M_END <= RING_BYTES, "ssm LDS (decoupled)");
typedef __attribute__((address_space(1))) unsigned long long gu64s;
__device__ __forceinline__ void ssm_job2(int bg, int sb, int l, unsigned char* ws, LAS unsigned char* shm) {
    int tid_ = threadIdx.x; asm volatile("" : "+v"(tid_));
    const int tid = tid_, lane = tid & 63, r32 = lane & 31, hi = lane >> 5; const int w = __builtin_amdgcn_readfirstlane(tid >> 6);
    const int b = bg / NG, g = bg % NG;
    const bf16* UGp = (const bf16*)(ws + WS_UG); bf16* YG = (bf16*)(ws + WS_YG);
    unsigned char* sp = ws + WS_SSMPRE + l * SSMPRE_STRIDE;
    const bf16* TOEP = (const bf16*)(sp + SP_TOEP) + (size_t)g * 8192; const bf16* WSTT = (const bf16*)(sp + SP_WSTT) + (size_t)g * 32768; const bf16* WOUTT = (const bf16*)(sp + SP_WOUTT) + (size_t)g * 32768;
    const float* AC = (const float*)(sp + SP_ACC) + g * 128; const float* AC64 = (const float*)(sp + SP_AC64) + g * 128; const float* PW = (const float*)(sp + SP_PW) + (size_t)g * 8192;
    gu64s* eb = (gu64s*)(ws + WS_EB) + (size_t)((l * 64 + bg) * 8) * 128;
    const int mt1 = w >> 2, nt1 = w & 3;
    const int J = w < 4 ? w : 11 - w, ns = 2 * J + 2;
    const size_t rowb = (size_t)b * SEQ + (size_t)sb * 1024;
    v4u up[4];
#pragma unroll
    for (int i = 0; i < 4; ++i) { const int pi = tid + 512 * i; up[i] = *(const v4u*)(UGp + ((size_t)g * T + rowb) * GD + (size_t)pi * 8); }
    bf16x8 tfr[2];
#pragma unroll
    for (int i = 0; i < 2; ++i) tfr[i] = *(const bf16x8*)(TOEP + (size_t)((2 * w + i) * 64 + lane) * 8);
    float2 pwv[8];
#pragma unroll
    for (int i = 0; i < 8; ++i) pwv[i] = *(const float2*)(PW + (size_t)(((tid >> 6) + 8 * i) * 64 + (tid & 63)) * 2);
    const float acr = AC[lane], aci = AC[64 + lane], a64r = AC64[lane], a64i = AC64[64 + lane];
    bf16x8 bw1[16], bc[8];
#pragma unroll
    for (int ks = 0; ks < 16; ++ks) bw1[ks] = *(const bf16x8*)(WSTT + (size_t)((nt1 * 16 + ks) * 64 + lane) * 8);
#pragma unroll
    for (int ks = 0; ks < 8; ++ks) bc[ks] = *(const bf16x8*)(WOUTT + (size_t)((J * 8 + ks) * 64 + lane) * 8);
#pragma unroll
    for (int i = 0; i < 4; ++i) { const int pi = tid + 512 * i, row = pi >> 1; *(LAS v4u*)(shm + M_U + (row >> 4) * UST + (row & 15) * 32 + (pi & 1) * 16) = up[i]; }
#pragma unroll
    for (int i = 0; i < 2; ++i) *(LAS bf16x8*)(shm + M_TF + (2 * w + i) * 1024 + lane * 16) = tfr[i];
    if (w < 3) { unsigned z0, z1, z2, z3; asm volatile("v_mov_b32 %0, 0\n\tv_mov_b32 %1, 0\n\tv_mov_b32 %2, 0\n\tv_mov_b32 %3, 0" : "=v"(z0), "=v"(z1), "=v"(z2), "=v"(z3));
        *(LAS v4u*)(shm + M_TF + (16 + w) * 1024 + lane * 16) = (v4u){z0, z1, z2, z3}; }
    asm volatile("s_waitcnt lgkmcnt(0)\n\ts_barrier" ::: "memory");
    const LAS unsigned char* ub = shm + M_U + hi * 16;
    {
        f32x16 acc = {};
#pragma unroll
        for (int ks = 0; ks < 16; ++ks) { const bf16x8 af = *(const LAS bf16x8*)(ub + (32 * mt1 + r32) * UST + ks * 32); acc = __builtin_amdgcn_mfma_f32_32x32x16_bf16(af, bw1[ks], acc, 0, 0, 0); }
        LAS float* sl = (LAS float*)(shm + M_SL);
#pragma unroll
        for (int r = 0; r < 16; ++r) sl[(32 * mt1 + crow(r, hi)) * 128 + 32 * nt1 + r32] = acc[r];
    }
    asm volatile("s_waitcnt lgkmcnt(0)\n\ts_barrier" ::: "memory");
    if (w == 0) {
        LAS float* sl = (LAS float*)(shm + M_SL);
        float pwr[4], pwi[4]; pwr[0] = acr; pwi[0] = aci;
#pragma unroll
        for (int j = 1; j < 4; ++j) { pwr[j] = pwr[j - 1] * acr - pwi[j - 1] * aci; pwi[j] = pwr[j - 1] * aci + pwi[j - 1] * acr; }
        float hr = 0.f, hi_ = 0.f;
        for (int c0 = 0; c0 < 64; c0 += 16) {
            float sr[16], si[16];
#pragma unroll
            for (int i = 0; i < 16; ++i) { sr[i] = sl[(c0 + i) * 128 + lane]; si[i] = sl[(c0 + i) * 128 + 64 + lane]; }
            asm volatile("s_waitcnt lgkmcnt(0)" ::: "memory");
#pragma unroll
            for (int gq = 0; gq < 4; ++gq) {
                float tr[4], ti[4]; tr[0] = sr[4 * gq]; ti[0] = si[4 * gq];
#pragma unroll
                for (int j = 1; j < 4; ++j) { tr[j] = __builtin_fmaf(acr, tr[j - 1], __builtin_fmaf(-aci, ti[j - 1], sr[4 * gq + j])); ti[j] = __builtin_fmaf(acr, ti[j - 1], __builtin_fmaf(aci, tr[j - 1], si[4 * gq + j])); }
                sl[(c0 + 4 * gq) * 128 + lane] = hr; sl[(c0 + 4 * gq) * 128 + 64 + lane] = hi_;
#pragma unroll
                for (int j = 1; j < 4; ++j) { const float xr = __builtin_fmaf(pwr[j - 1], hr, __builtin_fmaf(-pwi[j - 1], hi_, tr[j - 1])), xi = __builtin_fmaf(pwr[j - 1], hi_, __builtin_fmaf(pwi[j - 1], hr, ti[j - 1]));
                    sl[(c0 + 4 * gq + j) * 128 + lane] = xr; sl[(c0 + 4 * gq + j) * 128 + 64 + lane] = xi; }
                const float nr = __builtin_fmaf(pwr[3], hr, __builtin_fmaf(-pwi[3], hi_, tr[3])), ni = __builtin_fmaf(pwr[3], hi_, __builtin_fmaf(pwi[3], hr, ti[3])); hr = nr; hi_ = ni;
            }
        }
        { unsigned tagv; asm volatile("v_mov_b32 %0, %1" : "=v"(tagv) : "s"(EB_TAG));
          __hip_atomic_store(eb + sb * 128 + lane, ((unsigned long long)tagv << 32) | __float_as_uint(hr), __ATOMIC_RELAXED, __HIP_MEMORY_SCOPE_AGENT);
          __hip_atomic_store(eb + sb * 128 + 64 + lane, ((unsigned long long)tagv << 32) | __float_as_uint(hi_), __ATOMIC_RELAXED, __HIP_MEMORY_SCOPE_AGENT); }
        float Hr = 0.f, Hi = 0.f;
        for (int sp_ = 0; sp_ < sb; ++sp_) {
            unsigned long long xr = 0, xi = 0;
            for (unsigned spins = 0;; ++spins) {
                xr = __hip_atomic_load(eb + sp_ * 128 + lane, __ATOMIC_RELAXED, __HIP_MEMORY_SCOPE_AGENT); xi = __hip_atomic_load(eb + sp_ * 128 + 64 + lane, __ATOMIC_RELAXED, __HIP_MEMORY_SCOPE_AGENT);
                const bool ok = (unsigned)(xr >> 32) == EB_TAG && (unsigned)(xi >> 32) == EB_TAG;
                if (__all(ok)) break;
                if (spins > (1u << 20)) break;
                __builtin_amdgcn_s_sleep(2);
            }
            const float er = __uint_as_float((unsigned)xr), ei = __uint_as_float((unsigned)xi);
            const float nr = __builtin_fmaf(a64r, Hr, __builtin_fmaf(-a64i, Hi, er)), ni = __builtin_fmaf(a64r, Hi, __builtin_fmaf(a64i, Hr, ei)); Hr = nr; Hi = ni;
        }
        LAS float* hin = (LAS float*)(shm + M_HIN); hin[lane] = Hr; hin[64 + lane] = Hi;
    }
    f32x16 acc2[2]; acc2[0] = f32x16{}; acc2[1] = f32x16{};
#pragma unroll
    for (int kb = 0; kb < 4; ++kb) { if (4 * kb < ns) {
        bf16x8 bf[4];
#pragma unroll
        for (int q = 0; q < 4; ++q) bf[q] = *(const LAS bf16x8*)(shm + M_TF + (14 - 2 * J + 4 * kb + q) * 1024 + lane * 16);
#pragma unroll
        for (int mt = 0; mt < 2; ++mt) { bf16x8 af[4];
#pragma unroll
            for (int q = 0; q < 4; ++q) af[q] = *(const LAS bf16x8*)(ub + (32 * mt + r32) * UST + (4 * kb + q) * 32);
#pragma unroll
            for (int q = 0; q < 4; ++q) acc2[mt] = __builtin_amdgcn_mfma_f32_32x32x16_bf16(af[q], bf[q], acc2[mt], 0, 0, 0); }
    } }
    asm volatile("s_waitcnt lgkmcnt(0)\n\ts_barrier" ::: "memory");
    {
        const int n = tid & 63, cq = tid >> 6; const LAS float* sl = (const LAS float*)(shm + M_SL); const LAS float* hin = (const LAS float*)(shm + M_HIN);
        const float Hr = hin[n], Hi = hin[64 + n];
#pragma unroll
        for (int i = 0; i < 8; ++i) { const int c = cq + 8 * i; const float2 pw = pwv[i];
            const float xr = sl[c * 128 + n] + pw.x * Hr - pw.y * Hi, xi = sl[c * 128 + 64 + n] + pw.x * Hi + pw.y * Hr;
            *(LAS unsigned*)(shm + M_HB + c * HST + n * 4) = pg8::cvt_pk_bf16(xr, xi); }
    }
    asm volatile("s_waitcnt lgkmcnt(0)\n\ts_barrier" ::: "memory");
#pragma unroll
    for (int ks = 0; ks < 8; ++ks) {
#pragma unroll
        for (int mt = 0; mt < 2; ++mt) { const bf16x8 af = *(const LAS bf16x8*)(shm + M_HB + (32 * mt + r32) * HST + ks * 32 + hi * 16); acc2[mt] = __builtin_amdgcn_mfma_f32_32x32x16_bf16(af, bc[ks], acc2[mt], 0, 0, 0); } }
    {   const int t = 2 * J + (r32 >> 4), co = r32 & 15;
#pragma unroll
        for (int mt = 0; mt < 2; ++mt)
#pragma unroll
            for (int r = 0; r < 16; ++r) { const int chunk = 32 * mt + crow(r, hi);
                YG[(rowb + (size_t)chunk * 16 + t) * SW + 16 * g + co] = (bf16)pg8::cvt_pk_bf16(gelu_tanh(acc2[mt][r]), 0.f); } }
    asm volatile("s_waitcnt lgkmcnt(0)\n\ts_barrier" ::: "memory");
}
}
__device__ __forceinline__ void ssm_phase_v2(Frame& F, int l) {
    for (int j = blockIdx.x; j < BATCH * NG * (SEQ / 1024); j += F.G) ssm::ssm_job2(j % (BATCH * NG), j / (BATCH * NG), l, F.ws, F.lds + RING_OFF);
}

__device__ __forceinline__ void route1(Frame& F, const Args& a) {
    LAS int* hl = (LAS int*)(F.lds + RING_OFF);
    unsigned char* rt = F.ws + WS_ROUTE; int* TOPE = (int*)(rt + RT_TOPE); float* TOPG = (float*)(rt + RT_TOPG); float* RINVT = (float*)(rt + RT_RINVT); int* HIST = (int*)(rt + RT_HIST);
    const float* wr = a.in[22]; const float* gn = a.in[18] + D;
    f32x4 w0[4][4], w1[4][4];
#pragma unroll
    for (int j = 0; j < 4; ++j)
#pragma unroll
        for (int q = 0; q < 4; ++q) { const int k = 4 * (F.lane + 64 * j) + q; const float g = gn[k]; w0[j][q] = *(const f32x4*)(wr + k * 8) * g; w1[j][q] = *(const f32x4*)(wr + k * 8 + 4) * g; }
    for (int blk = blockIdx.x; blk < T / 64; blk += F.G) {
        __syncthreads();
        if (F.tid < 8) hl[F.tid] = 0;
        __syncthreads();
        for (int ib = 0; ib < 8; ib += 2) {
            f32x4 xv4[2][4];
#pragma unroll
            for (int i = 0; i < 2; ++i) { const GAS unsigned long long* xr = (const GAS unsigned long long*)((const bf16*)(F.ws + WS_XB) + (size_t)(blk * 64 + F.wave * 8 + ib + i) * D) + F.lane;
#pragma unroll
                for (int j = 0; j < 4; ++j) { const unsigned long long w = xr[64 * j]; const unsigned lo = (unsigned)w, hi2 = (unsigned)(w >> 32); xv4[i][j] = (f32x4){pg8::bf_lo(lo), pg8::bf_hi(lo), pg8::bf_lo(hi2), pg8::bf_hi(hi2)}; } }
#pragma unroll
            for (int i = 0; i < 2; ++i) {
            const int t = blk * 64 + F.wave * 8 + ib + i;
            f32x4 la = {0.f, 0.f, 0.f, 0.f}, lb = {0.f, 0.f, 0.f, 0.f}; float ss = 0.f;
#pragma unroll
            for (int j = 0; j < 4; ++j) { const f32x4 v = xv4[i][j]; const float xv[4] = {v.x, v.y, v.z, v.w};
#pragma unroll
                for (int q = 0; q < 4; ++q) { ss += xv[q] * xv[q]; la += w0[j][q] * xv[q]; lb += w1[j][q] * xv[q]; } }
            ss = wave_sum(ss);
            float lg[8] = {la.x, la.y, la.z, la.w, lb.x, lb.y, lb.z, lb.w};
#pragma unroll
            for (int e = 0; e < 8; ++e) lg[e] = wave_sum(lg[e]);
            const float rinv = 1.0f / sqrtf(ss * (1.0f / D) + EPS);
            int e1 = 0; float l1 = lg[0];
#pragma unroll
            for (int e = 1; e < 8; ++e) if (lg[e] > l1) { l1 = lg[e]; e1 = e; }
            int e2 = -1; float l2 = -3.0e38f;
#pragma unroll
            for (int e = 0; e < 8; ++e) if (e != e1 && lg[e] > l2) { l2 = lg[e]; e2 = e; }
            const float g2 = 1.0f / (1.0f + __expf((l1 - l2) * rinv)), g1 = 1.0f - g2;
            if (F.lane == 0) { TOPE[t * 2] = e1; TOPE[t * 2 + 1] = e2; TOPG[t * 2] = g1; TOPG[t * 2 + 1] = g2; RINVT[t] = rinv; atomicAdd((int*)&hl[e1], 1); atomicAdd((int*)&hl[e2], 1); }
            }
        }
        __syncthreads();
        if (F.tid < 8) HIST[blk * 8 + F.tid] = hl[F.tid];
    }
    __syncthreads();
}
__device__ __forceinline__ void route2(Frame& F) {
    LAS int* sb = (LAS int*)(F.lds + RING_OFF);
    unsigned char* rt = F.ws + WS_ROUTE; const int* TOPE = (const int*)(rt + RT_TOPE); const float* TOPG = (const float*)(rt + RT_TOPG); const float* RINVT = (const float*)(rt + RT_RINVT); const int* HIST = (const int*)(rt + RT_HIST);
    int* IDX = (int*)(rt + RT_IDX); float* GATE = (float*)(rt + RT_GATE); float* RINVS = (float*)(rt + RT_RINVS); int* POS = (int*)(rt + RT_POS); int* PEND = (int*)(rt + RT_PEND);
    for (int blk = blockIdx.x; blk < T / 64; blk += F.G) {
        __syncthreads();
        if (F.tid < 16) sb[F.tid] = 0;
        __syncthreads();
        if (F.tid < T / 64) {
            const int4 h0 = *(const int4*)(HIST + F.tid * 8), h1 = *(const int4*)(HIST + F.tid * 8 + 4); const int hv[8] = {h0.x, h0.y, h0.z, h0.w, h1.x, h1.y, h1.z, h1.w};
#pragma unroll
            for (int e = 0; e < 8; ++e) { atomicAdd((int*)&sb[e], hv[e]); if (F.tid < blk) atomicAdd((int*)&sb[8 + e], hv[e]); }
        }
        __syncthreads();
        if (F.tid == 0) { int ps = 0; for (int e = 0; e < 8; ++e) { const int pd = (sb[e] + 255) & ~255; sb[16 + e] = ps; sb[24 + e] = pd; ps += pd; if (blk == 0) PEND[e] = ps >> 8; } }
        __syncthreads();
        if (F.wave == 0) {
            const int t = blk * 64 + F.lane; int run[8];
#pragma unroll
            for (int e = 0; e < 8; ++e) run[e] = sb[16 + e] + sb[8 + e];
#pragma unroll
            for (int k = 0; k < 2; ++k) { const int e = TOPE[t * 2 + k]; int slot = 0;
#pragma unroll
                for (int ee = 0; ee < 8; ++ee) { const unsigned long long mk = __ballot(e == ee); const int below = __popcll(mk & ((1ull << F.lane) - 1ull));
                    if (e == ee) slot = run[ee] + below; run[ee] += __popcll(mk); }
                IDX[slot] = t; GATE[slot] = TOPG[t * 2 + k]; RINVS[slot] = RINVT[t]; POS[t * 2 + k] = slot; }
        }
        if (blk == 0) {
            for (int e = 0; e < 8; ++e) { const int s0 = sb[16 + e] + sb[e], s1 = sb[16 + e] + sb[24 + e]; for (int s = s0 + F.tid; s < s1; s += 512) { IDX[s] = 0; GATE[s] = 0.f; RINVS[s] = 0.f; } }
        }
    }
    __syncthreads();
}
__device__ __forceinline__ void moe_combine(Frame& F) {
    const bf16* YS = (const bf16*)(F.ws + WS_YS); const int* POS = (const int*)(F.ws + WS_ROUTE + RT_POS); const float* GATE = (const float*)(F.ws + WS_ROUTE + RT_GATE);
    const unsigned* TM = (const unsigned*)(F.ws + WS_CTL) + CW_TAILMAP; const float* SLAB = (const float*)(F.ws + WS_SLAB);
    const int S = pg8::ks_slices(((const int*)(F.ws + WS_ROUTE + RT_PEND))[7] * (D / 256), F.G);
    const int gw = F.vcu * NWAVES + F.wave, NGW = F.G * NWAVES;
    for (int t = gw; t < T; t += NGW) {
        const int p0 = POS[t * 2], p1 = POS[t * 2 + 1];
        const v4u tm0 = *(const v4u*)(TM + (p0 >> 8) * 4), tm1 = *(const v4u*)(TM + (p1 >> 8) * 4);
        GAS f32x4* xr = (GAS f32x4*)(F.out + (size_t)t * D) + F.lane;
        const GAS unsigned long long* xb = (const GAS unsigned long long*)((const bf16*)(F.ws + WS_XB) + (size_t)t * D) + F.lane;
        const bf16* YS2 = (const bf16*)(F.ws + WS_YS2);
        const GAS unsigned long long* y0 = (const GAS unsigned long long*)(p0 < YS_SPLIT ? YS + (size_t)p0 * D : YS2 + (size_t)(p0 - YS_SPLIT) * D) + F.lane; const GAS unsigned long long* y1 = (const GAS unsigned long long*)(p1 < YS_SPLIT ? YS + (size_t)p1 * D : YS2 + (size_t)(p1 - YS_SPLIT) * D) + F.lane;
        f32x4 v[4]; unsigned long long a0[4], a1[4];
#pragma unroll
        for (int j = 0; j < 4; ++j) { const unsigned long long w = xb[64 * j]; const unsigned lo = (unsigned)w, hi2 = (unsigned)(w >> 32); v[j] = (f32x4){pg8::bf_lo(lo), pg8::bf_hi(lo), pg8::bf_lo(hi2), pg8::bf_hi(hi2)}; a0[j] = y0[64 * j]; a1[j] = y1[64 * j]; }
        const unsigned t0[4] = {tm0.x, tm0.y, tm0.z, tm0.w}, t1[4] = {tm1.x, tm1.y, tm1.z, tm1.w};
#pragma unroll
        for (int j = 0; j < 4; ++j) { f32x4 y = {0.f, 0.f, 0.f, 0.f};
#pragma unroll
            for (int k = 0; k < 2; ++k) { const int p = k ? p1 : p0; const unsigned tm = k ? t1[j] : t0[j]; const unsigned long long aa = k ? a1[j] : a0[j];
                if (tm == 0u) { const unsigned lo = (unsigned)aa, hi = (unsigned)(aa >> 32); y.x += pg8::bf_lo(lo); y.y += pg8::bf_hi(lo); y.z += pg8::bf_lo(hi); y.w += pg8::bf_hi(hi); }
                else {
                    f32x4 a = {0.f, 0.f, 0.f, 0.f}; const float* sp = SLAB + (size_t)(tm - 1u) * S * 65536 + (size_t)(p & 255) * 256 + 4 * F.lane;
                    for (int q = 0; q < S; ++q) a += *(const f32x4*)(sp + (size_t)q * 65536);
                    y += a * GATE[p]; }
            }
            xr[64 * j] = v[j] + y; }
    }
}

__device__ __forceinline__ int wd_quota(int rem, int G) { if (rem == 0) return 0; const int q = (G - rem) * NWAVES * 7; return q < NE * IT_DN ? q : NE * IT_DN; }
constexpr int NPHASE = 19;
__global__ void __launch_bounds__(NWAVES * 64, 2) hymba_fwd(Args args) {
    extern __shared__ __attribute__((aligned(16))) unsigned char lds[];
    Frame F;
    F.lds = (LAS unsigned char*)lds; F.MISC = (volatile LAS unsigned*)(F.lds + MISC_OFF);
    F.tid = threadIdx.x; F.lane = F.tid & 63; F.wave = __builtin_amdgcn_readfirstlane(F.tid >> 6);
    F.G = gridDim.x; { const int bx = blockIdx.x; F.vcu = (F.G % 8 == 0) ? (bx % 8) * (F.G / 8) + bx / 8 : bx; }
    F.ws = args.ws; F.out = args.out; F.ctl = (gu32*)(args.ws + WS_CTL);
    for (int u = F.tid; u < (LDS_BYTES - LDSCTL_OFF) / 4; u += NWAVES * 64) ((LAS unsigned*)(F.lds + LDSCTL_OFF))[u] = 0u;
    __syncthreads();
    const int lo = args.ph_lo, hi = args.ph_hi;
    XcdBarrier bar; bar.bar = (unsigned*)(F.ctl + CW_BAR); bar.x = 0; bar.st = nullptr;
    if (hi - lo > 1) bar = xcd_barrier_post((unsigned*)(F.ctl + CW_BAR), F.MISC + 8);
#ifndef PH_MASK
#define PH_MASK 0x7FFFF
#endif
#define IN(k) (((PH_MASK >> (k)) & 1) && lo <= (k) && (k) < hi)
#define SEAM(k) do { if ((k) + 1 < hi) xcd_barrier(bar); } while (0)
#ifndef PH_TWICE
#define PH_TWICE 0
#endif
#define REP(k) for (int rep_ = 0; rep_ < 1 + ((PH_TWICE >> (k)) & 1); ++rep_)
#define REPSEAM() do { if (rep_ == 0 && hi - lo > 1) xcd_barrier(bar); } while (0)
    unsigned char* ws = args.ws;
#define PH() do { GAS unsigned char* w_ = (GAS unsigned char*)args.ws; GAS float* o_ = (GAS float*)args.out; int t_ = threadIdx.x; asm volatile("" : "+s"(w_), "+s"(o_), "+v"(t_)); F.ws = (unsigned char*)w_; F.out = (float*)o_; F.tid = t_; F.lane = t_ & 63; ws = (unsigned char*)w_; } while (0)
#define XB_ ((bf16*)(ws + WS_XB))
#define QKVU_ ((bf16*)(ws + WS_QKVU))
#define MIX_ ((bf16*)(ws + WS_MIX))
#define YG_ ((bf16*)(ws + WS_YG))
#define SSQ_A_ ((float*)(ws + WS_SSQ_A))
#define SSQ_F_ ((float*)(ws + WS_SSQ_F))
#define SSQ_ATT_ ((float*)(ws + WS_SSQ_ATT))
#define SSQ_SSM_ ((float*)(ws + WS_SSQ_SSM))

    if (IN(0)) REP(0) {
        PH();
        { v4u* ebz = (v4u*)(ws + WS_EB); for (int i = (int)blockIdx.x * 512 + F.tid; i < 65536; i += F.G * 512) ebz[i] = (v4u){0u, 0u, 0u, 0u}; }
        p0_xb(F, args.in[0], (int)blockIdx.x, F.G);
        { LAS unsigned char* scr = F.lds + RING_OFF + F.wave * CONV_LDS; const int it = F.vcu * NWAVES + F.wave;
          if (it < IT_IN) conv_inproj(args.in[2], args.in[1], (bf16*)(ws + WS_WSMALL + WS_WIN), it, F.lane, scr); }
        SEAM(0);
    }
    if (IN(1) && lo <= 1 && 1 < hi) { PH(); if ((int)blockIdx.x >= 64 && (int)blockIdx.x < 64 + 2 * NG) ssm_precompute(F, args, ((int)blockIdx.x - 64) / NG, ((int)blockIdx.x - 64) % NG); }
    for (int l = 0; l < 2; ++l) {
        const int pb = l == 0 ? 1 : 8;
        if (IN(pb)) REP(pb) {
            PH(); unsigned char* wb = ws + WS_WSMALL + l * WSMALL_STRIDE;
            pg8::Gemm g{XB_, (const bf16*)(wb + WS_WIN), nullptr}; pg8::StaticOrder S; S.init(T, INW, F.G, (int)blockIdx.x);
            pg8::EpiInProj E{QKVU_, (bf16*)(ws + WS_UG), SSQ_A_, args.in[3] + l * HD, args.in[4] + l * HD, 0.125f * LOG2E};
            pg8::gemm_phase<pg8::EpiInProj, pg8::StaticOrder, false, D>(F.lds + RING_OFF, g, S, E);
            if (l == 0 && (int)blockIdx.x >= 64 + 2 * NG) p0_convert(F, args, (int)blockIdx.x - 64 - 2 * NG, F.G - 64 - 2 * NG, IT_IN, IT_P0);
            bg_convert(F, args, l == 0 ? 0 : BG_B3, l == 0 ? BG_B1 : BG_B4, (int)blockIdx.x - (l == 0 ? 64 + 2 * NG : 64), F.G - (l == 0 ? 64 + 2 * NG : 64));
            SEAM(pb);
        }
        if (IN(pb + 1)) REP(pb + 1) { PH(); ssm_phase_v2(F, l); attn_phase_v1(F, args, l, 0, F.G); bg_convert(F, args, l == 0 ? BG_B1 : BG_B4, l == 0 ? BG_B2 : BG_B5, (int)blockIdx.x, F.G); SEAM(pb + 1); }
        if (IN(pb + 3)) REP(pb + 3) {
            PH(); unsigned char* wb = ws + WS_WSMALL + l * WSMALL_STRIDE;
            pg8::Gemm g{YG_, (const bf16*)(wb + WS_WGLU), nullptr}; pg8::StaticOrder S; S.init(T, SW, F.G, (int)blockIdx.x);
            pg8::EpiGlu E{YG_, MIX_, SSQ_SSM_};
            pg8::gemm_phase<pg8::EpiGlu, pg8::StaticOrder, false, SW>(F.lds + RING_OFF, g, S, E);
            bg_convert(F, args, l == 0 ? BG_B2 : BG_B5, l == 0 ? BG_B3 : BG_B6, (int)blockIdx.x - 128, F.G - 128);
            SEAM(pb + 3);
        }
        if (IN(pb + 4)) REP(pb + 4) {
            PH(); unsigned char* wb = ws + WS_WSMALL + l * WSMALL_STRIDE;
            pg8::Gemm g{MIX_, (const bf16*)(wb + WS_WO), nullptr}; pg8::StaticOrder S; S.init(T, D, F.G, (int)blockIdx.x);
            pg8::EpiRes<true, false> E{nullptr, XB_, SSQ_F_, SSQ_ATT_, SSQ_SSM_, (LAS float*)(F.lds + TAB_OFF)};
            pg8::gemm_phase<pg8::EpiRes<true, false>, pg8::StaticOrder, false, D>(F.lds + RING_OFF, g, S, E);
            SEAM(pb + 4);
        }
    if (l == 0) {
        if (IN(6)) REP(6) {
            PH();
            pg8::Gemm g{XB_, (const bf16*)(ws + WS_DGU), nullptr}; pg8::StaticOrder S; S.init(T, 2 * FF, F.G, (int)blockIdx.x);
            pg8::EpiSwiglu<false> E{(bf16*)(ws + WS_HD), nullptr, (LAS float*)(F.lds + TAB2_OFF)};
            pg8::fill_rinv_tab(S, SSQ_F_, (LAS float*)(F.lds + TAB2_OFF), F.tid, TAB2_UNITS);
            pg8::gemm_phase<pg8::EpiSwiglu<false>, pg8::StaticOrder, false, D>(F.lds + RING_OFF, g, S, E);
            SEAM(6);
        }
        if (IN(7)) REP(7) {
            PH();
            pg8::Gemm g{(const bf16*)(ws + WS_HD), (const bf16*)(ws + WS_DD), nullptr}; pg8::StaticOrder S; S.init(T, D, F.G, (int)blockIdx.x);
            pg8::EpiRes<false, false> E{nullptr, XB_, SSQ_A_, nullptr, nullptr, (LAS float*)(F.lds + TAB_OFF)};
            pg8::gemm_phase<pg8::EpiRes<false, false>, pg8::StaticOrder, false, FF>(F.lds + RING_OFF, g, S, E);
            SEAM(7);
        }
    } else {
        if (IN(13)) REP(13) { PH(); route1(F, args); SEAM(13); }
        if (IN(14)) REP(14) { PH(); route2(F); conv_run2<0>(F, args, BG_B6 + (int)blockIdx.x * NWAVES + F.wave, F.G * NWAVES, IT_BG); SEAM(14); }
        if (IN(15)) REP(15) {
            PH(); unsigned char* rt = ws + WS_ROUTE;
            pg8::Gemm g{XB_, (const bf16*)(ws + WS_MOEW), (const int*)(rt + RT_IDX)}; pg8::MoeOrder S; S.init((const int*)(rt + RT_PEND), 2 * FF, F.G, (int)blockIdx.x);
            pg8::EpiSwiglu<true> E{(bf16*)(ws + WS_HS), (const float*)(rt + RT_RINVS), nullptr};
            pg8::gemm_phase<pg8::EpiSwiglu<true>, pg8::MoeOrder, true, D>(F.lds + RING_OFF, g, S, E);
            { const int rem = S.nwg % F.G, q = wd_quota(rem, F.G);
              if (rem && (int)blockIdx.x >= rem) conv_run2<1>(F, args, ((int)blockIdx.x - rem) * NWAVES + F.wave, (F.G - rem) * NWAVES, q); }
            SEAM(15);
        }
        if (IN(16)) REP(16) { PH(); const int nwgu = ((const int*)(ws + WS_ROUTE + RT_PEND))[7] * (2 * FF / 256), q = wd_quota(nwgu % F.G, F.G);
            if (q < NE * IT_DN) { conv_run2<1>(F, args, q + F.vcu * NWAVES + F.wave, F.G * NWAVES, NE * IT_DN); SEAM(16); } }
        if (IN(17)) REP(17) {
            PH(); unsigned char* rt = ws + WS_ROUTE;
            pg8::Gemm g{(const bf16*)(ws + WS_HS), (const bf16*)(ws + WS_WDT), nullptr}; pg8::MoeOrderSplit<FF / 64> S; S.init((const int*)(rt + RT_PEND), D, F.G, (int)blockIdx.x, WDT_E7);
            pg8::EpiMoeDown E{(bf16*)(ws + WS_YS), (bf16*)(ws + WS_YS2), YS_SPLIT, (const float*)(rt + RT_GATE), (float*)(ws + WS_SLAB), (unsigned*)(ws + WS_CTL) + CW_TAILMAP, S.S};
            pg8::gemm_phase<pg8::EpiMoeDown, pg8::MoeOrderSplit<FF / 64>, false, FF>(F.lds + RING_OFF, g, S, E);
            SEAM(17);
        }
        if (IN(18)) REP(18) { PH(); moe_combine(F); }
    }
    }
#undef IN
#undef SEAM
}

extern "C" void kernel_launch(void* const* d_in, const int* in_sizes, int n_in, void* d_out, int out_size, void* d_ws, size_t ws_size, hipStream_t stream) {
    static int grid = 0;
    if (grid == 0) {
        if (n_in != 26 || in_sizes[0] != T * D || out_size != T * D || ws_size < WS_END) { fprintf(stderr, "kernel_launch: unexpected shapes/workspace (n_in %d, in0 %d, out %d, ws %zu, need %zu); nothing launched\n", n_in, n_in > 0 ? in_sizes[0] : -1, out_size, ws_size, (size_t)WS_END); grid = -1; return; }
        int dev = 0, cus = 0, per_cu = 0;
        if (hipGetDevice(&dev) != hipSuccess || hipDeviceGetAttribute(&cus, hipDeviceAttributeMultiprocessorCount, dev) != hipSuccess) { grid = -1; return; }
        if (hipFuncSetAttribute((const void*)hymba_fwd, hipFuncAttributeMaxDynamicSharedMemorySize, LDS_BYTES) != hipSuccess) { fprintf(stderr, "kernel_launch: hipFuncSetAttribute failed\n"); grid = -1; return; }
        if (hipOccupancyMaxActiveBlocksPerMultiprocessor(&per_cu, (const void*)hymba_fwd, NWAVES * 64, LDS_BYTES) != hipSuccess || per_cu < 1) { fprintf(stderr, "kernel_launch: occupancy query reports %d workgroups per CU\n", per_cu); (void)hipGetLastError(); grid = -1; return; }
        grid = cus;
    }
    if (grid < 0) return;
    (void)hipMemsetAsync((char*)d_ws + WS_CTL, 0, CTL_ZERO_BYTES, stream);
    Args a{};
    for (int i = 0; i < 26; ++i) a.in[i] = (const float*)d_in[i];
    a.out = (float*)d_out; a.ws = (unsigned char*)d_ws;
#if MK_N_LAUNCHES == 1
    a.ph_lo = 0; a.ph_hi = NPHASE;
    hipLaunchKernelGGL(hymba_fwd, dim3(grid), dim3(NWAVES * 64), LDS_BYTES, stream, a);
#else
    for (int p = 0; p < NPHASE; ++p) { a.ph_lo = p; a.ph_hi = p + 1; hipLaunchKernelGGL(hymba_fwd, dim3(grid), dim3(NWAVES * 64), LDS_BYTES, stream, a); }
#endif
}
```

```cpp
#include <hip/hip_runtime.h>
#include <cstdio>
#include <cstdint>

#ifndef MK_N_LAUNCHES
#define MK_N_LAUNCHES 1
#endif

constexpr int BATCH = 2, SEQ = 8192, T = BATCH * SEQ, D = 1024, INW = 1280, FF = 3584, NE = 8;
constexpr int NH = 8, NKV = 2, HD = 64, AW = 512, KVW = 128, SW = 512, NG = 32, GD = 16, NS = 64, WIN = 128;
constexpr int QOFF = 0, KOFF = 512, VOFF = 640, UOFF = 768;
constexpr float EPS = 1e-6f;
constexpr float LOG2E = 1.4426950408889634f;
constexpr int CAP = 2 * T + NE * 256;
constexpr int CN = 16;

namespace pg8 {
#define PG8_LAS __attribute__((address_space(3)))
typedef unsigned short bf16_t;
typedef short bf16x8 __attribute__((ext_vector_type(8)));
typedef float f32x4 __attribute__((ext_vector_type(4)));
typedef float f32x2 __attribute__((ext_vector_type(2)));
typedef unsigned u32x4 __attribute__((ext_vector_type(4)));
typedef unsigned u32x2 __attribute__((ext_vector_type(2)));
constexpr int BM = 256, BK = 64, HALF = 128, HTB = HALF * BK * 2, STAGE_BYTES = 8 * HTB, NXCD = 8, WGM = 8;

__host__ __device__ __forceinline__ int lds_byte(int r, int c) { const int st = (r >> 4) * 2 + (c >> 5), rr = r & 15, cc = c & 31, ob = rr * 64 + cc * 2; return st * 1024 + (ob ^ (((ob >> 9) & 1) << 5)); }
__host__ __device__ __forceinline__ void stage_rc(int b, int& R, int& C) { const int st = b / 1024, sb = b % 1024, swz = sb ^ (((sb >> 9) & 1) << 5); R = (st >> 1) * 16 + swz / 64; C = (st & 1) * 32 + (swz % 64) / 2; }
__host__ __device__ __forceinline__ int perm32(int rho) { const int n = rho >> 4, i = rho & 15; return 8 * (i >> 2) + 4 * n + (i & 3); }

struct Unit { int pm, pn, pb, k0, nk, sl; };
struct Gemm { const bf16_t* A; const bf16_t* Bt; const int* idx; };

struct StaticOrder {
    static constexpr bool KSPLIT = false;
    int nM, nN, nwg, G, c;
    __device__ __forceinline__ void init(int M, int N, int G_, int c_) { nM = M / BM; nN = N / BM; nwg = nM * nN; G = G_; c = c_; }
    __device__ __forceinline__ bool next(int i, Unit& u) const {
        const long L = (long)i * G + c; if (L >= nwg) return false;
        int wgid = (int)L; { const int q = nwg / NXCD, r = nwg % NXCD, xcd = wgid % NXCD, off = wgid / NXCD; wgid = (xcd < r ? xcd * (q + 1) : r * (q + 1) + (xcd - r) * q) + off; }
        const int nig = WGM * nN, gid = wgid / nig, fm = gid * WGM, gsz = (nM - fm) < WGM ? (nM - fm) : WGM;
        u.pm = fm + ((wgid % nig) % gsz); u.pn = (wgid % nig) / gsz; u.pb = u.pn; return true;
    }
};
struct MoeOrder {
    static constexpr bool KSPLIT = false;
    int nM, nN, nwg, G, c; int pend[8];
    __device__ __forceinline__ void init(const int* pendg, int N, int G_, int c_) {
#pragma unroll
        for (int e = 0; e < 8; ++e) pend[e] = __builtin_amdgcn_readfirstlane(pendg[e]);
        nM = pend[7]; nN = N / BM; nwg = nM * nN; G = G_; c = c_; }
    __device__ __forceinline__ bool next(int i, Unit& u) const {
        const long L = (long)i * G + c; if (L >= nwg) return false;
        int wgid = (int)L; { const int q = nwg / NXCD, r = nwg % NXCD, xcd = wgid % NXCD, off = wgid / NXCD; wgid = (xcd < r ? xcd * (q + 1) : r * (q + 1) + (xcd - r) * q) + off; }
        const int nig = WGM * nN, gid = wgid / nig, fm = gid * WGM, gsz = (nM - fm) < WGM ? (nM - fm) : WGM;
        u.pm = fm + ((wgid % nig) % gsz); u.pn = (wgid % nig) / gsz;
        int e = 0;
#pragma unroll
        for (int k = 0; k < 7; ++k) e += (pend[k] <= u.pm) ? 1 : 0;
        u.pb = e * nN + u.pn; return true;
    }
};

constexpr int KS_MAXSLAB = 144, KS_MAXS = 8;
__device__ __forceinline__ int ks_slices(int nwg, int G) { const int rem = nwg % G; if (rem == 0) return 1; int S = G / rem; S = S > KS_MAXS ? KS_MAXS : S; if (S * rem > KS_MAXSLAB) S = KS_MAXSLAB / rem; return S < 2 ? 1 : S; }
template <int NT> struct MoeOrderSplit {
    static constexpr bool KSPLIT = true;
    int nM, nN, nwg, G, c, nfull, S, e7tile; int pend[8];
    __device__ __forceinline__ void init(const int* pendg, int N, int G_, int c_, int e7tile_) { e7tile = e7tile_;
#pragma unroll
        for (int e = 0; e < 8; ++e) pend[e] = __builtin_amdgcn_readfirstlane(pendg[e]);
        nM = pend[7]; nN = N / BM; nwg = nM * nN; G = G_; c = c_; S = ks_slices(nwg, G); nfull = S > 1 ? (nwg / G) * G : nwg; }
    __device__ __forceinline__ bool next(int i, Unit& u) const {
        const long L = (long)i * G + c; int wgid, sl = -1, s = 0;
        if (L < nfull) wgid = (int)L; else { const int j = (int)(L - nfull); if (j >= (nwg - nfull) * S) return false; wgid = nfull + j / S; s = j % S; sl = j; }
        { const int q = nwg / NXCD, r = nwg % NXCD, xcd = wgid % NXCD, off = wgid / NXCD; wgid = (xcd < r ? xcd * (q + 1) : r * (q + 1) + (xcd - r) * q) + off; }
        const int nig = WGM * nN, gid = wgid / nig, fm = gid * WGM, gsz = (nM - fm) < WGM ? (nM - fm) : WGM;
        u.pm = fm + ((wgid % nig) % gsz); u.pn = (wgid % nig) / gsz;
        int e = 0;
#pragma unroll
        for (int k = 0; k < 7; ++k) e += (pend[k] <= u.pm) ? 1 : 0;
        u.pb = (e < 7 ? e * nN : e7tile) + u.pn; u.sl = sl;
        if (sl < 0) { u.k0 = 0; u.nk = NT; } else { const int p0 = (NT / 2) * s / S, p1 = (NT / 2) * (s + 1) / S; u.k0 = 2 * p0; u.nk = 2 * (p1 - p0); }
        return true;
    }
};

__device__ __forceinline__ unsigned cvt_pk_bf16(float lo, float hi) { unsigned r; asm volatile("v_cvt_pk_bf16_f32 %0, %1, %2" : "=v"(r) : "v"(lo), "v"(hi)); return r; }
__device__ __forceinline__ float bf_lo(unsigned w) { return __uint_as_float(w << 16); }
__device__ __forceinline__ float bf_hi(unsigned w) { return __uint_as_float(w & 0xffff0000u); }
__device__ __forceinline__ float sum4(const float* p) { const f32x4 v = *(const f32x4*)p; return (v[0] + v[1]) + (v[2] + v[3]); }
__device__ __forceinline__ float sum16(const float* p) { return (sum4(p) + sum4(p + 4)) + (sum4(p + 8) + sum4(p + 12)); }
__device__ __forceinline__ float sum8(const float* p) { return sum4(p) + sum4(p + 4); }

struct EpiInProj {
    static constexpr bool PERM = true, MID = false; static constexpr int MID_T = 0;
    bf16_t* O; bf16_t* UG; PG8_LAS float* tab; const float* gq; const float* gk; float qscale;
    struct State {};
    __device__ __forceinline__ void begin(const Unit&, int, int, State&) const {}
    __device__ __forceinline__ void mid(f32x4 (&)[2][2][4][2], const Unit&, int, int, int, int, int, State&) const {}
    __device__ __forceinline__ void operator()(const f32x4 (&acc)[2][2][4][2], const Unit& u, int ui, int wr, int wc, int fr, int fq, const State& est) const {
        const int row0 = u.pm * BM + wr * 64 + fr, tcol0 = u.pn * BM + 64 * wc;
        const int kind = tcol0 < KOFF ? 0 : (tcol0 < VOFF ? 1 : 2);
        f32x4 gv[2][2];
        if (kind < 2) { const float* g = kind == 0 ? gq : gk;
#pragma unroll
            for (int bj = 0; bj < 2; ++bj)
#pragma unroll
                for (int n = 0; n < 2; ++n) gv[bj][n] = *(const f32x4*)(g + 32 * bj + 8 * fq + 4 * n); }
#pragma unroll
        for (int ai = 0; ai < 2; ++ai) {
            float rinv4[4];
#pragma unroll
            for (int m = 0; m < 4; ++m) rinv4[m] = tab[ui * BM + wr * 64 + fr + ai * HALF + m * 16];
#pragma unroll
            for (int m = 0; m < 4; ++m) {
                const int row = row0 + ai * HALF + m * 16;
                const float rinv = rinv4[m];
                f32x4 v[2][2];
#pragma unroll
                for (int bj = 0; bj < 2; ++bj)
#pragma unroll
                    for (int n = 0; n < 2; ++n) v[bj][n] = acc[ai][bj][m][n] * rinv;
                if (kind < 2) {
                    float ss = 0.f;
#pragma unroll
                    for (int bj = 0; bj < 2; ++bj)
#pragma unroll
                        for (int n = 0; n < 2; ++n) { const f32x4 x = v[bj][n]; ss += (x[0] * x[0] + x[1] * x[1]) + (x[2] * x[2] + x[3] * x[3]); }
                    ss += __shfl_xor(ss, 16); ss += __shfl_xor(ss, 32);
                    const float hr = __builtin_amdgcn_rsqf(ss * (1.0f / HD) + EPS) * (kind == 0 ? qscale : 1.0f);
#pragma unroll
                    for (int bj = 0; bj < 2; ++bj)
#pragma unroll
                        for (int n = 0; n < 2; ++n) v[bj][n] = v[bj][n] * gv[bj][n] * hr;
                }
                bf16_t* rowp = O + (size_t)row * INW + tcol0 + 8 * fq;
#pragma unroll
                for (int bj = 0; bj < 2; ++bj) { u32x4 w; w.x = cvt_pk_bf16(v[bj][0][0], v[bj][0][1]); w.y = cvt_pk_bf16(v[bj][0][2], v[bj][0][3]); w.z = cvt_pk_bf16(v[bj][1][0], v[bj][1][1]); w.w = cvt_pk_bf16(v[bj][1][2], v[bj][1][3]);
                    if (tcol0 >= UOFF) { const int uc = tcol0 - UOFF + 32 * bj + 8 * fq;
                        *(u32x4*)(UG + ((size_t)(uc >> 4) * T + row) * GD + (uc & 15)) = w; }
                    else *(u32x4*)(rowp + 32 * bj) = w; }
            }
        }
    }
};
struct EpiGlu {
    static constexpr bool PERM = true, MID = false; static constexpr int MID_T = 0;
    const bf16_t* Y; bf16_t* MIX; float* ssq;
    struct State {};
    __device__ __forceinline__ void begin(const Unit&, int, int, State&) const {}
    __device__ __forceinline__ void mid(f32x4 (&)[2][2][4][2], const Unit&, int, int, int, int, int, State&) const {}
    __device__ __forceinline__ void operator()(const f32x4 (&acc)[2][2][4][2], const Unit& u, int ui, int wr, int wc, int fr, int fq, const State& est) const {
        const int row0 = u.pm * BM + wr * 64 + fr, col0 = u.pn * BM + wc * 32 + 8 * fq;
#pragma unroll
        for (int ai = 0; ai < 2; ++ai) {
            u32x4 yall[4][2];
#pragma unroll
            for (int m = 0; m < 4; ++m)
#pragma unroll
                for (int bj = 0; bj < 2; ++bj) yall[m][bj] = *(const u32x4*)(Y + (size_t)(row0 + ai * HALF + m * 16) * SW + col0 + bj * HALF);
#pragma unroll
            for (int m = 0; m < 4; ++m) {
                const int row = row0 + ai * HALF + m * 16; float ss = 0.f;
#pragma unroll
                for (int bj = 0; bj < 2; ++bj) {
                    const u32x4 yw = yall[m][bj];
                    const float y[8] = {bf_lo(yw.x), bf_hi(yw.x), bf_lo(yw.y), bf_hi(yw.y), bf_lo(yw.z), bf_hi(yw.z), bf_lo(yw.w), bf_hi(yw.w)};
                    float s[8];
#pragma unroll
                    for (int n = 0; n < 2; ++n)
#pragma unroll
                        for (int j = 0; j < 4; ++j) { const float g = acc[ai][bj][m][n][j]; const float o = y[4 * n + j] * __builtin_amdgcn_rcpf(1.0f + __builtin_amdgcn_exp2f(-LOG2E * g)); s[4 * n + j] = o; ss += o * o; }
                    u32x4 w; w.x = cvt_pk_bf16(s[0], s[1]); w.y = cvt_pk_bf16(s[2], s[3]); w.z = cvt_pk_bf16(s[4], s[5]); w.w = cvt_pk_bf16(s[6], s[7]);
                    *(u32x4*)(MIX + (size_t)row * D + AW + col0 + bj * HALF) = w;
                }
                ss += __shfl_xor(ss, 16); ss += __shfl_xor(ss, 32);
                if (fq == 0) ssq[(size_t)row * 8 + u.pn * 4 + wc] = ss;
            }
        }
    }
};
template <bool WO, bool RESF32> struct EpiRes {
    static constexpr bool PERM = true, MID = WO; static constexpr int MID_T = 8;
    const float* res; bf16_t* XB; float* ssq_out; const float* ssq_a; const float* ssq_s;
    PG8_LAS float* tab;
    struct State {};
    __device__ __forceinline__ void begin(const Unit& u, int ui, int tid, State&) const {
        if (WO) { if (tid < BM) { const int row = u.pm * BM + tid;
            const float ra = 1.0f / sqrtf(sum8(ssq_a + (size_t)row * 8) * (1.0f / AW) + EPS), rs = 1.0f / sqrtf(sum8(ssq_s + (size_t)row * 8) * (1.0f / SW) + EPS);
            *(PG8_LAS f32x2*)(tab + ((ui & 1) * BM + tid) * 2) = (f32x2){ra / rs, rs}; } }
    }
    __device__ __forceinline__ void mid(f32x4 (&acc)[2][2][4][2], const Unit& u, int ui, int wr, int wc, int fr, int fq, State&) const {
        const int r0 = wr * 64 + fr;
#pragma unroll
        for (int ai = 0; ai < 2; ++ai)
#pragma unroll
            for (int m = 0; m < 4; ++m) {
                const float f = tab[((ui & 1) * BM + r0 + ai * HALF + m * 16) * 2];
#pragma unroll
                for (int bj = 0; bj < 2; ++bj)
#pragma unroll
                    for (int n = 0; n < 2; ++n) acc[ai][bj][m][n] *= f;
            }
    }
    __device__ __forceinline__ void operator()(const f32x4 (&acc)[2][2][4][2], const Unit& u, int ui, int wr, int wc, int fr, int fq, const State& est) const {
        const int r0 = wr * 64 + fr, row0 = u.pm * BM + r0, col0 = u.pn * BM + wc * 32 + 8 * fq;
        constexpr int NB = RESF32 ? 2 : 4;
#pragma unroll
        for (int b0 = 0; b0 < 8; b0 += NB) {
            f32x4 rf[NB][2][2]; u32x4 rb[NB][2];
#pragma unroll
            for (int q = 0; q < NB; ++q) { const int ai = (b0 + q) >> 2, m = (b0 + q) & 3; const size_t off = (size_t)(row0 + ai * HALF + m * 16) * D + col0;
#pragma unroll
                for (int bj = 0; bj < 2; ++bj) { if (RESF32) { rf[q][bj][0] = *(const f32x4*)(res + off + bj * HALF); rf[q][bj][1] = *(const f32x4*)(res + off + bj * HALF + 4); } else rb[q][bj] = *(const u32x4*)(XB + off + bj * HALF); } }
#pragma unroll
            for (int q = 0; q < NB; ++q) { const int ai = (b0 + q) >> 2, m = (b0 + q) & 3, row = row0 + ai * HALF + m * 16; float ss = 0.f;
                float sc = 1.0f; if (WO) sc = tab[((ui & 1) * BM + r0 + ai * HALF + m * 16) * 2 + 1];
#pragma unroll
                for (int bj = 0; bj < 2; ++bj) {
                    f32x4 r0v, r1v;
                    if (RESF32) { r0v = rf[q][bj][0]; r1v = rf[q][bj][1]; }
                    else { const u32x4 w = rb[q][bj]; r0v = (f32x4){bf_lo(w.x), bf_hi(w.x), bf_lo(w.y), bf_hi(w.y)}; r1v = (f32x4){bf_lo(w.z), bf_hi(w.z), bf_lo(w.w), bf_hi(w.w)}; }
                    const f32x4 o0 = r0v + acc[ai][bj][m][0] * sc, o1 = r1v + acc[ai][bj][m][1] * sc;
                    u32x4 w; w.x = cvt_pk_bf16(o0[0], o0[1]); w.y = cvt_pk_bf16(o0[2], o0[3]); w.z = cvt_pk_bf16(o1[0], o1[1]); w.w = cvt_pk_bf16(o1[2], o1[3]);
                    *(u32x4*)(XB + (size_t)row * D + col0 + bj * HALF) = w;
                    ss += ((o0[0] * o0[0] + o0[1] * o0[1]) + (o0[2] * o0[2] + o0[3] * o0[3])) + ((o1[0] * o1[0] + o1[1] * o1[1]) + (o1[2] * o1[2] + o1[3] * o1[3]));
                }
                ss += __shfl_xor(ss, 16); ss += __shfl_xor(ss, 32);
                if (fq == 0) ssq_out[(size_t)row * 16 + u.pn * 4 + wc] = ss;
            }
        }
    }
};
template <bool MOE> struct EpiSwiglu {
    static constexpr bool PERM = true, MID = false; static constexpr int MID_T = 0;
    bf16_t* H; const float* rs;
    PG8_LAS float* tab;
    struct State { float r[MOE ? 8 : 1]; };
    __device__ __forceinline__ void begin(const Unit& u, int ui, int tid, State& st) const {
        if (MOE) { const int wid = tid >> 6, lane = tid & 63, row0 = u.pm * BM + (wid >> 2) * 64 + (lane & 15);
#pragma unroll
            for (int ai = 0; ai < 2; ++ai)
#pragma unroll
                for (int m = 0; m < 4; ++m) st.r[ai * 4 + m] = rs[row0 + ai * HALF + m * 16]; }
    }
    __device__ __forceinline__ void mid(f32x4 (&)[2][2][4][2], const Unit&, int, int, int, int, int, State&) const {}
    __device__ __forceinline__ void operator()(const f32x4 (&acc)[2][2][4][2], const Unit& u, int ui, int wr, int wc, int fr, int fq, const State& est) const {
        const int r0 = wr * 64 + fr, row0 = u.pm * BM + r0, hcol = u.pn * HALF + wc * 32 + 8 * fq;
#pragma unroll
        for (int ai = 0; ai < 2; ++ai)
#pragma unroll
            for (int m = 0; m < 4; ++m) {
                const int row = row0 + ai * HALF + m * 16;
                const float rinv = MOE ? est.r[MOE ? ai * 4 + m : 0] : tab[ui * BM + r0 + ai * HALF + m * 16];
                float h[8];
#pragma unroll
                for (int n = 0; n < 2; ++n)
#pragma unroll
                    for (int j = 0; j < 4; ++j) { const float g = acc[ai][0][m][n][j] * rinv, uu = acc[ai][1][m][n][j] * rinv; h[4 * n + j] = g * __builtin_amdgcn_rcpf(1.0f + __builtin_amdgcn_exp2f(-LOG2E * g)) * uu; }
                u32x4 w; w.x = cvt_pk_bf16(h[0], h[1]); w.y = cvt_pk_bf16(h[2], h[3]); w.z = cvt_pk_bf16(h[4], h[5]); w.w = cvt_pk_bf16(h[6], h[7]);
                *(u32x4*)(H + (size_t)row * FF + hcol) = w;
            }
    }
};
template <class Sched> __device__ __forceinline__ void fill_rinv_tab(const Sched& S, const float* ssq, PG8_LAS float* tab, int tid, int maxu) {
    if (tid < BM) { Unit u;
        for (int i = 0; i < maxu && S.next(i, u); ++i) tab[i * BM + tid] = __builtin_amdgcn_rsqf(sum16(ssq + (size_t)(u.pm * BM + tid) * 16) * (1.0f / D) + EPS); }
    asm volatile("s_waitcnt lgkmcnt(0)\n\ts_barrier" ::: "memory");
}
struct EpiMoeDown {
    static constexpr bool PERM = true, MID = false; static constexpr int MID_T = 0;
    bf16_t* Ys; bf16_t* Ys2; int ysplit; const float* gate; float* slab; unsigned* tailmap; int S;
    struct State {};
    __device__ __forceinline__ void begin(const Unit&, int, int, State&) const {}
    __device__ __forceinline__ void mid(f32x4 (&)[2][2][4][2], const Unit&, int, int, int, int, int, State&) const {}
    __device__ __forceinline__ void operator()(const f32x4 (&acc)[2][2][4][2], const Unit& u, int ui, int wr, int wc, int fr, int fq, const State& est) const {
        if (u.sl >= 0) {
            float* sb = slab + (size_t)u.sl * (BM * BM) + (size_t)(wr * 64 + fr) * BM + wc * 32 + 8 * fq;
#pragma unroll
            for (int ai = 0; ai < 2; ++ai)
#pragma unroll
                for (int m = 0; m < 4; ++m)
#pragma unroll
                    for (int bj = 0; bj < 2; ++bj) { float* q = sb + (size_t)(ai * HALF + m * 16) * BM + bj * HALF; *(f32x4*)q = acc[ai][bj][m][0]; *(f32x4*)(q + 4) = acc[ai][bj][m][1]; }
            if (u.sl % S == 0 && wr == 0 && wc == 0 && fr == 0 && fq == 0) tailmap[u.pm * 4 + u.pn] = 1u + (unsigned)(u.sl / S);
            return;
        }
        const int row0 = u.pm * BM + wr * 64 + fr, col0 = u.pn * BM + wc * 32 + 8 * fq;
        bf16_t* ysb = u.pm * BM < ysplit ? Ys + (size_t)u.pm * BM * D : Ys2 + (size_t)(u.pm * BM - ysplit) * D;
        float g8[2][4];
#pragma unroll
        for (int ai = 0; ai < 2; ++ai)
#pragma unroll
            for (int m = 0; m < 4; ++m) g8[ai][m] = gate[row0 + ai * HALF + m * 16];
#pragma unroll
        for (int ai = 0; ai < 2; ++ai)
#pragma unroll
            for (int m = 0; m < 4; ++m) {
                const int row = row0 + ai * HALF + m * 16; const float g = g8[ai][m];
#pragma unroll
                for (int bj = 0; bj < 2; ++bj) { const f32x4 v0 = acc[ai][bj][m][0] * g, v1 = acc[ai][bj][m][1] * g;
                    u32x4 w; w.x = cvt_pk_bf16(v0[0], v0[1]); w.y = cvt_pk_bf16(v0[2], v0[3]); w.z = cvt_pk_bf16(v1[0], v1[1]); w.w = cvt_pk_bf16(v1[2], v1[3]);
                    *(u32x4*)(ysb + (size_t)(row - u.pm * BM) * D + col0 + bj * HALF) = w; }
            }
    }
};

template <class Epi, class Sched, bool GATHER, int K, bool ALIGN_EPI = true, bool SP2 = true>
__device__ __forceinline__ void gemm_phase(PG8_LAS unsigned char* lds, const Gemm g, const Sched& S, const Epi& E) {
    int tid_ = threadIdx.x; asm volatile("" : "+v"(tid_));
    const int tid = tid_, wid = __builtin_amdgcn_readfirstlane(tid >> 6), lane = tid & 63, wr = wid >> 2, wc = wid & 3, fr = lane & 15, fq = lane >> 4;
    constexpr int nt = K / BK;
    unsigned voffA[2], voffB[2]; int RA[2], CA[2];
#pragma unroll
    for (int i = 0; i < 2; ++i) { int R, C; stage_rc(tid * 16 + i * 8192, R, C); const int Rb = Epi::PERM ? ((R & ~31) + perm32(R & 31)) : R;
        RA[i] = R; CA[i] = C; voffA[i] = (unsigned)(R * K + C) * 2u; voffB[i] = (unsigned)(Rb * K + C) * 2u; }
    constexpr size_t kstep = (size_t)(BK * 2);
    constexpr size_t hstep = (size_t)HALF * K * 2;
    constexpr size_t tstep = 2 * hstep;
    const unsigned ldsw = (unsigned)wid * 1024u;
    const int aoff = lds_byte(wr * 64 + fr, fq * 8), boff = lds_byte(wc * 32 + fr, fq * 8);
#define PG8_SA(b, h) (((b) * 2 + (h)) * HTB)
#define PG8_SB(b, h) ((4 + (b) * 2 + (h)) * HTB)
    const char* const rsA = (const char*)g.A; const char* const rsB = (const char*)g.Bt;
#define PG8_STAGE_R(bufoff, rs, soff, voff) do { _Pragma("unroll") for (int _i = 0; _i < 2; ++_i) \
        __builtin_amdgcn_global_load_lds((const unsigned*)((rs) + (size_t)(unsigned)((voff)[_i] + (unsigned)(soff))), (PG8_LAS unsigned*)(lds + (bufoff) + ldsw + _i * 8192), 16, 0, 0); } while (0)
#define PG8_STAGE(bufoff, soff, voff) PG8_STAGE_R(bufoff, rsB, soff, voff)
#define PG8_STAGE_A(bufoff, soff, h, VG) do { if constexpr (GATHER) { PG8_STAGE_R(bufoff, rsA, soff, VG[h]); } else { PG8_STAGE_R(bufoff, rsA, (soff) + (unsigned)((h) * hstep), voffA); } } while (0)
#define PG8_LDA(dst, b, h) do { _Pragma("unroll") for (int m = 0; m < 4; ++m) _Pragma("unroll") for (int k = 0; k < 2; ++k) dst[m][k] = *(const PG8_LAS bf16x8*)(lds + PG8_SA(b, h) + aoff + m * 2048 + k * 1024); } while (0)
#define PG8_LDB(dst, b, h) do { _Pragma("unroll") for (int n = 0; n < 2; ++n) _Pragma("unroll") for (int k = 0; k < 2; ++k) dst[n][k] = *(const PG8_LAS bf16x8*)(lds + PG8_SB(b, h) + boff + n * 2048 + k * 1024); } while (0)
#define PG8_MMA(ai, bj, At, Bt) do { __builtin_amdgcn_s_setprio(1); _Pragma("unroll") for (int m = 0; m < 4; ++m) _Pragma("unroll") for (int n = 0; n < 2; ++n) _Pragma("unroll") for (int k = 0; k < 2; ++k) \
        acc[ai][bj][m][n] = __builtin_amdgcn_mfma_f32_16x16x32_bf16(Bt[n][k], At[m][k], acc[ai][bj][m][n], 0, 0, 0); __builtin_amdgcn_s_setprio(0); } while (0)
#define PG8_WAIT_V(n) asm volatile("s_waitcnt vmcnt(" #n ")" ::: "memory")
#define PG8_WAIT_L(n) asm volatile("s_waitcnt lgkmcnt(" #n ")" ::: "memory")
#define PG8_BAR __builtin_amdgcn_s_barrier()
#define PG8_SCHED __builtin_amdgcn_sched_barrier(0)
#define PG8_GOFF(dst, U) do { _Pragma("unroll") for (int _h = 0; _h < 2; ++_h) _Pragma("unroll") for (int _i = 0; _i < 2; ++_i) \
        dst[_h][_i] = ((unsigned)g.idx[(U).pm * BM + _h * HALF + RA[_i]] * (unsigned)K + (unsigned)CA[_i]) * 2u; } while (0)
    Unit cur, nxt; int ui = 0;
    if (!S.next(0, cur)) return;
    if constexpr (!Sched::KSPLIT) { cur.k0 = 0; cur.nk = nt; cur.sl = -1; }
    f32x4 acc[2][2][4][2];
#pragma unroll
    for (int a = 0; a < 2; ++a)
#pragma unroll
        for (int b = 0; b < 2; ++b)
#pragma unroll
            for (int m = 0; m < 4; ++m)
#pragma unroll
                for (int n = 0; n < 2; ++n) acc[a][b][m][n] = (f32x4){0.f, 0.f, 0.f, 0.f};
    bf16x8 At[4][2], B0[2][2], B1[2][2];
    unsigned vgc[2][2] = {{0u, 0u}, {0u, 0u}}, vgn[2][2] = {{0u, 0u}, {0u, 0u}};
    unsigned cA = (GATHER ? 0u : (unsigned)cur.pm * (unsigned)tstep) + (unsigned)cur.k0 * (unsigned)kstep, cB = (unsigned)cur.pb * (unsigned)tstep + (unsigned)cur.k0 * (unsigned)kstep;
    if constexpr (GATHER) PG8_GOFF(vgc, cur);
    typename Epi::State est;
    E.begin(cur, 0, tid, est);
    if constexpr (SP2) {
        PG8_STAGE(PG8_SB(0, 0), cB, voffB); PG8_STAGE(PG8_SB(0, 1), cB + hstep, voffB); PG8_STAGE_A(PG8_SA(0, 0), cA, 0, vgc); PG8_STAGE_A(PG8_SA(0, 1), cA, 1, vgc);
        if (wr == 1) PG8_BAR;
        PG8_WAIT_V(2); PG8_BAR;
        PG8_STAGE(PG8_SB(1, 0), cB + kstep, voffB); PG8_STAGE_A(PG8_SA(1, 0), cA + kstep, 0, vgc); PG8_STAGE(PG8_SB(1, 1), cB + hstep + kstep, voffB);
        PG8_WAIT_V(6); PG8_BAR;
    } else {
        PG8_STAGE(PG8_SB(0, 0), cB, voffB); PG8_STAGE_A(PG8_SA(0, 0), cA, 0, vgc); PG8_STAGE(PG8_SB(0, 1), cB + hstep, voffB); PG8_STAGE_A(PG8_SA(0, 1), cA, 1, vgc);
        if (wr == 1) PG8_BAR;
        PG8_WAIT_V(4); PG8_BAR;
        PG8_STAGE(PG8_SB(1, 0), cB + kstep, voffB); PG8_STAGE_A(PG8_SA(1, 0), cA + kstep, 0, vgc); PG8_STAGE(PG8_SB(1, 1), cB + hstep + kstep, voffB);
        PG8_WAIT_V(6); PG8_BAR;
    }
    for (;;) {
        const bool has_next = S.next(ui + 1, nxt);
        if constexpr (!Sched::KSPLIT) { nxt.k0 = 0; nxt.nk = nt; nxt.sl = -1; }
        const unsigned nA = has_next ? (GATHER ? 0u : (unsigned)nxt.pm * (unsigned)tstep) + (unsigned)nxt.k0 * (unsigned)kstep : cA, nB = has_next ? (unsigned)nxt.pb * (unsigned)tstep + (unsigned)nxt.k0 * (unsigned)kstep : cB;
        if constexpr (GATHER) { if (has_next) PG8_GOFF(vgn, nxt); else {
#pragma unroll
            for (int h = 0; h < 2; ++h)
#pragma unroll
                for (int i = 0; i < 2; ++i) vgn[h][i] = vgc[h][i]; } }
        const int nk = cur.nk;
        for (int t = 0; t < nk; t += 2) {
            const bool last = (t == nk - 2);
            if constexpr (Epi::MID) { if (t == Epi::MID_T) E.mid(acc, cur, ui, wr, wc, fr, fq, est); }
            const unsigned a1 = cA + (unsigned)(t + 1) * (unsigned)kstep;
            const unsigned a2 = last ? nA : cA + (unsigned)(t + 2) * (unsigned)kstep, b2 = last ? nB : cB + (unsigned)(t + 2) * (unsigned)kstep;
            const unsigned a3 = a2 + (unsigned)kstep, b3 = b2 + (unsigned)kstep;
            unsigned vgs[2][2];
#pragma unroll
            for (int h = 0; h < 2; ++h)
#pragma unroll
                for (int i = 0; i < 2; ++i) vgs[h][i] = last ? vgn[h][i] : vgc[h][i];
            if constexpr (SP2) {
            PG8_LDB(B0, 0, 0); PG8_LDB(B1, 0, 1); PG8_SCHED; PG8_LDA(At, 0, 0); PG8_STAGE_A(PG8_SA(1, 1), a1, 1, vgc);
            PG8_WAIT_V(8); PG8_WAIT_L(0); PG8_BAR; PG8_MMA(0, 0, At, B0); PG8_MMA(0, 1, At, B1); PG8_BAR; PG8_SCHED;
            PG8_LDA(At, 0, 1); PG8_STAGE(PG8_SB(0, 0), b2, voffB); PG8_STAGE(PG8_SB(0, 1), b2 + hstep, voffB); PG8_STAGE_A(PG8_SA(0, 0), a2, 0, vgs);
            PG8_WAIT_V(8); PG8_WAIT_L(0); PG8_BAR; PG8_MMA(1, 0, At, B0); PG8_MMA(1, 1, At, B1); PG8_BAR; PG8_SCHED;
            PG8_LDB(B0, 1, 0); PG8_LDB(B1, 1, 1); PG8_SCHED; PG8_LDA(At, 1, 0); PG8_STAGE_A(PG8_SA(0, 1), a2, 1, vgs);
            PG8_WAIT_V(8); PG8_WAIT_L(0); PG8_BAR; PG8_MMA(0, 0, At, B0); PG8_MMA(0, 1, At, B1); PG8_BAR; PG8_SCHED;
            PG8_LDA(At, 1, 1); PG8_STAGE(PG8_SB(1, 0), b3, voffB); PG8_STAGE(PG8_SB(1, 1), b3 + hstep, voffB); PG8_STAGE_A(PG8_SA(1, 0), a3, 0, vgs);
            PG8_WAIT_V(8); PG8_WAIT_L(0); PG8_BAR; PG8_MMA(1, 0, At, B0); PG8_MMA(1, 1, At, B1); PG8_BAR; PG8_SCHED;
            } else {
            PG8_LDB(B0, 0, 0); PG8_SCHED; PG8_LDA(At, 0, 0); PG8_STAGE_A(PG8_SA(1, 1), a1, 1, vgc);
            PG8_WAIT_L(8); PG8_BAR; PG8_WAIT_L(0); PG8_MMA(0, 0, At, B0); PG8_BAR; PG8_SCHED;
            PG8_LDB(B1, 0, 1); PG8_STAGE(PG8_SB(0, 0), b2, voffB);
            PG8_BAR; PG8_WAIT_L(0); PG8_MMA(0, 1, At, B1); PG8_BAR;
            PG8_LDA(At, 0, 1); PG8_STAGE_A(PG8_SA(0, 0), a2, 0, vgs);
            PG8_BAR; PG8_WAIT_L(0); PG8_MMA(1, 0, At, B0); PG8_BAR; PG8_SCHED;
            PG8_STAGE(PG8_SB(0, 1), b2 + hstep, voffB);
            PG8_WAIT_V(6); PG8_BAR; PG8_MMA(1, 1, At, B1); PG8_BAR;
            PG8_LDB(B0, 1, 0); PG8_SCHED; PG8_LDA(At, 1, 0); PG8_STAGE_A(PG8_SA(0, 1), a2, 1, vgs);
            PG8_WAIT_L(8); PG8_BAR; PG8_WAIT_L(0); PG8_MMA(0, 0, At, B0); PG8_BAR; PG8_SCHED;
            PG8_LDB(B1, 1, 1); PG8_STAGE(PG8_SB(1, 0), b3, voffB);
            PG8_BAR; PG8_WAIT_L(0); PG8_MMA(0, 1, At, B1); PG8_BAR;
            PG8_LDA(At, 1, 1); PG8_STAGE_A(PG8_SA(1, 0), a3, 0, vgs);
            PG8_BAR; PG8_WAIT_L(0); PG8_MMA(1, 0, At, B0); PG8_BAR; PG8_SCHED;
            PG8_STAGE(PG8_SB(1, 1), b3 + hstep, voffB);
            PG8_WAIT_V(6); PG8_BAR; PG8_MMA(1, 1, At, B1); PG8_BAR;
            }
        }
        if constexpr (ALIGN_EPI) { if (wr == 0) PG8_BAR; }
        E(acc, cur, ui, wr, wc, fr, fq, est);
        if (!has_next) break;
#pragma unroll
        for (int a = 0; a < 2; ++a)
#pragma unroll
            for (int b = 0; b < 2; ++b)
#pragma unroll
                for (int m = 0; m < 4; ++m)
#pragma unroll
                    for (int n = 0; n < 2; ++n) acc[a][b][m][n] = (f32x4){0.f, 0.f, 0.f, 0.f};
        cur = nxt; cA = nA; cB = nB; ++ui;
        E.begin(cur, ui, tid, est);
#pragma unroll
        for (int h = 0; h < 2; ++h)
#pragma unroll
            for (int i = 0; i < 2; ++i) vgc[h][i] = vgn[h][i];
        if constexpr (ALIGN_EPI) { if (wr == 1) PG8_BAR; }
    }
    PG8_WAIT_V(0);
    if constexpr (!ALIGN_EPI) { if (wr == 0) PG8_BAR; }
    PG8_BAR;
#undef PG8_SA
#undef PG8_SB
#undef PG8_STAGE
#undef PG8_STAGE_A
#undef PG8_LDA
#undef PG8_LDB
#undef PG8_MMA
#undef PG8_WAIT_V
#undef PG8_WAIT_L
#undef PG8_BAR
#undef PG8_SCHED
#undef PG8_GOFF
}
}

constexpr size_t MiB = 1u << 20;
constexpr size_t WS_CTL = 0, CTL_ZERO_BYTES = 128 * 1024;
constexpr size_t WS_SSQ_A = 1 * MiB, WS_SSQ_F = 2 * MiB, WS_SSQ_ATT = 3 * MiB, WS_SSQ_SSM = 3 * MiB + 512 * 1024;
constexpr size_t WS_ROUTE = 4 * MiB;
constexpr size_t RT_IDX = 0, RT_GATE = 160 * 1024, RT_RINVS = 320 * 1024, RT_POS = 480 * 1024, RT_TOPE = 608 * 1024, RT_TOPG = 736 * 1024, RT_RINVT = 864 * 1024, RT_HIST = 928 * 1024, RT_PEND = 944 * 1024;
constexpr size_t WS_SSMPRE = 6 * MiB, SSMPRE_STRIDE = 9 * MiB;
constexpr size_t WS_WSMALL = 24 * MiB, WSMALL_STRIDE = 5 * MiB, WS_WIN = 0, WS_WGLU = 5 * MiB / 2, WS_WO = 3 * MiB;
constexpr size_t WS_DGU = 34 * MiB, WS_DD = 48 * MiB;
constexpr size_t WS_MOEW = 56 * MiB, WS_XB = 168 * MiB, WS_YS = 56 * MiB, WS_YS2 = WS_YS + (size_t)28672 * 1024 * 2;
constexpr int YS_SPLIT = 28672;
constexpr size_t WS_RA = 200 * MiB, WS_QKVU = WS_RA, WS_MIX = 240 * MiB, WS_YG = 272 * MiB, WS_HD = 288 * MiB, WS_HS = WS_RA;
constexpr size_t WS_UG = WS_HD;
constexpr size_t WS_END = 446 * MiB;
static_assert(WS_YS2 + (size_t)(CAP - YS_SPLIT) * D * 2 <= 124 * MiB && WS_HS + (size_t)CAP * FF * 2 <= WS_END && WS_HD + (size_t)T * FF * 2 <= WS_END, "ws map");
constexpr int CW_BAR = 4096, CW_TAILMAP = 16384;
constexpr size_t WS_SLAB = 124 * MiB;
static_assert(WS_SLAB + (size_t)pg8::KS_MAXSLAB * 256 * 256 * 4 <= 168 * MiB, "slabs");
constexpr size_t WS_WDT = 6 * MiB, WDT_TILEB = (size_t)256 * FF * 2;
constexpr int WDT_E7 = 247;
static_assert(WS_WDT + 7 * 4 * WDT_TILEB <= 55 * MiB && WS_WDT + WDT_E7 * WDT_TILEB >= 438 * MiB, "MoE down weight copies");

constexpr int RING_OFF = 0, RING_BYTES = 131072;
constexpr int LDSCTL_OFF = RING_BYTES, MISC_OFF = LDSCTL_OFF + 320;
constexpr int TAB_OFF = MISC_OFF + 192;
constexpr int LDS_BYTES = 147456;
constexpr int TAB2_OFF = TAB_OFF + 4096, TAB2_UNITS = 11;
static_assert(TAB_OFF % 16 == 0 && TAB2_OFF + TAB2_UNITS * 1024 <= LDS_BYTES, "LDS map");
constexpr int NWAVES = 8;

#define GAS __attribute__((address_space(1)))
#define LAS __attribute__((address_space(3)))
typedef unsigned short bf16;
typedef unsigned v4u __attribute__((ext_vector_type(4)));
typedef float f32x4 __attribute__((ext_vector_type(4)));
typedef GAS unsigned gu32;
#define RLX_AGENT __ATOMIC_RELAXED, __HIP_MEMORY_SCOPE_AGENT
#define LDS_WAIT() asm volatile("s_waitcnt lgkmcnt(0)" ::: "memory")
#define VM_WAIT() asm volatile("s_waitcnt vmcnt(0)" ::: "memory")
__device__ __forceinline__ unsigned f2bf(float f) { unsigned u = __builtin_bit_cast(unsigned, f); return (u + 0x7fffu + ((u >> 16) & 1u)) >> 16; }
__device__ __forceinline__ unsigned pk2(float lo, float hi) { return f2bf(lo) | (f2bf(hi) << 16); }
__device__ __forceinline__ float bf2f(bf16 v) { return __uint_as_float((unsigned)v << 16); }

#define XB_TMO      128
#define XB_XCNT(j)  (256  + 64 * (j))
#define XB_XSUB(j)  (1280 + 64 * (j))
#define XB_XGEN(j)  (2304 + 64 * (j))
#define XB_TOP      3328
#define XB_TOPGEN   3392
#define XCD_BAR_WORDS 3456
#define XB_SPIN_CAP (1u << 22)
__device__ __forceinline__ unsigned xb_ld(unsigned* p)              { return __hip_atomic_load(p, __ATOMIC_RELAXED, __HIP_MEMORY_SCOPE_AGENT); }
__device__ __forceinline__ unsigned xb_add(unsigned* p, unsigned v) { return __hip_atomic_fetch_add(p, v, __ATOMIC_RELAXED, __HIP_MEMORY_SCOPE_AGENT); }
__device__ __forceinline__ unsigned xb_xcc_id() { return (unsigned)__builtin_amdgcn_s_getreg((3 << 11) | 20) & 0xFu; }
#define XB_SPIN(cond, bar) do { unsigned _sp = 0; while (cond) { __builtin_amdgcn_s_sleep(1); \
    if ((++_sp & 255u) == 0u) { if (xb_ld(&(bar)[XB_TMO])) break; if (_sp > XB_SPIN_CAP) { atomicAdd(&(bar)[XB_TMO], 1u); break; } } } } while (0)
struct XcdBarrier { unsigned* bar; unsigned x; volatile LAS unsigned* st; };
__device__ __forceinline__ XcdBarrier xcd_barrier_post(unsigned* bar, volatile LAS unsigned* st) {
    XcdBarrier b; b.bar = bar; b.x = xb_xcc_id(); b.st = st;
    if (threadIdx.x == 0) (void)xb_add(&bar[XB_XCNT(b.x)], 1u);
    return b;
}
__device__ __forceinline__ void xcd_barrier_complete(unsigned* bar, unsigned x, unsigned& nloc, unsigned& nx) {
    const unsigned G = gridDim.x * gridDim.y * gridDim.z;
    unsigned sum, cnt, mine, sp = 0u;
    for (;;) {
        sum = 0u; cnt = 0u; mine = 0u;
#pragma unroll
        for (unsigned j = 0; j < 16; ++j) { const unsigned c = xb_ld(&bar[XB_XCNT(j)]); sum += c; cnt += (c > 0u) ? 1u : 0u; mine = (j == x) ? c : mine; }
        if (sum == G) break;
        __builtin_amdgcn_s_sleep(1);
        if ((++sp & 255u) == 0u) { if (xb_ld(&bar[XB_TMO])) break; if (sp > XB_SPIN_CAP) { atomicAdd(&bar[XB_TMO], 1u); break; } }
    }
    nloc = mine > 0u ? mine : 1u; nx = cnt > 0u ? cnt : 1u;
}
__device__ __forceinline__ void xcd_barrier(const XcdBarrier& b) {
    asm volatile("s_waitcnt vmcnt(0)" ::: "memory");
    __syncthreads();
    if (threadIdx.x == 0) {
        unsigned* bar = b.bar;
        __builtin_amdgcn_s_waitcnt(0);
        unsigned nloc = b.st[0], nx = b.st[1];
        if (nloc == 0u) { xcd_barrier_complete(bar, b.x, nloc, nx); b.st[0] = nloc; b.st[1] = nx; }
        const unsigned old = xb_add(&bar[XB_XSUB(b.x)], 1u);
        const unsigned gen = old / nloc;
        if (old + 1u == (gen + 1u) * nloc) {
            __builtin_amdgcn_fence(__ATOMIC_RELEASE, "agent");
            asm volatile("s_waitcnt vmcnt(0)" ::: "memory");
            const unsigned og = xb_add(&bar[XB_TOP], 1u);
            const unsigned tg = og / nx;
            if (og + 1u == (tg + 1u) * nx) xb_add(&bar[XB_TOPGEN], 1u);
            else XB_SPIN(xb_ld(&bar[XB_TOPGEN]) == tg, bar);
            __builtin_amdgcn_fence(__ATOMIC_ACQUIRE, "agent");
            xb_add(&bar[XB_XGEN(b.x)], 1u);
            asm volatile("s_waitcnt vmcnt(0)" ::: "memory");
        } else {
            XB_SPIN(xb_ld(&bar[XB_XGEN(b.x)]) == gen, bar);
            __builtin_amdgcn_fence(__ATOMIC_ACQUIRE, "agent");
            asm volatile("s_waitcnt vmcnt(0)" ::: "memory");
        }
    }
    __syncthreads();
}

struct Args { const float* in[26]; float* out; unsigned char* ws; int ph_lo, ph_hi; };
typedef __attribute__((address_space(4))) const Args* KA;
struct Frame {
    LAS unsigned char* lds; volatile LAS unsigned* MISC; gu32* ctl;
    int tid, lane, wave, vcu, G, bx;
    unsigned char* ws; float* out;
};
__device__ __forceinline__ float wave_sum(float v) {
#pragma unroll
    for (int o = 1; o < 64; o <<= 1) v += __shfl_xor(v, o);
    return v;
}
__device__ __forceinline__ float wave_max(float v) {
#pragma unroll
    for (int o = 1; o < 64; o <<= 1) v = fmaxf(v, __shfl_xor(v, o));
    return v;
}

constexpr int CKB = 64;
constexpr int CONV_LDS = 64 * 144;
__device__ __forceinline__ void conv_item(const float* srcl, int ldn, int k0, const float* ks, bf16* dst0  , int K, LAS unsigned char* scr, int lane) {
    float v[CKB];
    { const float* q = srcl + (size_t)k0 * ldn;
#pragma unroll
      for (int i = 0; i < CKB; ++i) { if ((i & 7) == 0) asm volatile("" : "+v"(q)); v[i] = __builtin_nontemporal_load(q + (size_t)(i & 7) * ldn); if ((i & 7) == 7) q += (size_t)8 * ldn; } }
    if (ks) {
#pragma unroll
        for (int i = 0; i < CKB; ++i) v[i] *= ks[k0 + i]; }
#pragma unroll
    for (int j = 0; j < CKB / 8; ++j) { v4u o; o.x = pg8::cvt_pk_bf16(v[8 * j], v[8 * j + 1]); o.y = pg8::cvt_pk_bf16(v[8 * j + 2], v[8 * j + 3]); o.z = pg8::cvt_pk_bf16(v[8 * j + 4], v[8 * j + 5]); o.w = pg8::cvt_pk_bf16(v[8 * j + 6], v[8 * j + 7]);
        *(LAS v4u*)(scr + lane * 144 + j * 16) = o; }
    asm volatile("s_waitcnt lgkmcnt(0)" ::: "memory");
#pragma unroll
    for (int i = 0; i < 8; ++i) { const int row = 8 * i + (lane >> 3), ch = lane & 7; const v4u o = *(const LAS v4u*)(scr + row * 144 + ch * 16);
        *(GAS v4u*)(dst0 + (size_t)row * K + ch * 8) = o; }
    asm volatile("s_waitcnt lgkmcnt(0)" ::: "memory");
}
__device__ __forceinline__ void conv_plain(const float* W, int K, int N, const float* ks_lo, const float* ks_hi, bf16* WT, int item, int lane, LAS unsigned char* scr) {
    const int nblk = N / 64, kb = item / nblk, nb = item % nblk, k0 = CKB * kb;
    const float* ks = ks_lo ? (k0 < 512 || !ks_hi ? ks_lo : ks_hi - 512) : nullptr;
    conv_item(W + 64 * nb + lane, N, k0, ks, WT + (size_t)(64 * nb) * K + k0, K, scr, lane);
}
__device__ __forceinline__ void conv_inproj(const float* W, const float* ks, bf16* WT, int item, int lane, LAS unsigned char* scr) {
    const int nblk = INW / 64, kb = item / nblk, db = item % nblk, drow = 64 * db + lane, pn = drow >> 8, bj = (drow >> 7) & 1, wc = (drow >> 5) & 3, i = drow & 31;
    conv_item(W + 256 * pn + 64 * wc + 32 * bj + i, INW, CKB * kb, ks, WT + (size_t)(64 * db) * D + CKB * kb, D, scr, lane);
}
__device__ __forceinline__ void conv_gu(const float* Wg, const float* Wu, const float* ks, bf16* WT, int item, int lane, LAS unsigned char* scr) {
    const int nblk = 2 * FF / 64, kb = item / nblk, db = item % nblk, drow = 64 * db + lane, pn = drow >> 8, bj = (drow >> 7) & 1, r = drow & 127;
    conv_item((bj ? Wu : Wg) + 128 * pn + r, FF, CKB * kb, ks, WT + (size_t)(64 * db) * D + CKB * kb, D, scr, lane);
}

constexpr int IT_IN = (D / CKB) * (INW / 64), IT_GLU = (SW / CKB) * (SW / 64), IT_WO = (D / CKB) * (D / 64), IT_L = IT_IN + IT_GLU + IT_WO;
constexpr int IT_GU = (D / CKB) * (2 * FF / 64), IT_DN = (FF / CKB) * (D / 64);
constexpr int IT_P0 = 2 * IT_L;
constexpr int IT_BG = IT_GU + IT_DN + NE * IT_GU;
#ifndef BGQ
#define BGQ 2000, 0, 2900, 3000, 0, 2900
#endif
constexpr int BG_Q[6] = {BGQ};
constexpr int BG_B1 = BG_Q[0], BG_B2 = BG_B1 + BG_Q[1], BG_B3 = BG_B2 + BG_Q[2], BG_B4 = BG_B3 + BG_Q[3], BG_B5 = BG_B4 + BG_Q[4], BG_B6 = BG_B5 + BG_Q[5];
static_assert(BG_B3 >= IT_GU + IT_DN && BG_B6 <= IT_BG, "dense FFN weights are needed right after slot 3");

__device__ __forceinline__ void p0_convert(Frame& F, KA a, int rank, int nranks, int lo, int hi) {
    LAS unsigned char* scr = F.lds + RING_OFF + F.wave * CONV_LDS;
    const int gw = rank * NWAVES + F.wave, NGW = nranks * NWAVES;
    for (int it = lo + gw; it < hi; it += NGW) {
        const int l = it / IT_L; int r = it - l * IT_L; unsigned char* wb = F.ws + WS_WSMALL + l * WSMALL_STRIDE;
        if (r < IT_IN) { conv_inproj(a->in[2] + (size_t)l * D * INW, a->in[1] + l * D, (bf16*)(wb + WS_WIN), r, F.lane, scr); continue; } r -= IT_IN;
        if (r < IT_GLU) { conv_plain(a->in[14] + (size_t)l * SW * SW, SW, SW, nullptr, nullptr, (bf16*)(wb + WS_WGLU), r, F.lane, scr); continue; } r -= IT_GLU;
        conv_plain(a->in[17] + (size_t)l * D * D, D, D, a->in[15] + l * AW, a->in[16] + l * SW, (bf16*)(wb + WS_WO), r, F.lane, scr);
    }
}
__device__ __forceinline__ void bg_convert(Frame& F, KA a, int lo, int hi, int rank, int nranks) {
    if (rank < 0) return;
    LAS unsigned char* scr = F.lds + RING_OFF + F.wave * CONV_LDS;
    for (int it = lo + rank * NWAVES + F.wave; it < hi; it += nranks * NWAVES) {
        int r = it;
        if (r < IT_GU) { conv_gu(a->in[19], a->in[20], a->in[18], (bf16*)(F.ws + WS_DGU), r, F.lane, scr); continue; } r -= IT_GU;
        if (r < IT_DN) { conv_plain(a->in[21], FF, D, nullptr, nullptr, (bf16*)(F.ws + WS_DD), r, F.lane, scr); continue; } r -= IT_DN;
        { const int e = r / IT_GU; r -= e * IT_GU;
          conv_gu(a->in[23] + (size_t)e * D * FF, a->in[24] + (size_t)e * D * FF, a->in[18] + D, (bf16*)(F.ws + WS_MOEW) + (size_t)e * 2 * FF * D, r, F.lane, scr); }
    }
}
__device__ __forceinline__ void moe_wd_convert(Frame& F, KA a) {
    LAS unsigned char* scr = F.lds + RING_OFF + F.wave * CONV_LDS;
    const int gw = F.vcu * NWAVES + F.wave, NGW = F.G * NWAVES;
    for (int it = gw; it < NE * IT_DN; it += NGW) { const int e = it / IT_DN, r = it % IT_DN;
        conv_plain(a->in[25] + (size_t)e * FF * D, FF, D, nullptr, nullptr, (bf16*)(F.ws + WS_WDT + (size_t)(e < 7 ? 4 * e : WDT_E7) * WDT_TILEB), r, F.lane, scr); }
}
__device__ __forceinline__ void conv_load2(const float* srcl, int ldn, int k0, float (&v)[CKB]) {
    const float* q = srcl + (size_t)k0 * ldn;
#pragma unroll
    for (int i = 0; i < CKB; ++i) { if ((i & 7) == 0) asm volatile("" : "+v"(q)); v[i] = __builtin_nontemporal_load(q + (size_t)(i & 7) * ldn); if ((i & 7) == 7) q += (size_t)8 * ldn; }
}
__device__ __forceinline__ void conv_store2(float (&v)[CKB], const float* ks, int k0, bf16* dst0, int K, LAS unsigned char* scr, int lane) {
    if (ks) {
#pragma unroll
        for (int i = 0; i < CKB; ++i) v[i] *= ks[k0 + i]; }
#pragma unroll
    for (int j = 0; j < CKB / 8; ++j) { v4u o; o.x = pg8::cvt_pk_bf16(v[8 * j], v[8 * j + 1]); o.y = pg8::cvt_pk_bf16(v[8 * j + 2], v[8 * j + 3]); o.z = pg8::cvt_pk_bf16(v[8 * j + 4], v[8 * j + 5]); o.w = pg8::cvt_pk_bf16(v[8 * j + 6], v[8 * j + 7]);
        *(LAS v4u*)(scr + lane * 144 + j * 16) = o; }
    asm volatile("s_waitcnt lgkmcnt(0)" ::: "memory");
#pragma unroll
    for (int i = 0; i < 8; ++i) { const int row = 8 * i + (lane >> 3), ch = lane & 7; const v4u o = *(const LAS v4u*)(scr + row * 144 + ch * 16);
        *(GAS v4u*)(dst0 + (size_t)row * K + ch * 8) = o; }
    asm volatile("s_waitcnt lgkmcnt(0)" ::: "memory");
}
struct CvI { const float* srcl; const float* ks; bf16* dst0; int ldn, k0, K; };
__device__ __forceinline__ CvI cvi_gu(const float* Wg, const float* Wu, const float* ks, bf16* WT, int item, int lane) {
    const int nblk = 2 * FF / 64, kb = item / nblk, db = item % nblk, drow = 64 * db + lane, pn = drow >> 8, bj = (drow >> 7) & 1, r = drow & 127;
    return CvI{(bj ? Wu : Wg) + 128 * pn + r, ks, WT + (size_t)(64 * db) * D + CKB * kb, FF, CKB * kb, D};
}
__device__ __forceinline__ CvI cvi_plain(const float* W, int K, int N, bf16* WT, int item, int lane) {
    const int nblk = N / 64, kb = item / nblk, nb = item % nblk, k0 = CKB * kb;
    return CvI{W + 64 * nb + lane, nullptr, WT + (size_t)(64 * nb) * K + k0, N, k0, K};
}
template <int WHICH> __device__ __forceinline__ void conv_run2(Frame& F, KA a, int first, int step, int hi) {
    LAS unsigned char* scr = F.lds + RING_OFF + F.wave * CONV_LDS;
    auto dec = [&](int it) {
        if (WHICH == 1) { const int e = it / IT_DN, r = it % IT_DN; return cvi_plain(a->in[25] + (size_t)e * FF * D, FF, D, (bf16*)(F.ws + WS_WDT + (size_t)(e < 7 ? 4 * e : WDT_E7) * WDT_TILEB), r, F.lane); }
        int r = it;
        if (r < IT_GU) return cvi_gu(a->in[19], a->in[20], a->in[18], (bf16*)(F.ws + WS_DGU), r, F.lane);
        r -= IT_GU;
        if (r < IT_DN) return cvi_plain(a->in[21], FF, D, (bf16*)(F.ws + WS_DD), r, F.lane);
        r -= IT_DN;
        const int e = r / IT_GU; r -= e * IT_GU;
        return cvi_gu(a->in[23] + (size_t)e * D * FF, a->in[24] + (size_t)e * D * FF, a->in[18] + D, (bf16*)(F.ws + WS_MOEW) + (size_t)e * 2 * FF * D, r, F.lane); };
    if (first >= hi) return;
    static_assert(BG_B6 >= IT_GU + IT_DN, "the left-over background items are all MoE gate|up items (row length FF)");
    constexpr int LDN = WHICH == 1 ? D : FF;
    float va[CKB], vb[CKB];
    CvI ca = dec(first), cb = ca; conv_load2(ca.srcl, LDN, ca.k0, va);
    for (int it = first;; ) {
        const bool nb = it + step < hi; if (nb) { cb = dec(it + step); conv_load2(cb.srcl, LDN, cb.k0, vb); }
        conv_store2(va, ca.ks, ca.k0, ca.dst0, ca.K, scr, F.lane); if (!nb) break; it += step;
        const bool na = it + step < hi; if (na) { ca = dec(it + step); conv_load2(ca.srcl, LDN, ca.k0, va); }
        conv_store2(vb, cb.ks, cb.k0, cb.dst0, cb.K, scr, F.lane); if (!na) break; it += step;
    }
}
__device__ __forceinline__ void p0_xb(Frame& F, const float* x, int rank, int nranks) {
    const int gw = rank * NWAVES + F.wave, NGW = nranks * NWAVES;
    bf16* XB = (bf16*)(F.ws + WS_XB); float* ssq = (float*)(F.ws + WS_SSQ_A);
    for (int m0 = gw * 4; m0 < T; m0 += NGW * 4) {
        f32x4 v[4][4];
#pragma unroll
        for (int r = 0; r < 4; ++r) { const GAS f32x4* xr = (const GAS f32x4*)(x + (size_t)(m0 + r) * D) + F.lane;
#pragma unroll
            for (int j = 0; j < 4; ++j) v[r][j] = __builtin_nontemporal_load(xr + 64 * j); }
#pragma unroll
        for (int r = 0; r < 4; ++r) { float s = 0.f; GAS unsigned long long* o8 = (GAS unsigned long long*)(XB + (size_t)(m0 + r) * D) + F.lane;
#pragma unroll
            for (int j = 0; j < 4; ++j) { const f32x4 w = v[r][j]; s += (w.x * w.x + w.y * w.y) + (w.z * w.z + w.w * w.w);
                o8[64 * j] = (unsigned long long)pk2(w.x, w.y) | ((unsigned long long)pk2(w.z, w.w) << 32); }
            s = wave_sum(s);
            if (F.lane < 16) ssq[(size_t)(m0 + r) * 16 + F.lane] = F.lane == 0 ? s : 0.f; }
    }
}
constexpr size_t SP_TOEP = 0  , SP_PW = 1 * MiB, SP_ACC = 2 * MiB, SP_AC64 = 2 * MiB + 16 * 1024, SP_WSTT = 4 * MiB, SP_WOUTT = 6 * MiB;
constexpr size_t WS_EB = 5 * MiB;
constexpr unsigned EB_TAG = 0x5EED0001u;
__device__ __forceinline__ void ssm_precompute(Frame& F, KA a, int l, int g) {
    LAS float* apr = (LAS float*)(F.lds + RING_OFF); LAS float* api = apr + 17 * 64; LAS float* bbr = api + 17 * 64; LAS float* bbi = bbr + 1024; LAS float* cr = bbi + 1024; LAS float* ci = cr + 1024; LAS float* KT = ci + 1024;
    unsigned char* sp = F.ws + WS_SSMPRE + l * SSMPRE_STRIDE;
    bf16* TOEP = (bf16*)(sp + SP_TOEP) + (size_t)g * 8192; bf16* WSTT = (bf16*)(sp + SP_WSTT) + (size_t)g * 32768; bf16* WOUTT = (bf16*)(sp + SP_WOUTT) + (size_t)g * 32768; float* AC = (float*)(sp + SP_ACC) + g * 128;
    const int lg = l * NG + g, tid = F.tid;
    __syncthreads();
    if (tid < 64) { const int n = tid;
        const double lr = a->in[6][lg * 64 + n], li = a->in[7][lg * 64 + n], dt = exp((double)a->in[8][lg]);
        const double mag = exp(lr * dt), ang = li * dt, a1r = mag * cos(ang), a1i = mag * sin(ang);
        double pr = 1.0, pi = 0.0, a16r = 0.0, a16i = 0.0;
        for (int tau = 0; tau <= 16; ++tau) { apr[tau * 64 + n] = (float)pr; api[tau * 64 + n] = (float)pi; if (tau == 16) { a16r = pr; a16i = pi; } const double qr = pr * a1r - pi * a1i, qi = pr * a1i + pi * a1r; pr = qr; pi = qi; }
        { float* PW = (float*)(sp + SP_PW) + (size_t)g * 8192; float* AC64 = (float*)(sp + SP_AC64) + g * 128; double qr = 1.0, qi = 0.0;
          for (int c = 0; c < 64; ++c) { PW[(c * 64 + n) * 2] = (float)qr; PW[(c * 64 + n) * 2 + 1] = (float)qi; const double tr = qr * a16r - qi * a16i, ti = qr * a16i + qi * a16r; qr = tr; qi = ti; }
          AC64[n] = (float)qr; AC64[64 + n] = (float)qi; }
        const double nr = a1r - 1.0, den = lr * lr + li * li, fre = (nr * lr + a1i * li) / den, fim = (a1i * lr - nr * li) / den;
        for (int c = 0; c < 16; ++c) { const double br = a->in[9][(size_t)(lg * 64 + n) * 16 + c], bi = a->in[10][(size_t)(lg * 64 + n) * 16 + c];
            bbr[n * 16 + c] = (float)(fre * br - fim * bi); bbi[n * 16 + c] = (float)(fre * bi + fim * br); }
        AC[n] = apr[16 * 64 + n]; AC[64 + n] = api[16 * 64 + n];
    }
    for (int o = tid; o < 1024; o += 512) { cr[o] = a->in[11][(size_t)lg * 1024 + o]; ci[o] = a->in[12][(size_t)lg * 1024 + o]; }
    __syncthreads();
    {
        const int co = tid >> 5, c = (tid >> 1) & 15, th = tid & 1; float acc8[8];
#pragma unroll
        for (int q = 0; q < 8; ++q) acc8[q] = 0.f;
        for (int n = 0; n < 64; ++n) { const float c_r = cr[co * 64 + n], c_i = ci[co * 64 + n], br = bbr[n * 16 + c], bi = bbi[n * 16 + c];
            const float xr = c_r * br - c_i * bi, xi = c_r * bi + c_i * br;
#pragma unroll
            for (int q = 0; q < 8; ++q) { const int tau = 8 * th + q; acc8[q] += xr * apr[tau * 64 + n] - xi * api[tau * 64 + n]; } }
#pragma unroll
        for (int q = 0; q < 8; ++q) { const int tau = 8 * th + q; float sv = acc8[q]; if (tau == 0 && co == c) sv += a->in[13][l * SW + g * 16 + co]; KT[tau * 256 + co * 16 + c] = sv; }
    }
    __syncthreads();
    for (int o = tid; o < 4096; o += 512) {
        const int col = 224 + (o >> 7), k = (o & 127) * 2, t = col >> 4, co = col & 15, s0 = k >> 4, c0 = k & 15;
        const float v0 = t >= s0 ? KT[(t - s0) * 256 + co * 16 + c0] : 0.f, v1 = t >= s0 ? KT[(t - s0) * 256 + co * 16 + c0 + 1] : 0.f;
        *(unsigned*)(TOEP + (size_t)((((k >> 4) * 64) + ((k >> 3) & 1) * 32 + (col - 224)) * 8 + (k & 7))) = pk2(v0, v1); }
    for (int o = tid; o < 16384; o += 512) {
        const int n2 = o >> 7, k = (o & 127) * 2, n = n2 & 63, sidx = k >> 4, c0 = k & 15; float v[2];
#pragma unroll
        for (int q = 0; q < 2; ++q) { const float pr = apr[(15 - sidx) * 64 + n], pi = api[(15 - sidx) * 64 + n], br = bbr[n * 16 + c0 + q], bi = bbi[n * 16 + c0 + q]; v[q] = (n2 < 64) ? (pr * br - pi * bi) : (pr * bi + pi * br); }
        *(unsigned*)(WSTT + (size_t)(((((n2 >> 5) * 16 + (k >> 4)) * 64) + ((k >> 3) & 1) * 32 + (n2 & 31)) * 8 + (k & 7))) = pk2(v[0], v[1]); }
    for (int o = tid; o < 16384; o += 512) {
        const int col = o >> 6, n = o & 63, tl = col >> 4, co = col & 15;
        const float pr = apr[(tl + 1) * 64 + n], pi = api[(tl + 1) * 64 + n], c_r = cr[co * 64 + n], c_i = ci[co * 64 + n];
        { const int k = 2 * n; *(unsigned*)(WOUTT + (size_t)(((((col >> 5) * 8 + (k >> 4)) * 64) + ((k >> 3) & 1) * 32 + (col & 31)) * 8 + (k & 7))) = pk2(c_r * pr - c_i * pi, -(c_r * pi + c_i * pr)); } }
    __syncthreads();
}

namespace att {
typedef short bf16x8 __attribute__((ext_vector_type(8)));
typedef short s16x4 __attribute__((ext_vector_type(4)));
typedef short v4i16_t __attribute__((ext_vector_type(4)));
typedef float f32x16 __attribute__((ext_vector_type(16)));
typedef unsigned u32x4 __attribute__((ext_vector_type(4)));
typedef __attribute__((address_space(3))) const char* lds_cptr;
constexpr int SLOTB = 8192, BUFB = 6 * SLOTB, LDS_K = 0, LDS_V = 3 * SLOTB, LDS_WS = 2 * BUFB, LDS_OST = LDS_WS + 8 * 64 * 4, LDS_TOTAL = LDS_OST + 8 * 2048;
static_assert(LDS_TOTAL <= RING_BYTES, "attention LDS");
__device__ __forceinline__ int crow(int r, int hi) { return (r & 3) + 8 * (r >> 2) + 4 * hi; }
__device__ __forceinline__ void glds16(const void* gsrc, unsigned lds_dst) { unsigned keep;
    asm volatile("s_mov_b32 %0, m0\n\ts_mov_b32 m0, %2\n\ts_nop 0\n\tglobal_load_lds_dwordx4 %1, off\n\ts_mov_b32 m0, %0" : "=&s"(keep) : "v"(gsrc), "s"(lds_dst) : "memory"); }
typedef float f32x2_t __attribute__((ext_vector_type(2))); typedef __bf16 bf16x2_t __attribute__((ext_vector_type(2)));
__device__ __forceinline__ unsigned cvtpk(float lo, float hi) { f32x2_t v = {lo, hi}; bf16x2_t b = __builtin_convertvector(v, bf16x2_t); return __builtin_bit_cast(unsigned, b); }
__device__ __forceinline__ s16x4 vtr(lds_cptr p) { return __builtin_bit_cast(s16x4, __builtin_amdgcn_ds_read_tr16_b64_v4i16((__attribute__((address_space(3))) v4i16_t*)p)); }
__device__ __forceinline__ float xhalf_max(float m) { auto rr = __builtin_amdgcn_permlane32_swap(__float_as_uint(m), __float_as_uint(m), false, false); return fmaxf(__uint_as_float(rr[0]), __uint_as_float(rr[1])); }
__device__ __forceinline__ float xhalf_sum(float m) { auto rr = __builtin_amdgcn_permlane32_swap(__float_as_uint(m), __float_as_uint(m), false, false); return __uint_as_float(rr[0]) + __uint_as_float(rr[1]); }

struct Ctx { int tid, lane, r32, hi, wid; };
__device__ __forceinline__ void attn_issue(const Ctx& c, int u, int buf, const bf16* QKVU, LAS unsigned char* shm, bf16x8 (&qn)[4]) {
    const int qb = u % (SEQ / 64), kvh = (u / (SEQ / 64)) % NKV, b = u / (NKV * (SEQ / 64));
    const int h = kvh * 4 + (c.wid >> 1), q0 = qb * 64, qw = q0 + 32 * (c.wid & 1);
    const size_t rowbase = (size_t)b * SEQ; const unsigned lds0 = (unsigned)(uintptr_t)shm + buf * BUFB;
#pragma unroll
    for (int j = 0; j < 3; ++j) {
        const int kv0 = q0 - 128 + 64 * j;
        int kr = kv0 + c.lane; kr = kr < 0 ? 0 : kr;
        int vr = kv0 + 16 * (c.wid & 3) + (c.lane >> 2); vr = vr < 0 ? 0 : vr;
        glds16(QKVU + (rowbase + kr) * INW + KOFF + kvh * 64 + c.wid * 8, (unsigned)__builtin_amdgcn_readfirstlane(lds0 + LDS_K + j * SLOTB + c.wid * 1024));
        glds16(QKVU + (rowbase + vr) * INW + VOFF + kvh * 64 + (c.wid >> 2) * 32 + (c.lane & 3) * 8, (unsigned)__builtin_amdgcn_readfirstlane(lds0 + LDS_V + j * SLOTB + c.wid * 1024));
    }
    const bf16* qp = QKVU + (rowbase + qw + c.r32) * INW + QOFF + h * 64 + c.hi * 8;
#pragma unroll
    for (int d0 = 0; d0 < 4; ++d0) qn[d0] = *(const bf16x8*)(qp + d0 * 16);
}
__device__ __forceinline__ void attn_compute(const Ctx& c, int u, int buf, const bf16x8 (&qr)[4], bf16* MIX, float* ssq, const float* sinks, LAS unsigned char* shm0) {
    const int lane = c.lane, r32 = c.r32, hi = c.hi, wid = c.wid;
    const int qb = u % (SEQ / 64), kvh = (u / (SEQ / 64)) % NKV, b = u / (NKV * (SEQ / 64));
    const int h = kvh * 4 + (wid >> 1), qsub = wid & 1, q0 = qb * 64, qw = q0 + 32 * qsub;
    const size_t rowbase = (size_t)b * SEQ;
    LAS unsigned char* shm = shm0 + buf * BUFB;
    const float sink2 = sinks[h] * LOG2E;
    f32x16 p[5];
    const lds_cptr kbase = (lds_cptr)shm + LDS_K + hi * 1024 + r32 * 16;
#pragma unroll
    for (int hb = 0; hb < 5; ++hb) {
        const int G = qsub + hb;
        const lds_cptr kp = kbase + (G >> 1) * SLOTB + (G & 1) * 512;
        f32x16 acc = {};
#pragma unroll
        for (int d0 = 0; d0 < 4; ++d0) { const bf16x8 kf = *(const __attribute__((address_space(3))) bf16x8*)(kp + d0 * 2048); acc = __builtin_amdgcn_mfma_f32_32x32x16_bf16(kf, qr[d0], acc, 0, 0, 0); }
        p[hb] = acc;
    }
    const float NEG = -1.0e30f;
#pragma unroll
    for (int r = 0; r < 16; ++r) { const int cr_ = crow(r, hi); if (!(r32 < cr_)) p[0][r] = NEG; if (!(cr_ <= r32)) p[4][r] = NEG; }
    if (q0 < 128) {
#pragma unroll
        for (int hb = 0; hb < 5; ++hb)
#pragma unroll
            for (int r = 0; r < 16; ++r) { if (qw - 128 + 32 * hb + crow(r, hi) < 0) p[hb][r] = NEG; }
    }
    float m = sink2;
#pragma unroll
    for (int hb = 0; hb < 5; ++hb)
#pragma unroll
        for (int r = 0; r < 16; ++r) m = fmaxf(m, p[hb][r]);
    m = xhalf_max(m);
    float lsum = 0.f;
#pragma unroll
    for (int hb = 0; hb < 5; ++hb)
#pragma unroll
        for (int r = 0; r < 16; ++r) { const float e = __builtin_amdgcn_exp2f(p[hb][r] - m); p[hb][r] = e; lsum += e; }
    lsum = xhalf_sum(lsum) + __builtin_amdgcn_exp2f(sink2 - m);
    f32x16 o[2]; o[0] = f32x16{}; o[1] = f32x16{};
    const lds_cptr vp0 = (lds_cptr)shm + LDS_V + ((lane >> 4) & 1) * 32 + (lane & 3) * 8 + (4 * hi + ((lane & 15) >> 2)) * 64;
#pragma unroll
    for (int hb = 0; hb < 5; ++hb) {
#pragma unroll
        for (int kk = 0; kk < 2; ++kk) {
            const int ko = 32 * (qsub + hb) + 16 * kk, j = ko >> 6, ks = (ko >> 4) & 3;
            u32x4 pw; pw.x = cvtpk(p[hb][8 * kk + 0], p[hb][8 * kk + 1]); pw.y = cvtpk(p[hb][8 * kk + 2], p[hb][8 * kk + 3]); pw.z = cvtpk(p[hb][8 * kk + 4], p[hb][8 * kk + 5]); pw.w = cvtpk(p[hb][8 * kk + 6], p[hb][8 * kk + 7]);
            const bf16x8 pa = __builtin_bit_cast(bf16x8, pw);
#pragma unroll
            for (int d0 = 0; d0 < 2; ++d0) {
                const lds_cptr vp = vp0 + j * SLOTB + d0 * 4096 + ks * 1024;
                const s16x4 lo = vtr(vp), hh = vtr(vp + 512);
                const bf16x8 vf = (bf16x8){lo[0], lo[1], lo[2], lo[3], hh[0], hh[1], hh[2], hh[3]};
                o[d0] = __builtin_amdgcn_mfma_f32_32x32x16_bf16(pa, vf, o[d0], 0, 0, 0);
            }
        }
    }
    LAS float* wsf = (LAS float*)(shm0 + LDS_WS) + wid * 64;
    if (hi == 0) wsf[r32] = lsum;
    asm volatile("s_waitcnt lgkmcnt(0)" ::: "memory");
    float rli[16];
#pragma unroll
    for (int r = 0; r < 16; ++r) rli[r] = __builtin_amdgcn_rcpf(wsf[crow(r, hi)]);
    LAS bf16* stg = (LAS bf16*)(shm0 + LDS_OST) + wid * 1024;
    bf16* Ow = MIX + (rowbase + qw) * D + h * 64;
    float ssrow[2] = {0.f, 0.f};
#pragma unroll
    for (int d0 = 0; d0 < 2; ++d0) {
#pragma unroll
        for (int r = 0; r < 16; ++r) stg[crow(r, hi) * 32 + r32] = (bf16)pg8::cvt_pk_bf16(o[d0][r] * rli[r], 0.f);
        asm volatile("s_waitcnt lgkmcnt(0)" ::: "memory");
#pragma unroll
        for (int i = 0; i < 2; ++i) { const int row = i * 16 + (lane >> 2), ch = lane & 3; const u32x4 v = *(const LAS u32x4*)(stg + row * 32 + ch * 8);
            *(u32x4*)(Ow + (size_t)row * D + d0 * 32 + ch * 8) = v;
            const unsigned w4[4] = {v.x, v.y, v.z, v.w};
#pragma unroll
            for (int k = 0; k < 4; ++k) { const float a = pg8::bf_lo(w4[k]), cc = pg8::bf_hi(w4[k]); ssrow[i] += a * a + cc * cc; } }
        asm volatile("s_waitcnt lgkmcnt(0)" ::: "memory");
    }
#pragma unroll
    for (int i = 0; i < 2; ++i) { float ss = ssrow[i]; ss += __shfl_xor(ss, 1); ss += __shfl_xor(ss, 2); if ((lane & 3) == 0) ssq[(rowbase + qw + i * 16 + (lane >> 2)) * 8 + h] = ss; }
}
}
__device__ __forceinline__ void attn_phase_v1(Frame& F, KA a, int l, int first, int count) {
    const int me = F.bx - first; if (me < 0 || me >= count) return;
    const bf16* QKVU = (const bf16*)(F.ws + WS_QKVU); bf16* MIX = (bf16*)(F.ws + WS_MIX); float* ssq = (float*)(F.ws + WS_SSQ_ATT);
    att::Ctx c; { int tid_ = F.tid; asm volatile("" : "+v"(tid_)); c.tid = tid_; c.lane = tid_ & 63; c.r32 = c.lane & 31; c.hi = c.lane >> 5; c.wid = __builtin_amdgcn_readfirstlane(tid_ >> 6); }
    constexpr int NU = BATCH * NKV * (SEQ / 64);
    att::bf16x8 qr[4], qn[4];
    int u = me, it = 0;
    if (u >= NU) return;
    asm volatile("s_waitcnt lgkmcnt(0)\n\ts_barrier" ::: "memory");
    att::attn_issue(c, u, 0, QKVU, F.lds + RING_OFF, qr);
    for (; u < NU; u += count, ++it) {
        const bool has_next = u + count < NU;
        if (has_next) att::attn_issue(c, u + count, (it + 1) & 1, QKVU, F.lds + RING_OFF, qn);
        if (has_next && it > 0) asm volatile("s_waitcnt vmcnt(14)" ::: "memory"); else if (has_next) asm volatile("s_waitcnt vmcnt(10)" ::: "memory"); else asm volatile("s_waitcnt vmcnt(0)" ::: "memory");
        asm volatile("s_barrier" ::: "memory");
        att::attn_compute(c, u, it & 1, qr, MIX, ssq, a->in[5] + l * NH, F.lds + RING_OFF);
        asm volatile("s_waitcnt lgkmcnt(0)\n\ts_barrier" ::: "memory");
#pragma unroll
        for (int d0 = 0; d0 < 4; ++d0) qr[d0] = qn[d0];
    }
}

__device__ __forceinline__ float gelu_tanh(float y) {
    const float t = y * (2.0f * 0.7978845608028654f * LOG2E + (2.0f * 0.7978845608028654f * 0.044715f * LOG2E) * y * y);
    return y - y * __builtin_amdgcn_rcpf(1.0f + __builtin_amdgcn_exp2f(t));
}
namespace ssm {
typedef short bf16x8 __attribute__((ext_vector_type(8)));
typedef float f32x16 __attribute__((ext_vector_type(16)));
constexpr int UST = 528, UBUF = 64 * UST, HST = 272;
constexpr int L_U = 0, L_SL = 2 * UBUF, L_HB = L_SL  , L_TF = L_SL + 64 * 128 * 4, L_END = L_TF + 19 * 1024;
static_assert(L_END <= RING_BYTES, "ssm LDS");
__device__ __forceinline__ int crow(int r, int hi) { return (r & 3) + 8 * (r >> 2) + 4 * hi; }
constexpr int M_U = 0, M_SL = UBUF, M_HB = M_SL + 64 * 128 * 4, M_TF = M_HB + 64 * HST, M_HIN = M_TF + 19 * 1024, M_END = M_HIN + 512;
static_assert(M_END <= RING_BYTES, "ssm LDS (decoupled)");
typedef __attribute__((address_space(1))) unsigned long long gu64s;
__device__ __forceinline__ void ssm_job2(int bg, int sb, int l, unsigned char* ws, LAS unsigned char* shm) {
    int tid_ = threadIdx.x; asm volatile("" : "+v"(tid_));
    const int tid = tid_, lane = tid & 63, r32 = lane & 31, hi = lane >> 5; const int w = __builtin_amdgcn_readfirstlane(tid >> 6);
    const int b = bg / NG, g = bg % NG;
    const bf16* UGp = (const bf16*)(ws + WS_UG); bf16* YG = (bf16*)(ws + WS_YG);
    unsigned char* sp = ws + WS_SSMPRE + l * SSMPRE_STRIDE;
    const bf16* TOEP = (const bf16*)(sp + SP_TOEP) + (size_t)g * 8192; const bf16* WSTT = (const bf16*)(sp + SP_WSTT) + (size_t)g * 32768; const bf16* WOUTT = (const bf16*)(sp + SP_WOUTT) + (size_t)g * 32768;
    const float* AC = (const float*)(sp + SP_ACC) + g * 128; const float* AC64 = (const float*)(sp + SP_AC64) + g * 128; const float* PW = (const float*)(sp + SP_PW) + (size_t)g * 8192;
    gu64s* eb = (gu64s*)(ws + WS_EB) + (size_t)((l * 64 + bg) * 8) * 128;
    const int mt1 = w >> 2, nt1 = w & 3;
    const int J = w < 4 ? w : 11 - w, ns = 2 * J + 2;
    const size_t rowb = (size_t)b * SEQ + (size_t)sb * 1024;
    v4u up[4];
#pragma unroll
    for (int i = 0; i < 4; ++i) { const int pi = tid + 512 * i; up[i] = *(const v4u*)(UGp + ((size_t)g * T + rowb) * GD + (size_t)pi * 8); }
    bf16x8 tfr[2];
#pragma unroll
    for (int i = 0; i < 2; ++i) tfr[i] = *(const bf16x8*)(TOEP + (size_t)((2 * w + i) * 64 + lane) * 8);
    float2 pwv[8];
#pragma unroll
    for (int i = 0; i < 8; ++i) pwv[i] = *(const float2*)(PW + (size_t)(((tid >> 6) + 8 * i) * 64 + (tid & 63)) * 2);
    const float acr = AC[lane], aci = AC[64 + lane], a64r = AC64[lane], a64i = AC64[64 + lane];
    bf16x8 bw1[16], bc[8];
#pragma unroll
    for (int ks = 0; ks < 16; ++ks) bw1[ks] = *(const bf16x8*)(WSTT + (size_t)((nt1 * 16 + ks) * 64 + lane) * 8);
#pragma unroll
    for (int ks = 0; ks < 8; ++ks) bc[ks] = *(const bf16x8*)(WOUTT + (size_t)((J * 8 + ks) * 64 + lane) * 8);
#pragma unroll
    for (int i = 0; i < 4; ++i) { const int pi = tid + 512 * i, row = pi >> 1; *(LAS v4u*)(shm + M_U + (row >> 4) * UST + (row & 15) * 32 + (pi & 1) * 16) = up[i]; }
#pragma unroll
    for (int i = 0; i < 2; ++i) *(LAS bf16x8*)(shm + M_TF + (2 * w + i) * 1024 + lane * 16) = tfr[i];
    if (w < 3) { unsigned z0, z1, z2, z3; asm volatile("v_mov_b32 %0, 0\n\tv_mov_b32 %1, 0\n\tv_mov_b32 %2, 0\n\tv_mov_b32 %3, 0" : "=v"(z0), "=v"(z1), "=v"(z2), "=v"(z3));
        *(LAS v4u*)(shm + M_TF + (16 + w) * 1024 + lane * 16) = (v4u){z0, z1, z2, z3}; }
    asm volatile("s_waitcnt lgkmcnt(0)\n\ts_barrier" ::: "memory");
    const LAS unsigned char* ub = shm + M_U + hi * 16;
    {
        f32x16 acc = {};
#pragma unroll
        for (int ks = 0; ks < 16; ++ks) { const bf16x8 af = *(const LAS bf16x8*)(ub + (32 * mt1 + r32) * UST + ks * 32); acc = __builtin_amdgcn_mfma_f32_32x32x16_bf16(af, bw1[ks], acc, 0, 0, 0); }
        LAS float* sl = (LAS float*)(shm + M_SL);
#pragma unroll
        for (int r = 0; r < 16; ++r) sl[(32 * mt1 + crow(r, hi)) * 128 + 32 * nt1 + r32] = acc[r];
    }
    asm volatile("s_waitcnt lgkmcnt(0)\n\ts_barrier" ::: "memory");
    if (w == 0) {
        LAS float* sl = (LAS float*)(shm + M_SL);
        float pwr[4], pwi[4]; pwr[0] = acr; pwi[0] = aci;
#pragma unroll
        for (int j = 1; j < 4; ++j) { pwr[j] = pwr[j - 1] * acr - pwi[j - 1] * aci; pwi[j] = pwr[j - 1] * aci + pwi[j - 1] * acr; }
        float hr = 0.f, hi_ = 0.f;
        for (int c0 = 0; c0 < 64; c0 += 16) {
            float sr[16], si[16];
#pragma unroll
            for (int i = 0; i < 16; ++i) { sr[i] = sl[(c0 + i) * 128 + lane]; si[i] = sl[(c0 + i) * 128 + 64 + lane]; }
            asm volatile("s_waitcnt lgkmcnt(0)" ::: "memory");
#pragma unroll
            for (int gq = 0; gq < 4; ++gq) {
                float tr[4], ti[4]; tr[0] = sr[4 * gq]; ti[0] = si[4 * gq];
#pragma unroll
                for (int j = 1; j < 4; ++j) { tr[j] = __builtin_fmaf(acr, tr[j - 1], __builtin_fmaf(-aci, ti[j - 1], sr[4 * gq + j])); ti[j] = __builtin_fmaf(acr, ti[j - 1], __builtin_fmaf(aci, tr[j - 1], si[4 * gq + j])); }
                sl[(c0 + 4 * gq) * 128 + lane] = hr; sl[(c0 + 4 * gq) * 128 + 64 + lane] = hi_;
#pragma unroll
                for (int j = 1; j < 4; ++j) { const float xr = __builtin_fmaf(pwr[j - 1], hr, __builtin_fmaf(-pwi[j - 1], hi_, tr[j - 1])), xi = __builtin_fmaf(pwr[j - 1], hi_, __builtin_fmaf(pwi[j - 1], hr, ti[j - 1]));
                    sl[(c0 + 4 * gq + j) * 128 + lane] = xr; sl[(c0 + 4 * gq + j) * 128 + 64 + lane] = xi; }
                const float nr = __builtin_fmaf(pwr[3], hr, __builtin_fmaf(-pwi[3], hi_, tr[3])), ni = __builtin_fmaf(pwr[3], hi_, __builtin_fmaf(pwi[3], hr, ti[3])); hr = nr; hi_ = ni;
            }
        }
        { unsigned tagv; asm volatile("v_mov_b32 %0, %1" : "=v"(tagv) : "s"(EB_TAG));
          __hip_atomic_store(eb + sb * 128 + lane, ((unsigned long long)tagv << 32) | __float_as_uint(hr), __ATOMIC_RELAXED, __HIP_MEMORY_SCOPE_AGENT);
          __hip_atomic_store(eb + sb * 128 + 64 + lane, ((unsigned long long)tagv << 32) | __float_as_uint(hi_), __ATOMIC_RELAXED, __HIP_MEMORY_SCOPE_AGENT); }
        float Hr = 0.f, Hi = 0.f;
        for (int sp_ = 0; sp_ < sb; ++sp_) {
            unsigned long long xr = 0, xi = 0;
            for (unsigned spins = 0;; ++spins) {
                xr = __hip_atomic_load(eb + sp_ * 128 + lane, __ATOMIC_RELAXED, __HIP_MEMORY_SCOPE_AGENT); xi = __hip_atomic_load(eb + sp_ * 128 + 64 + lane, __ATOMIC_RELAXED, __HIP_MEMORY_SCOPE_AGENT);
                const bool ok = (unsigned)(xr >> 32) == EB_TAG && (unsigned)(xi >> 32) == EB_TAG;
                if (__all(ok)) break;
                if (spins > (1u << 20)) break;
                __builtin_amdgcn_s_sleep(2);
            }
            const float er = __uint_as_float((unsigned)xr), ei = __uint_as_float((unsigned)xi);
            const float nr = __builtin_fmaf(a64r, Hr, __builtin_fmaf(-a64i, Hi, er)), ni = __builtin_fmaf(a64r, Hi, __builtin_fmaf(a64i, Hr, ei)); Hr = nr; Hi = ni;
        }
        LAS float* hin = (LAS float*)(shm + M_HIN); hin[lane] = Hr; hin[64 + lane] = Hi;
    }
    f32x16 acc2[2]; acc2[0] = f32x16{}; acc2[1] = f32x16{};
#pragma unroll
    for (int kb = 0; kb < 4; ++kb) { if (4 * kb < ns) {
        bf16x8 bf[4];
#pragma unroll
        for (int q = 0; q < 4; ++q) bf[q] = *(const LAS bf16x8*)(shm + M_TF + (14 - 2 * J + 4 * kb + q) * 1024 + lane * 16);
#pragma unroll
        for (int mt = 0; mt < 2; ++mt) { bf16x8 af[4];
#pragma unroll
            for (int q = 0; q < 4; ++q) af[q] = *(const LAS bf16x8*)(ub + (32 * mt + r32) * UST + (4 * kb + q) * 32);
#pragma unroll
            for (int q = 0; q < 4; ++q) acc2[mt] = __builtin_amdgcn_mfma_f32_32x32x16_bf16(af[q], bf[q], acc2[mt], 0, 0, 0); }
    } }
    asm volatile("s_waitcnt lgkmcnt(0)\n\ts_barrier" ::: "memory");
    {
        const int n = tid & 63, cq = tid >> 6; const LAS float* sl = (const LAS float*)(shm + M_SL); const LAS float* hin = (const LAS float*)(shm + M_HIN);
        const float Hr = hin[n], Hi = hin[64 + n];
#pragma unroll
        for (int i = 0; i < 8; ++i) { const int c = cq + 8 * i; const float2 pw = pwv[i];
            const float xr = sl[c * 128 + n] + pw.x * Hr - pw.y * Hi, xi = sl[c * 128 + 64 + n] + pw.x * Hi + pw.y * Hr;
            *(LAS unsigned*)(shm + M_HB + c * HST + n * 4) = pg8::cvt_pk_bf16(xr, xi); }
    }
    asm volatile("s_waitcnt lgkmcnt(0)\n\ts_barrier" ::: "memory");
#pragma unroll
    for (int ks = 0; ks < 8; ++ks) {
#pragma unroll
        for (int mt = 0; mt < 2; ++mt) { const bf16x8 af = *(const LAS bf16x8*)(shm + M_HB + (32 * mt + r32) * HST + ks * 32 + hi * 16); acc2[mt] = __builtin_amdgcn_mfma_f32_32x32x16_bf16(af, bc[ks], acc2[mt], 0, 0, 0); } }
    {   const int t = 2 * J + (r32 >> 4), co = r32 & 15;
#pragma unroll
        for (int mt = 0; mt < 2; ++mt)
#pragma unroll
            for (int r = 0; r < 16; ++r) { const int chunk = 32 * mt + crow(r, hi);
                YG[(rowb + (size_t)chunk * 16 + t) * SW + 16 * g + co] = (bf16)pg8::cvt_pk_bf16(gelu_tanh(acc2[mt][r]), 0.f); } }
    asm volatile("s_waitcnt lgkmcnt(0)\n\ts_barrier" ::: "memory");
}
}
__device__ __forceinline__ void ssm_phase_v2(Frame& F, int l) {
    for (int j = F.bx; j < BATCH * NG * (SEQ / 1024); j += F.G) ssm::ssm_job2(j % (BATCH * NG), j / (BATCH * NG), l, F.ws, F.lds + RING_OFF);
}

__device__ __forceinline__ void route1(Frame& F, KA a) {
    LAS int* hl = (LAS int*)(F.lds + RING_OFF);
    unsigned char* rt = F.ws + WS_ROUTE; int* TOPE = (int*)(rt + RT_TOPE); float* TOPG = (float*)(rt + RT_TOPG); float* RINVT = (float*)(rt + RT_RINVT); int* HIST = (int*)(rt + RT_HIST);
    const float* wr = a->in[22]; const float* gn = a->in[18] + D;
    f32x4 w0[4][4], w1[4][4];
#pragma unroll
    for (int j = 0; j < 4; ++j)
#pragma unroll
        for (int q = 0; q < 4; ++q) { const int k = 4 * (F.lane + 64 * j) + q; const float g = gn[k]; w0[j][q] = *(const f32x4*)(wr + k * 8) * g; w1[j][q] = *(const f32x4*)(wr + k * 8 + 4) * g; }
    for (int blk = F.bx; blk < T / 64; blk += F.G) {
        __syncthreads();
        if (F.tid < 8) hl[F.tid] = 0;
        __syncthreads();
        for (int ib = 0; ib < 8; ib += 2) {
            f32x4 xv4[2][4];
#pragma unroll
            for (int i = 0; i < 2; ++i) { const GAS unsigned long long* xr = (const GAS unsigned long long*)((const bf16*)(F.ws + WS_XB) + (size_t)(blk * 64 + F.wave * 8 + ib + i) * D) + F.lane;
#pragma unroll
                for (int j = 0; j < 4; ++j) { const unsigned long long w = xr[64 * j]; const unsigned lo = (unsigned)w, hi2 = (unsigned)(w >> 32); xv4[i][j] = (f32x4){pg8::bf_lo(lo), pg8::bf_hi(lo), pg8::bf_lo(hi2), pg8::bf_hi(hi2)}; } }
#pragma unroll
            for (int i = 0; i < 2; ++i) {
            const int t = blk * 64 + F.wave * 8 + ib + i;
            f32x4 la = {0.f, 0.f, 0.f, 0.f}, lb = {0.f, 0.f, 0.f, 0.f}; float ss = 0.f;
#pragma unroll
            for (int j = 0; j < 4; ++j) { const f32x4 v = xv4[i][j]; const float xv[4] = {v.x, v.y, v.z, v.w};
#pragma unroll
                for (int q = 0; q < 4; ++q) { ss += xv[q] * xv[q]; la += w0[j][q] * xv[q]; lb += w1[j][q] * xv[q]; } }
            ss = wave_sum(ss);
            float lg[8] = {la.x, la.y, la.z, la.w, lb.x, lb.y, lb.z, lb.w};
#pragma unroll
            for (int e = 0; e < 8; ++e) lg[e] = wave_sum(lg[e]);
            const float rinv = 1.0f / sqrtf(ss * (1.0f / D) + EPS);
            int e1 = 0; float l1 = lg[0];
#pragma unroll
            for (int e = 1; e < 8; ++e) if (lg[e] > l1) { l1 = lg[e]; e1 = e; }
            int e2 = -1; float l2 = -3.0e38f;
#pragma unroll
            for (int e = 0; e < 8; ++e) if (e != e1 && lg[e] > l2) { l2 = lg[e]; e2 = e; }
            const float g2 = 1.0f / (1.0f + __expf((l1 - l2) * rinv)), g1 = 1.0f - g2;
            if (F.lane == 0) { TOPE[t * 2] = e1; TOPE[t * 2 + 1] = e2; TOPG[t * 2] = g1; TOPG[t * 2 + 1] = g2; RINVT[t] = rinv; atomicAdd((int*)&hl[e1], 1); atomicAdd((int*)&hl[e2], 1); }
            }
        }
        __syncthreads();
        if (F.tid < 8) HIST[blk * 8 + F.tid] = hl[F.tid];
    }
    __syncthreads();
}
__device__ __forceinline__ void route2(Frame& F) {
    LAS int* sb = (LAS int*)(F.lds + RING_OFF);
    unsigned char* rt = F.ws + WS_ROUTE; const int* TOPE = (const int*)(rt + RT_TOPE); const float* TOPG = (const float*)(rt + RT_TOPG); const float* RINVT = (const float*)(rt + RT_RINVT); const int* HIST = (const int*)(rt + RT_HIST);
    int* IDX = (int*)(rt + RT_IDX); float* GATE = (float*)(rt + RT_GATE); float* RINVS = (float*)(rt + RT_RINVS); int* POS = (int*)(rt + RT_POS); int* PEND = (int*)(rt + RT_PEND);
    for (int blk = F.bx; blk < T / 64; blk += F.G) {
        __syncthreads();
        if (F.tid < 16) sb[F.tid] = 0;
        __syncthreads();
        if (F.tid < T / 64) {
            const int4 h0 = *(const int4*)(HIST + F.tid * 8), h1 = *(const int4*)(HIST + F.tid * 8 + 4); const int hv[8] = {h0.x, h0.y, h0.z, h0.w, h1.x, h1.y, h1.z, h1.w};
#pragma unroll
            for (int e = 0; e < 8; ++e) { atomicAdd((int*)&sb[e], hv[e]); if (F.tid < blk) atomicAdd((int*)&sb[8 + e], hv[e]); }
        }
        __syncthreads();
        if (F.tid == 0) { int ps = 0; for (int e = 0; e < 8; ++e) { const int pd = (sb[e] + 255) & ~255; sb[16 + e] = ps; sb[24 + e] = pd; ps += pd; if (blk == 0) PEND[e] = ps >> 8; } }
        __syncthreads();
        if (F.wave == 0) {
            const int t = blk * 64 + F.lane; int run[8];
#pragma unroll
            for (int e = 0; e < 8; ++e) run[e] = sb[16 + e] + sb[8 + e];
#pragma unroll
            for (int k = 0; k < 2; ++k) { const int e = TOPE[t * 2 + k]; int slot = 0;
#pragma unroll
                for (int ee = 0; ee < 8; ++ee) { const unsigned long long mk = __ballot(e == ee); const int below = __popcll(mk & ((1ull << F.lane) - 1ull));
                    if (e == ee) slot = run[ee] + below; run[ee] += __popcll(mk); }
                IDX[slot] = t; GATE[slot] = TOPG[t * 2 + k]; RINVS[slot] = RINVT[t]; POS[t * 2 + k] = slot; }
        }
        if (blk == 0) {
            for (int e = 0; e < 8; ++e) { const int s0 = sb[16 + e] + sb[e], s1 = sb[16 + e] + sb[24 + e]; for (int s = s0 + F.tid; s < s1; s += 512) { IDX[s] = 0; GATE[s] = 0.f; RINVS[s] = 0.f; } }
        }
    }
    __syncthreads();
}
__device__ __forceinline__ void moe_combine(Frame& F) {
    const bf16* YS = (const bf16*)(F.ws + WS_YS); const int* POS = (const int*)(F.ws + WS_ROUTE + RT_POS); const float* GATE = (const float*)(F.ws + WS_ROUTE + RT_GATE);
    const unsigned* TM = (const unsigned*)(F.ws + WS_CTL) + CW_TAILMAP; const float* SLAB = (const float*)(F.ws + WS_SLAB);
    const int S = pg8::ks_slices(((const int*)(F.ws + WS_ROUTE + RT_PEND))[7] * (D / 256), F.G);
    const int gw = F.vcu * NWAVES + F.wave, NGW = F.G * NWAVES;
    for (int t = gw; t < T; t += NGW) {
        const int p0 = POS[t * 2], p1 = POS[t * 2 + 1];
        const v4u tm0 = *(const v4u*)(TM + (p0 >> 8) * 4), tm1 = *(const v4u*)(TM + (p1 >> 8) * 4);
        GAS f32x4* xr = (GAS f32x4*)(F.out + (size_t)t * D) + F.lane;
        const GAS unsigned long long* xb = (const GAS unsigned long long*)((const bf16*)(F.ws + WS_XB) + (size_t)t * D) + F.lane;
        const bf16* YS2 = (const bf16*)(F.ws + WS_YS2);
        const GAS unsigned long long* y0 = (const GAS unsigned long long*)(p0 < YS_SPLIT ? YS + (size_t)p0 * D : YS2 + (size_t)(p0 - YS_SPLIT) * D) + F.lane; const GAS unsigned long long* y1 = (const GAS unsigned long long*)(p1 < YS_SPLIT ? YS + (size_t)p1 * D : YS2 + (size_t)(p1 - YS_SPLIT) * D) + F.lane;
        f32x4 v[4]; unsigned long long a0[4], a1[4];
#pragma unroll
        for (int j = 0; j < 4; ++j) { const unsigned long long w = xb[64 * j]; const unsigned lo = (unsigned)w, hi2 = (unsigned)(w >> 32); v[j] = (f32x4){pg8::bf_lo(lo), pg8::bf_hi(lo), pg8::bf_lo(hi2), pg8::bf_hi(hi2)}; a0[j] = y0[64 * j]; a1[j] = y1[64 * j]; }
        const unsigned t0[4] = {tm0.x, tm0.y, tm0.z, tm0.w}, t1[4] = {tm1.x, tm1.y, tm1.z, tm1.w};
#pragma unroll
        for (int j = 0; j < 4; ++j) { f32x4 y = {0.f, 0.f, 0.f, 0.f};
#pragma unroll
            for (int k = 0; k < 2; ++k) { const int p = k ? p1 : p0; const unsigned tm = k ? t1[j] : t0[j]; const unsigned long long aa = k ? a1[j] : a0[j];
                if (tm == 0u) { const unsigned lo = (unsigned)aa, hi = (unsigned)(aa >> 32); y.x += pg8::bf_lo(lo); y.y += pg8::bf_hi(lo); y.z += pg8::bf_lo(hi); y.w += pg8::bf_hi(hi); }
                else {
                    f32x4 a = {0.f, 0.f, 0.f, 0.f}; const float* sp = SLAB + (size_t)(tm - 1u) * S * 65536 + (size_t)(p & 255) * 256 + 4 * F.lane;
                    for (int q = 0; q < S; ++q) a += *(const f32x4*)(sp + (size_t)q * 65536);
                    y += a * GATE[p]; }
            }
            xr[64 * j] = v[j] + y; }
    }
}

__device__ __forceinline__ int wd_quota(int rem, int G) { if (rem == 0) return 0; const int q = (G - rem) * NWAVES * 7; return q < NE * IT_DN ? q : NE * IT_DN; }
constexpr int NPHASE = 19;
__global__ void __launch_bounds__(NWAVES * 64, 2) hymba_fwd(Args args_) {
    KA args = (KA)__builtin_amdgcn_kernarg_segment_ptr();
    (void)args_;
    extern __shared__ __attribute__((aligned(16))) unsigned char lds[];
    Frame F;
    F.lds = (LAS unsigned char*)lds; F.MISC = (volatile LAS unsigned*)(F.lds + MISC_OFF);
    F.tid = threadIdx.x; F.lane = F.tid & 63; F.wave = __builtin_amdgcn_readfirstlane(F.tid >> 6);
    F.G = gridDim.x; F.bx = blockIdx.x; { const int bx = blockIdx.x; F.vcu = (F.G % 8 == 0) ? (bx % 8) * (F.G / 8) + bx / 8 : bx; }
    F.ws = args->ws; F.out = args->out; F.ctl = (gu32*)(args->ws + WS_CTL);
    for (int u = F.tid; u < (LDS_BYTES - LDSCTL_OFF) / 4; u += NWAVES * 64) ((LAS unsigned*)(F.lds + LDSCTL_OFF))[u] = 0u;
    __syncthreads();
    const int lo = args->ph_lo, hi = args->ph_hi;
    XcdBarrier bar; bar.bar = (unsigned*)(F.ctl + CW_BAR); bar.x = 0; bar.st = nullptr;
    if (hi - lo > 1) bar = xcd_barrier_post((unsigned*)(F.ctl + CW_BAR), F.MISC + 8);
#ifndef PH_MASK
#define PH_MASK 0x7FFFF
#endif
#define IN(k) (((PH_MASK >> (k)) & 1) && lo <= (k) && (k) < hi)
#define SEAM(k) do { if ((k) + 1 < hi) xcd_barrier(bar); } while (0)
#ifndef PH_TWICE
#define PH_TWICE 0
#endif
#define REP(k) for (int rep_ = 0; rep_ < 1 + ((PH_TWICE >> (k)) & 1); ++rep_)
#define REPSEAM() do { if (rep_ == 0 && hi - lo > 1) xcd_barrier(bar); } while (0)
    unsigned char* ws = args->ws;
#define PH() do { asm volatile("" : "+s"(args)); GAS unsigned char* w_ = (GAS unsigned char*)args->ws; GAS float* o_ = (GAS float*)args->out; int t_ = threadIdx.x; int b_ = blockIdx.x, g_ = gridDim.x; asm volatile("" : "+s"(w_), "+s"(o_), "+v"(t_), "+s"(b_), "+s"(g_)); F.ws = (unsigned char*)w_; F.out = (float*)o_; F.tid = t_; F.lane = t_ & 63; F.bx = b_; F.G = g_; F.vcu = (g_ % 8 == 0) ? (b_ % 8) * (g_ / 8) + b_ / 8 : b_; ws = (unsigned char*)w_; } while (0)
#define XB_ ((bf16*)(ws + WS_XB))
#define QKVU_ ((bf16*)(ws + WS_QKVU))
#define MIX_ ((bf16*)(ws + WS_MIX))
#define YG_ ((bf16*)(ws + WS_YG))
#define SSQ_A_ ((float*)(ws + WS_SSQ_A))
#define SSQ_F_ ((float*)(ws + WS_SSQ_F))
#define SSQ_ATT_ ((float*)(ws + WS_SSQ_ATT))
#define SSQ_SSM_ ((float*)(ws + WS_SSQ_SSM))

    if (IN(0)) REP(0) {
        PH();
        { v4u* ebz = (v4u*)(ws + WS_EB); for (int i = F.bx * 512 + F.tid; i < 65536; i += F.G * 512) ebz[i] = (v4u){0u, 0u, 0u, 0u}; }
        p0_xb(F, args->in[0], F.bx, F.G);
        { LAS unsigned char* scr = F.lds + RING_OFF + F.wave * CONV_LDS; const int it = F.vcu * NWAVES + F.wave;
          if (it < IT_IN) conv_inproj(args->in[2], args->in[1], (bf16*)(ws + WS_WSMALL + WS_WIN), it, F.lane, scr); }
        SEAM(0);
    }
    if (IN(1) && lo <= 1 && 1 < hi) { PH(); if (F.bx >= 64 && F.bx < 64 + 2 * NG) ssm_precompute(F, args, (F.bx - 64) / NG, (F.bx - 64) % NG); }
    for (int l = 0; l < 2; ++l) {
        const int pb = l == 0 ? 1 : 8;
        if (IN(pb)) REP(pb) {
            PH(); unsigned char* wb = ws + WS_WSMALL + l * WSMALL_STRIDE;
            pg8::Gemm g{XB_, (const bf16*)(wb + WS_WIN), nullptr}; pg8::StaticOrder S; S.init(T, INW, F.G, F.bx);
            pg8::EpiInProj E{QKVU_, (bf16*)(ws + WS_UG), (LAS float*)(F.lds + TAB2_OFF), args->in[3] + l * HD, args->in[4] + l * HD, 0.125f * LOG2E};
            pg8::fill_rinv_tab(S, SSQ_A_, (LAS float*)(F.lds + TAB2_OFF), F.tid, TAB2_UNITS);
            pg8::gemm_phase<pg8::EpiInProj, pg8::StaticOrder, false, D>(F.lds + RING_OFF, g, S, E);
            if (l == 0 && F.bx >= 64 + 2 * NG) p0_convert(F, args, F.bx - 64 - 2 * NG, F.G - 64 - 2 * NG, IT_IN, IT_P0);
            bg_convert(F, args, l == 0 ? 0 : BG_B3, l == 0 ? BG_B1 : BG_B4, F.bx - (l == 0 ? 64 + 2 * NG : 64), F.G - (l == 0 ? 64 + 2 * NG : 64));
            SEAM(pb);
        }
        if (IN(pb + 1)) REP(pb + 1) { PH(); ssm_phase_v2(F, l); attn_phase_v1(F, args, l, 0, F.G); bg_convert(F, args, l == 0 ? BG_B1 : BG_B4, l == 0 ? BG_B2 : BG_B5, F.bx, F.G); SEAM(pb + 1); }
        if (IN(pb + 3)) REP(pb + 3) {
            PH(); unsigned char* wb = ws + WS_WSMALL + l * WSMALL_STRIDE;
            pg8::Gemm g{YG_, (const bf16*)(wb + WS_WGLU), nullptr}; pg8::StaticOrder S; S.init(T, SW, F.G, F.bx);
            pg8::EpiGlu E{YG_, MIX_, SSQ_SSM_};
            pg8::gemm_phase<pg8::EpiGlu, pg8::StaticOrder, false, SW>(F.lds + RING_OFF, g, S, E);
            bg_convert(F, args, l == 0 ? BG_B2 : BG_B5, l == 0 ? BG_B3 : BG_B6, F.bx - 128, F.G - 128);
            SEAM(pb + 3);
        }
        if (IN(pb + 4)) REP(pb + 4) {
            PH(); unsigned char* wb = ws + WS_WSMALL + l * WSMALL_STRIDE;
            pg8::Gemm g{MIX_, (const bf16*)(wb + WS_WO), nullptr}; pg8::StaticOrder S; S.init(T, D, F.G, F.bx);
            pg8::EpiRes<true, false> E{nullptr, XB_, SSQ_F_, SSQ_ATT_, SSQ_SSM_, (LAS float*)(F.lds + TAB_OFF)};
            pg8::gemm_phase<pg8::EpiRes<true, false>, pg8::StaticOrder, false, D>(F.lds + RING_OFF, g, S, E);
            SEAM(pb + 4);
        }
    if (l == 0) {
        if (IN(6)) REP(6) {
            PH();
            pg8::Gemm g{XB_, (const bf16*)(ws + WS_DGU), nullptr}; pg8::StaticOrder S; S.init(T, 2 * FF, F.G, F.bx);
            pg8::EpiSwiglu<false> E{(bf16*)(ws + WS_HD), nullptr, (LAS float*)(F.lds + TAB2_OFF)};
            pg8::fill_rinv_tab(S, SSQ_F_, (LAS float*)(F.lds + TAB2_OFF), F.tid, TAB2_UNITS);
            pg8::gemm_phase<pg8::EpiSwiglu<false>, pg8::StaticOrder, false, D>(F.lds + RING_OFF, g, S, E);
            SEAM(6);
        }
        if (IN(7)) REP(7) {
            PH();
            pg8::Gemm g{(const bf16*)(ws + WS_HD), (const bf16*)(ws + WS_DD), nullptr}; pg8::StaticOrder S; S.init(T, D, F.G, F.bx);
            pg8::EpiRes<false, false> E{nullptr, XB_, SSQ_A_, nullptr, nullptr, (LAS float*)(F.lds + TAB_OFF)};
            pg8::gemm_phase<pg8::EpiRes<false, false>, pg8::StaticOrder, false, FF>(F.lds + RING_OFF, g, S, E);
            SEAM(7);
        }
    } else {
        if (IN(13)) REP(13) { PH(); route1(F, args); SEAM(13); }
        if (IN(14)) REP(14) { PH(); route2(F); conv_run2<0>(F, args, BG_B6 + F.bx * NWAVES + F.wave, F.G * NWAVES, IT_BG); SEAM(14); }
        if (IN(15)) REP(15) {
            PH(); unsigned char* rt = ws + WS_ROUTE;
            pg8::Gemm g{XB_, (const bf16*)(ws + WS_MOEW), (const int*)(rt + RT_IDX)}; pg8::MoeOrder S; S.init((const int*)(rt + RT_PEND), 2 * FF, F.G, F.bx);
            pg8::EpiSwiglu<true> E{(bf16*)(ws + WS_HS), (const float*)(rt + RT_RINVS), nullptr};
            pg8::gemm_phase<pg8::EpiSwiglu<true>, pg8::MoeOrder, true, D>(F.lds + RING_OFF, g, S, E);
            { const int rem = S.nwg % F.G, q = wd_quota(rem, F.G);
              if (rem && F.bx >= rem) conv_run2<1>(F, args, (F.bx - rem) * NWAVES + F.wave, (F.G - rem) * NWAVES, q); }
            SEAM(15);
        }
        if (IN(16)) REP(16) { PH(); const int nwgu = ((const int*)(ws + WS_ROUTE + RT_PEND))[7] * (2 * FF / 256), q = wd_quota(nwgu % F.G, F.G);
            if (q < NE * IT_DN) { conv_run2<1>(F, args, q + F.vcu * NWAVES + F.wave, F.G * NWAVES, NE * IT_DN); SEAM(16); } }
        if (IN(17)) REP(17) {
            PH(); unsigned char* rt = ws + WS_ROUTE;
            pg8::Gemm g{(const bf16*)(ws + WS_HS), (const bf16*)(ws + WS_WDT), nullptr}; pg8::MoeOrderSplit<FF / 64> S; S.init((const int*)(rt + RT_PEND), D, F.G, F.bx, WDT_E7);
            pg8::EpiMoeDown E{(bf16*)(ws + WS_YS), (bf16*)(ws + WS_YS2), YS_SPLIT, (const float*)(rt + RT_GATE), (float*)(ws + WS_SLAB), (unsigned*)(ws + WS_CTL) + CW_TAILMAP, S.S};
            pg8::gemm_phase<pg8::EpiMoeDown, pg8::MoeOrderSplit<FF / 64>, false, FF>(F.lds + RING_OFF, g, S, E);
            SEAM(17);
        }
        if (IN(18)) REP(18) { PH(); moe_combine(F); }
    }
    }
#undef IN
#undef SEAM
}

extern "C" void kernel_launch(void* const* d_in, const int* in_sizes, int n_in, void* d_out, int out_size, void* d_ws, size_t ws_size, hipStream_t stream) {
    static int grid = 0;
    if (grid == 0) {
        if (n_in != 26 || in_sizes[0] != T * D || out_size != T * D || ws_size < WS_END) { fprintf(stderr, "kernel_launch: unexpected shapes/workspace (n_in %d, in0 %d, out %d, ws %zu, need %zu); nothing launched\n", n_in, n_in > 0 ? in_sizes[0] : -1, out_size, ws_size, (size_t)WS_END); grid = -1; return; }
        int dev = 0, cus = 0, per_cu = 0;
        if (hipGetDevice(&dev) != hipSuccess || hipDeviceGetAttribute(&cus, hipDeviceAttributeMultiprocessorCount, dev) != hipSuccess) { grid = -1; return; }
        if (hipFuncSetAttribute((const void*)hymba_fwd, hipFuncAttributeMaxDynamicSharedMemorySize, LDS_BYTES) != hipSuccess) { fprintf(stderr, "kernel_launch: hipFuncSetAttribute failed\n"); grid = -1; return; }
        if (hipOccupancyMaxActiveBlocksPerMultiprocessor(&per_cu, (const void*)hymba_fwd, NWAVES * 64, LDS_BYTES) != hipSuccess || per_cu < 1) { fprintf(stderr, "kernel_launch: occupancy query reports %d workgroups per CU\n", per_cu); (void)hipGetLastError(); grid = -1; return; }
        grid = cus;
    }
    if (grid < 0) return;
    (void)hipMemsetAsync((char*)d_ws + WS_CTL, 0, CTL_ZERO_BYTES, stream);
    Args a{};
    for (int i = 0; i < 26; ++i) a.in[i] = (const float*)d_in[i];
    a.out = (float*)d_out; a.ws = (unsigned char*)d_ws;
#if MK_N_LAUNCHES == 1
    a.ph_lo = 0; a.ph_hi = NPHASE;
    hipLaunchKernelGGL(hymba_fwd, dim3(grid), dim3(NWAVES * 64), LDS_BYTES, stream, a);
#else
    for (int p = 0; p < NPHASE; ++p) { a.ph_lo = p; a.ph_hi = p + 1; hipLaunchKernelGGL(hymba_fwd, dim3(grid), dim3(NWAVES * 64), LDS_BYTES, stream, a); }
#endif
}
```

```cpp
#include <hip/hip_runtime.h>
#include <cstdio>
#include <cstdint>

#ifndef MK_N_LAUNCHES
#define MK_N_LAUNCHES 1
#endif

constexpr int BATCH = 2, SEQ = 8192, T = BATCH * SEQ, D = 1024, INW = 1280, FF = 3584, NE = 8;
constexpr int NH = 8, NKV = 2, HD = 64, AW = 512, KVW = 128, SW = 512, NG = 32, GD = 16, NS = 64, WIN = 128;
constexpr int QOFF = 0, KOFF = 512, VOFF = 640, UOFF = 768;
constexpr float EPS = 1e-6f;
constexpr float LOG2E = 1.4426950408889634f;
constexpr int CAP = 2 * T + NE * 256;
constexpr int CN = 16;

namespace pg8 {
#define PG8_LAS __attribute__((address_space(3)))
typedef unsigned short bf16_t;
typedef short bf16x8 __attribute__((ext_vector_type(8)));
typedef float f32x4 __attribute__((ext_vector_type(4)));
typedef float f32x2 __attribute__((ext_vector_type(2)));
typedef unsigned u32x4 __attribute__((ext_vector_type(4)));
typedef unsigned u32x2 __attribute__((ext_vector_type(2)));
constexpr int BM = 256, BK = 64, HALF = 128, HTB = HALF * BK * 2, STAGE_BYTES = 8 * HTB, NXCD = 8, WGM = 8;

__host__ __device__ __forceinline__ int lds_byte(int r, int c) { const int st = (r >> 4) * 2 + (c >> 5), rr = r & 15, cc = c & 31, ob = rr * 64 + cc * 2; return st * 1024 + (ob ^ (((ob >> 9) & 1) << 5)); }
__host__ __device__ __forceinline__ void stage_rc(int b, int& R, int& C) { const int st = b / 1024, sb = b % 1024, swz = sb ^ (((sb >> 9) & 1) << 5); R = (st >> 1) * 16 + swz / 64; C = (st & 1) * 32 + (swz % 64) / 2; }
__host__ __device__ __forceinline__ int perm32(int rho) { const int n = rho >> 4, i = rho & 15; return 8 * (i >> 2) + 4 * n + (i & 3); }

struct Unit { int pm, pn, pb, k0, nk, sl; };
struct Gemm { const bf16_t* A; const bf16_t* Bt; const int* idx; };

struct StaticOrder {
    static constexpr bool KSPLIT = false;
    int nM, nN, nwg, G, c;
    __device__ __forceinline__ void init(int M, int N, int G_, int c_) { nM = M / BM; nN = N / BM; nwg = nM * nN; G = G_; c = c_; }
    __device__ __forceinline__ bool next(int i, Unit& u) const {
        const long L = (long)i * G + c; if (L >= nwg) return false;
        int wgid = (int)L; { const int q = nwg / NXCD, r = nwg % NXCD, xcd = wgid % NXCD, off = wgid / NXCD; wgid = (xcd < r ? xcd * (q + 1) : r * (q + 1) + (xcd - r) * q) + off; }
        const int nig = WGM * nN, gid = wgid / nig, fm = gid * WGM, gsz = (nM - fm) < WGM ? (nM - fm) : WGM;
        u.pm = fm + ((wgid % nig) % gsz); u.pn = (wgid % nig) / gsz; u.pb = u.pn; return true;
    }
};
struct MoeOrder {
    static constexpr bool KSPLIT = false;
    int nM, nN, nwg, G, c; int pend[8];
    __device__ __forceinline__ void init(const int* pendg, int N, int G_, int c_) {
#pragma unroll
        for (int e = 0; e < 8; ++e) pend[e] = __builtin_amdgcn_readfirstlane(pendg[e]);
        nM = pend[7]; nN = N / BM; nwg = nM * nN; G = G_; c = c_; }
    __device__ __forceinline__ bool next(int i, Unit& u) const {
        const long L = (long)i * G + c; if (L >= nwg) return false;
        int wgid = (int)L; { const int q = nwg / NXCD, r = nwg % NXCD, xcd = wgid % NXCD, off = wgid / NXCD; wgid = (xcd < r ? xcd * (q + 1) : r * (q + 1) + (xcd - r) * q) + off; }
        const int nig = WGM * nN, gid = wgid / nig, fm = gid * WGM, gsz = (nM - fm) < WGM ? (nM - fm) : WGM;
        u.pm = fm + ((wgid % nig) % gsz); u.pn = (wgid % nig) / gsz;
        int e = 0;
#pragma unroll
        for (int k = 0; k < 7; ++k) e += (pend[k] <= u.pm) ? 1 : 0;
        u.pb = e * nN + u.pn; return true;
    }
};

constexpr int KS_MAXSLAB = 144, KS_MAXS = 8;
__device__ __forceinline__ int ks_slices(int nwg, int G) { const int rem = nwg % G; if (rem == 0) return 1; int S = G / rem; S = S > KS_MAXS ? KS_MAXS : S; if (S * rem > KS_MAXSLAB) S = KS_MAXSLAB / rem; return S < 2 ? 1 : S; }
template <int NT> struct MoeOrderSplit {
    static constexpr bool KSPLIT = true;
    int nM, nN, nwg, G, c, nfull, S, e7tile; int pend[8];
    __device__ __forceinline__ void init(const int* pendg, int N, int G_, int c_, int e7tile_) { e7tile = e7tile_;
#pragma unroll
        for (int e = 0; e < 8; ++e) pend[e] = __builtin_amdgcn_readfirstlane(pendg[e]);
        nM = pend[7]; nN = N / BM; nwg = nM * nN; G = G_; c = c_; S = ks_slices(nwg, G); nfull = S > 1 ? (nwg / G) * G : nwg; }
    __device__ __forceinline__ bool next(int i, Unit& u) const {
        const long L = (long)i * G + c; int wgid, sl = -1, s = 0;
        if (L < nfull) wgid = (int)L; else { const int j = (int)(L - nfull); if (j >= (nwg - nfull) * S) return false; wgid = nfull + j / S; s = j % S; sl = j; }
        { const int q = nwg / NXCD, r = nwg % NXCD, xcd = wgid % NXCD, off = wgid / NXCD; wgid = (xcd < r ? xcd * (q + 1) : r * (q + 1) + (xcd - r) * q) + off; }
        const int nig = WGM * nN, gid = wgid / nig, fm = gid * WGM, gsz = (nM - fm) < WGM ? (nM - fm) : WGM;
        u.pm = fm + ((wgid % nig) % gsz); u.pn = (wgid % nig) / gsz;
        int e = 0;
#pragma unroll
        for (int k = 0; k < 7; ++k) e += (pend[k] <= u.pm) ? 1 : 0;
        u.pb = (e < 7 ? e * nN : e7tile) + u.pn; u.sl = sl;
        if (sl < 0) { u.k0 = 0; u.nk = NT; } else { const int p0 = (NT / 2) * s / S, p1 = (NT / 2) * (s + 1) / S; u.k0 = 2 * p0; u.nk = 2 * (p1 - p0); }
        return true;
    }
};

__device__ __forceinline__ unsigned cvt_pk_bf16(float lo, float hi) { unsigned r; asm volatile("v_cvt_pk_bf16_f32 %0, %1, %2" : "=v"(r) : "v"(lo), "v"(hi)); return r; }
__device__ __forceinline__ float bf_lo(unsigned w) { return __uint_as_float(w << 16); }
__device__ __forceinline__ float bf_hi(unsigned w) { return __uint_as_float(w & 0xffff0000u); }
__device__ __forceinline__ float sum4(const float* p) { const f32x4 v = *(const f32x4*)p; return (v[0] + v[1]) + (v[2] + v[3]); }
__device__ __forceinline__ float sum16(const float* p) { return (sum4(p) + sum4(p + 4)) + (sum4(p + 8) + sum4(p + 12)); }
__device__ __forceinline__ float sum8(const float* p) { return sum4(p) + sum4(p + 4); }

struct EpiInProj {
    static constexpr bool PERM = true, MID = false; static constexpr int MID_T = 0;
    bf16_t* O; bf16_t* UG; PG8_LAS float* tab; const float* gq; const float* gk; float qscale;
    struct State {};
    __device__ __forceinline__ void begin(const Unit&, int, int, State&) const {}
    __device__ __forceinline__ void mid(f32x4 (&)[2][2][4][2], const Unit&, int, int, int, int, int, State&) const {}
    __device__ __forceinline__ void operator()(const f32x4 (&acc)[2][2][4][2], const Unit& u, int ui, int wr, int wc, int fr, int fq, const State& est) const {
        const int row0 = u.pm * BM + wr * 64 + fr, tcol0 = u.pn * BM + 64 * wc;
        const int kind = tcol0 < KOFF ? 0 : (tcol0 < VOFF ? 1 : 2);
        f32x4 gv[2][2];
        if (kind < 2) { const float* g = kind == 0 ? gq : gk;
#pragma unroll
            for (int bj = 0; bj < 2; ++bj)
#pragma unroll
                for (int n = 0; n < 2; ++n) gv[bj][n] = *(const f32x4*)(g + 32 * bj + 8 * fq + 4 * n); }
#pragma unroll
        for (int ai = 0; ai < 2; ++ai) {
            float rinv4[4];
#pragma unroll
            for (int m = 0; m < 4; ++m) rinv4[m] = tab[ui * BM + wr * 64 + fr + ai * HALF + m * 16];
#pragma unroll
            for (int m = 0; m < 4; ++m) {
                const int row = row0 + ai * HALF + m * 16;
                const float rinv = rinv4[m];
                f32x4 v[2][2];
#pragma unroll
                for (int bj = 0; bj < 2; ++bj)
#pragma unroll
                    for (int n = 0; n < 2; ++n) v[bj][n] = acc[ai][bj][m][n] * rinv;
                if (kind < 2) {
                    float ss = 0.f;
#pragma unroll
                    for (int bj = 0; bj < 2; ++bj)
#pragma unroll
                        for (int n = 0; n < 2; ++n) { const f32x4 x = v[bj][n]; ss += (x[0] * x[0] + x[1] * x[1]) + (x[2] * x[2] + x[3] * x[3]); }
                    ss += __shfl_xor(ss, 16); ss += __shfl_xor(ss, 32);
                    const float hr = __builtin_amdgcn_rsqf(ss * (1.0f / HD) + EPS) * (kind == 0 ? qscale : 1.0f);
#pragma unroll
                    for (int bj = 0; bj < 2; ++bj)
#pragma unroll
                        for (int n = 0; n < 2; ++n) v[bj][n] = v[bj][n] * gv[bj][n] * hr;
                }
                bf16_t* rowp = O + (size_t)row * INW + tcol0 + 8 * fq;
#pragma unroll
                for (int bj = 0; bj < 2; ++bj) { u32x4 w; w.x = cvt_pk_bf16(v[bj][0][0], v[bj][0][1]); w.y = cvt_pk_bf16(v[bj][0][2], v[bj][0][3]); w.z = cvt_pk_bf16(v[bj][1][0], v[bj][1][1]); w.w = cvt_pk_bf16(v[bj][1][2], v[bj][1][3]);
                    if (tcol0 >= UOFF) { const int uc = tcol0 - UOFF + 32 * bj + 8 * fq;
                        *(u32x4*)(UG + ((size_t)(uc >> 4) * T + row) * GD + (uc & 15)) = w; }
                    else *(u32x4*)(rowp + 32 * bj) = w; }
            }
        }
    }
};
struct EpiGlu {
    static constexpr bool PERM = true, MID = false; static constexpr int MID_T = 0;
    const bf16_t* Y; bf16_t* MIX; float* ssq;
    struct State {};
    __device__ __forceinline__ void begin(const Unit&, int, int, State&) const {}
    __device__ __forceinline__ void mid(f32x4 (&)[2][2][4][2], const Unit&, int, int, int, int, int, State&) const {}
    __device__ __forceinline__ void operator()(const f32x4 (&acc)[2][2][4][2], const Unit& u, int ui, int wr, int wc, int fr, int fq, const State& est) const {
        const int row0 = u.pm * BM + wr * 64 + fr, col0 = u.pn * BM + wc * 32 + 8 * fq;
#pragma unroll
        for (int ai = 0; ai < 2; ++ai) {
            u32x4 yall[4][2];
#pragma unroll
            for (int m = 0; m < 4; ++m)
#pragma unroll
                for (int bj = 0; bj < 2; ++bj) yall[m][bj] = *(const u32x4*)(Y + (size_t)(row0 + ai * HALF + m * 16) * SW + col0 + bj * HALF);
#pragma unroll
            for (int m = 0; m < 4; ++m) {
                const int row = row0 + ai * HALF + m * 16; float ss = 0.f;
#pragma unroll
                for (int bj = 0; bj < 2; ++bj) {
                    const u32x4 yw = yall[m][bj];
                    const float y[8] = {bf_lo(yw.x), bf_hi(yw.x), bf_lo(yw.y), bf_hi(yw.y), bf_lo(yw.z), bf_hi(yw.z), bf_lo(yw.w), bf_hi(yw.w)};
                    float s[8];
#pragma unroll
                    for (int n = 0; n < 2; ++n)
#pragma unroll
                        for (int j = 0; j < 4; ++j) { const float g = acc[ai][bj][m][n][j]; const float o = y[4 * n + j] * __builtin_amdgcn_rcpf(1.0f + __builtin_amdgcn_exp2f(-LOG2E * g)); s[4 * n + j] = o; ss += o * o; }
                    u32x4 w; w.x = cvt_pk_bf16(s[0], s[1]); w.y = cvt_pk_bf16(s[2], s[3]); w.z = cvt_pk_bf16(s[4], s[5]); w.w = cvt_pk_bf16(s[6], s[7]);
                    *(u32x4*)(MIX + (size_t)row * D + AW + col0 + bj * HALF) = w;
                }
                ss += __shfl_xor(ss, 16); ss += __shfl_xor(ss, 32);
                if (fq == 0) ssq[(size_t)row * 8 + u.pn * 4 + wc] = ss;
            }
        }
    }
};
template <bool WO, bool RESF32> struct EpiRes {
    static constexpr bool PERM = true, MID = WO; static constexpr int MID_T = 8;
    const float* res; bf16_t* XB; float* ssq_out; const float* ssq_a; const float* ssq_s;
    PG8_LAS float* tab;
    struct State {};
    __device__ __forceinline__ void begin(const Unit& u, int ui, int tid, State&) const {
        if (WO) { if (tid < BM) { const int row = u.pm * BM + tid;
            const float ra = 1.0f / sqrtf(sum8(ssq_a + (size_t)row * 8) * (1.0f / AW) + EPS), rs = 1.0f / sqrtf(sum8(ssq_s + (size_t)row * 8) * (1.0f / SW) + EPS);
            *(PG8_LAS f32x2*)(tab + ((ui & 1) * BM + tid) * 2) = (f32x2){ra / rs, rs}; } }
    }
    __device__ __forceinline__ void mid(f32x4 (&acc)[2][2][4][2], const Unit& u, int ui, int wr, int wc, int fr, int fq, State&) const {
        const int r0 = wr * 64 + fr;
#pragma unroll
        for (int ai = 0; ai < 2; ++ai)
#pragma unroll
            for (int m = 0; m < 4; ++m) {
                const float f = tab[((ui & 1) * BM + r0 + ai * HALF + m * 16) * 2];
#pragma unroll
                for (int bj = 0; bj < 2; ++bj)
#pragma unroll
                    for (int n = 0; n < 2; ++n) acc[ai][bj][m][n] *= f;
            }
    }
    __device__ __forceinline__ void operator()(const f32x4 (&acc)[2][2][4][2], const Unit& u, int ui, int wr, int wc, int fr, int fq, const State& est) const {
        const int r0 = wr * 64 + fr, row0 = u.pm * BM + r0, col0 = u.pn * BM + wc * 32 + 8 * fq;
        constexpr int NB = RESF32 ? 2 : 4;
#pragma unroll
        for (int b0 = 0; b0 < 8; b0 += NB) {
            f32x4 rf[NB][2][2]; u32x4 rb[NB][2];
#pragma unroll
            for (int q = 0; q < NB; ++q) { const int ai = (b0 + q) >> 2, m = (b0 + q) & 3; const size_t off = (size_t)(row0 + ai * HALF + m * 16) * D + col0;
#pragma unroll
                for (int bj = 0; bj < 2; ++bj) { if (RESF32) { rf[q][bj][0] = *(const f32x4*)(res + off + bj * HALF); rf[q][bj][1] = *(const f32x4*)(res + off + bj * HALF + 4); } else rb[q][bj] = *(const u32x4*)(XB + off + bj * HALF); } }
#pragma unroll
            for (int q = 0; q < NB; ++q) { const int ai = (b0 + q) >> 2, m = (b0 + q) & 3, row = row0 + ai * HALF + m * 16; float ss = 0.f;
                float sc = 1.0f; if (WO) sc = tab[((ui & 1) * BM + r0 + ai * HALF + m * 16) * 2 + 1];
#pragma unroll
                for (int bj = 0; bj < 2; ++bj) {
                    f32x4 r0v, r1v;
                    if (RESF32) { r0v = rf[q][bj][0]; r1v = rf[q][bj][1]; }
                    else { const u32x4 w = rb[q][bj]; r0v = (f32x4){bf_lo(w.x), bf_hi(w.x), bf_lo(w.y), bf_hi(w.y)}; r1v = (f32x4){bf_lo(w.z), bf_hi(w.z), bf_lo(w.w), bf_hi(w.w)}; }
                    const f32x4 o0 = r0v + acc[ai][bj][m][0] * sc, o1 = r1v + acc[ai][bj][m][1] * sc;
                    u32x4 w; w.x = cvt_pk_bf16(o0[0], o0[1]); w.y = cvt_pk_bf16(o0[2], o0[3]); w.z = cvt_pk_bf16(o1[0], o1[1]); w.w = cvt_pk_bf16(o1[2], o1[3]);
                    *(u32x4*)(XB + (size_t)row * D + col0 + bj * HALF) = w;
                    ss += ((o0[0] * o0[0] + o0[1] * o0[1]) + (o0[2] * o0[2] + o0[3] * o0[3])) + ((o1[0] * o1[0] + o1[1] * o1[1]) + (o1[2] * o1[2] + o1[3] * o1[3]));
                }
                ss += __shfl_xor(ss, 16); ss += __shfl_xor(ss, 32);
                if (fq == 0) ssq_out[(size_t)row * 16 + u.pn * 4 + wc] = ss;
            }
        }
    }
};
template <bool MOE> struct EpiSwiglu {
    static constexpr bool PERM = true, MID = false; static constexpr int MID_T = 0;
    bf16_t* H; const float* rs;
    PG8_LAS float* tab;
    struct State { float r[MOE ? 8 : 1]; };
    __device__ __forceinline__ void begin(const Unit& u, int ui, int tid, State& st) const {
        if (MOE) { const int wid = tid >> 6, lane = tid & 63, row0 = u.pm * BM + (wid >> 2) * 64 + (lane & 15);
#pragma unroll
            for (int ai = 0; ai < 2; ++ai)
#pragma unroll
                for (int m = 0; m < 4; ++m) st.r[ai * 4 + m] = rs[row0 + ai * HALF + m * 16]; }
    }
    __device__ __forceinline__ void mid(f32x4 (&)[2][2][4][2], const Unit&, int, int, int, int, int, State&) const {}
    __device__ __forceinline__ void operator()(const f32x4 (&acc)[2][2][4][2], const Unit& u, int ui, int wr, int wc, int fr, int fq, const State& est) const {
        const int r0 = wr * 64 + fr, row0 = u.pm * BM + r0, hcol = u.pn * HALF + wc * 32 + 8 * fq;
#pragma unroll
        for (int ai = 0; ai < 2; ++ai)
#pragma unroll
            for (int m = 0; m < 4; ++m) {
                const int row = row0 + ai * HALF + m * 16;
                const float rinv = MOE ? est.r[MOE ? ai * 4 + m : 0] : tab[ui * BM + r0 + ai * HALF + m * 16];
                const float rneg = -LOG2E * rinv, ir2 = __builtin_amdgcn_rcpf(rinv * rinv);
                f32x4 hv[2];
#pragma unroll
                for (int n = 0; n < 2; ++n) {
                    const f32x4 ag = acc[ai][0][m][n], au = acc[ai][1][m][n];
                    const f32x4 t = ag * rneg;
                    f32x4 e; e[0] = __builtin_amdgcn_exp2f(t[0]); e[1] = __builtin_amdgcn_exp2f(t[1]); e[2] = __builtin_amdgcn_exp2f(t[2]); e[3] = __builtin_amdgcn_exp2f(t[3]);
                    const f32x4 d = e * ir2 + ir2;
                    f32x4 sg; sg[0] = __builtin_amdgcn_rcpf(d[0]); sg[1] = __builtin_amdgcn_rcpf(d[1]); sg[2] = __builtin_amdgcn_rcpf(d[2]); sg[3] = __builtin_amdgcn_rcpf(d[3]);
                    hv[n] = (ag * au) * sg;
                }
                u32x4 w; w.x = cvt_pk_bf16(hv[0][0], hv[0][1]); w.y = cvt_pk_bf16(hv[0][2], hv[0][3]); w.z = cvt_pk_bf16(hv[1][0], hv[1][1]); w.w = cvt_pk_bf16(hv[1][2], hv[1][3]);
                *(u32x4*)(H + (size_t)row * FF + hcol) = w;
            }
    }
};
template <class Sched> __device__ __forceinline__ void fill_rinv_tab(const Sched& S, const float* ssq, PG8_LAS float* tab, int tid, int maxu) {
    if (tid < BM) { Unit u;
        for (int i = 0; i < maxu && S.next(i, u); ++i) tab[i * BM + tid] = __builtin_amdgcn_rsqf(sum16(ssq + (size_t)(u.pm * BM + tid) * 16) * (1.0f / D) + EPS); }
    asm volatile("s_waitcnt lgkmcnt(0)\n\ts_barrier" ::: "memory");
}
struct EpiMoeDown {
    static constexpr bool PERM = true, MID = false; static constexpr int MID_T = 0;
    bf16_t* Ys; bf16_t* Ys2; int ysplit; const float* gate; float* slab; unsigned* tailmap; int S;
    struct State {};
    __device__ __forceinline__ void begin(const Unit&, int, int, State&) const {}
    __device__ __forceinline__ void mid(f32x4 (&)[2][2][4][2], const Unit&, int, int, int, int, int, State&) const {}
    __device__ __forceinline__ void operator()(const f32x4 (&acc)[2][2][4][2], const Unit& u, int ui, int wr, int wc, int fr, int fq, const State& est) const {
        if (u.sl >= 0) {
            float* sb = slab + (size_t)u.sl * (BM * BM) + (size_t)(wr * 64 + fr) * BM + wc * 32 + 8 * fq;
#pragma unroll
            for (int ai = 0; ai < 2; ++ai)
#pragma unroll
                for (int m = 0; m < 4; ++m)
#pragma unroll
                    for (int bj = 0; bj < 2; ++bj) { float* q = sb + (size_t)(ai * HALF + m * 16) * BM + bj * HALF; *(f32x4*)q = acc[ai][bj][m][0]; *(f32x4*)(q + 4) = acc[ai][bj][m][1]; }
            if (u.sl % S == 0 && wr == 0 && wc == 0 && fr == 0 && fq == 0) tailmap[u.pm * 4 + u.pn] = 1u + (unsigned)(u.sl / S);
            return;
        }
        const int row0 = u.pm * BM + wr * 64 + fr, col0 = u.pn * BM + wc * 32 + 8 * fq;
        bf16_t* ysb = u.pm * BM < ysplit ? Ys + (size_t)u.pm * BM * D : Ys2 + (size_t)(u.pm * BM - ysplit) * D;
        float g8[2][4];
#pragma unroll
        for (int ai = 0; ai < 2; ++ai)
#pragma unroll
            for (int m = 0; m < 4; ++m) g8[ai][m] = gate[row0 + ai * HALF + m * 16];
#pragma unroll
        for (int ai = 0; ai < 2; ++ai)
#pragma unroll
            for (int m = 0; m < 4; ++m) {
                const int row = row0 + ai * HALF + m * 16; const float g = g8[ai][m];
#pragma unroll
                for (int bj = 0; bj < 2; ++bj) { const f32x4 v0 = acc[ai][bj][m][0] * g, v1 = acc[ai][bj][m][1] * g;
                    u32x4 w; w.x = cvt_pk_bf16(v0[0], v0[1]); w.y = cvt_pk_bf16(v0[2], v0[3]); w.z = cvt_pk_bf16(v1[0], v1[1]); w.w = cvt_pk_bf16(v1[2], v1[3]);
                    *(u32x4*)(ysb + (size_t)(row - u.pm * BM) * D + col0 + bj * HALF) = w; }
            }
    }
};

template <class Epi, class Sched, bool GATHER, int K, bool ALIGN_EPI = true, bool SP2 = true>
__device__ __forceinline__ void gemm_phase(PG8_LAS unsigned char* lds, const Gemm g, const Sched& S, const Epi& E) {
    int tid_ = threadIdx.x; asm volatile("" : "+v"(tid_));
    const int tid = tid_, wid = __builtin_amdgcn_readfirstlane(tid >> 6), lane = tid & 63, wr = wid >> 2, wc = wid & 3, fr = lane & 15, fq = lane >> 4;
    constexpr int nt = K / BK;
    unsigned voffA[2], voffB[2]; int RA[2], CA[2];
#pragma unroll
    for (int i = 0; i < 2; ++i) { int R, C; stage_rc(tid * 16 + i * 8192, R, C); const int Rb = Epi::PERM ? ((R & ~31) + perm32(R & 31)) : R;
        RA[i] = R; CA[i] = C; voffA[i] = (unsigned)(R * K + C) * 2u; voffB[i] = (unsigned)(Rb * K + C) * 2u; }
    constexpr size_t kstep = (size_t)(BK * 2);
    constexpr size_t hstep = (size_t)HALF * K * 2;
    constexpr size_t tstep = 2 * hstep;
    const unsigned ldsw = (unsigned)wid * 1024u;
    const int aoff = lds_byte(wr * 64 + fr, fq * 8), boff = lds_byte(wc * 32 + fr, fq * 8);
#define PG8_SA(b, h) (((b) * 2 + (h)) * HTB)
#define PG8_SB(b, h) ((4 + (b) * 2 + (h)) * HTB)
    const char* const rsA = (const char*)g.A; const char* const rsB = (const char*)g.Bt;
#define PG8_STAGE_R(bufoff, rs, soff, voff) do { _Pragma("unroll") for (int _i = 0; _i < 2; ++_i) \
        __builtin_amdgcn_global_load_lds((const unsigned*)((rs) + (size_t)(unsigned)((voff)[_i] + (unsigned)(soff))), (PG8_LAS unsigned*)(lds + (bufoff) + ldsw + _i * 8192), 16, 0, 0); } while (0)
#define PG8_STAGE(bufoff, soff, voff) PG8_STAGE_R(bufoff, rsB, soff, voff)
#define PG8_STAGE_A(bufoff, soff, h, VG) do { if constexpr (GATHER) { PG8_STAGE_R(bufoff, rsA, soff, VG[h]); } else { PG8_STAGE_R(bufoff, rsA, (soff) + (unsigned)((h) * hstep), voffA); } } while (0)
#define PG8_LDA(dst, b, h) do { _Pragma("unroll") for (int m = 0; m < 4; ++m) _Pragma("unroll") for (int k = 0; k < 2; ++k) dst[m][k] = *(const PG8_LAS bf16x8*)(lds + PG8_SA(b, h) + aoff + m * 2048 + k * 1024); } while (0)
#define PG8_LDB(dst, b, h) do { _Pragma("unroll") for (int n = 0; n < 2; ++n) _Pragma("unroll") for (int k = 0; k < 2; ++k) dst[n][k] = *(const PG8_LAS bf16x8*)(lds + PG8_SB(b, h) + boff + n * 2048 + k * 1024); } while (0)
#define PG8_MMA(ai, bj, At, Bt) do { __builtin_amdgcn_s_setprio(1); _Pragma("unroll") for (int m = 0; m < 4; ++m) _Pragma("unroll") for (int n = 0; n < 2; ++n) _Pragma("unroll") for (int k = 0; k < 2; ++k) \
        acc[ai][bj][m][n] = __builtin_amdgcn_mfma_f32_16x16x32_bf16(Bt[n][k], At[m][k], acc[ai][bj][m][n], 0, 0, 0); __builtin_amdgcn_s_setprio(0); } while (0)
#define PG8_WAIT_V(n) asm volatile("s_waitcnt vmcnt(" #n ")" ::: "memory")
#define PG8_WAIT_L(n) asm volatile("s_waitcnt lgkmcnt(" #n ")" ::: "memory")
#define PG8_BAR __builtin_amdgcn_s_barrier()
#define PG8_SCHED __builtin_amdgcn_sched_barrier(0)
#define PG8_GOFF(dst, U) do { _Pragma("unroll") for (int _h = 0; _h < 2; ++_h) _Pragma("unroll") for (int _i = 0; _i < 2; ++_i) \
        dst[_h][_i] = ((unsigned)g.idx[(U).pm * BM + _h * HALF + RA[_i]] * (unsigned)K + (unsigned)CA[_i]) * 2u; } while (0)
    Unit cur, nxt; int ui = 0;
    if (!S.next(0, cur)) return;
    if constexpr (!Sched::KSPLIT) { cur.k0 = 0; cur.nk = nt; cur.sl = -1; }
    f32x4 acc[2][2][4][2];
#pragma unroll
    for (int a = 0; a < 2; ++a)
#pragma unroll
        for (int b = 0; b < 2; ++b)
#pragma unroll
            for (int m = 0; m < 4; ++m)
#pragma unroll
                for (int n = 0; n < 2; ++n) acc[a][b][m][n] = (f32x4){0.f, 0.f, 0.f, 0.f};
    bf16x8 At[4][2], B0[2][2], B1[2][2];
    unsigned vgc[2][2] = {{0u, 0u}, {0u, 0u}}, vgn[2][2] = {{0u, 0u}, {0u, 0u}};
    unsigned cA = (GATHER ? 0u : (unsigned)cur.pm * (unsigned)tstep) + (unsigned)cur.k0 * (unsigned)kstep, cB = (unsigned)cur.pb * (unsigned)tstep + (unsigned)cur.k0 * (unsigned)kstep;
    if constexpr (GATHER) PG8_GOFF(vgc, cur);
    typename Epi::State est;
    E.begin(cur, 0, tid, est);
    if constexpr (SP2) {
        PG8_STAGE(PG8_SB(0, 0), cB, voffB); PG8_STAGE(PG8_SB(0, 1), cB + hstep, voffB); PG8_STAGE_A(PG8_SA(0, 0), cA, 0, vgc); PG8_STAGE_A(PG8_SA(0, 1), cA, 1, vgc);
        if (wr == 1) PG8_BAR;
        PG8_WAIT_V(2); PG8_BAR;
        PG8_STAGE(PG8_SB(1, 0), cB + kstep, voffB); PG8_STAGE_A(PG8_SA(1, 0), cA + kstep, 0, vgc); PG8_STAGE(PG8_SB(1, 1), cB + hstep + kstep, voffB);
        PG8_WAIT_V(6); PG8_BAR;
    } else {
        PG8_STAGE(PG8_SB(0, 0), cB, voffB); PG8_STAGE_A(PG8_SA(0, 0), cA, 0, vgc); PG8_STAGE(PG8_SB(0, 1), cB + hstep, voffB); PG8_STAGE_A(PG8_SA(0, 1), cA, 1, vgc);
        if (wr == 1) PG8_BAR;
        PG8_WAIT_V(4); PG8_BAR;
        PG8_STAGE(PG8_SB(1, 0), cB + kstep, voffB); PG8_STAGE_A(PG8_SA(1, 0), cA + kstep, 0, vgc); PG8_STAGE(PG8_SB(1, 1), cB + hstep + kstep, voffB);
        PG8_WAIT_V(6); PG8_BAR;
    }
    for (;;) {
        const bool has_next = S.next(ui + 1, nxt);
        if constexpr (!Sched::KSPLIT) { nxt.k0 = 0; nxt.nk = nt; nxt.sl = -1; }
        const unsigned nA = has_next ? (GATHER ? 0u : (unsigned)nxt.pm * (unsigned)tstep) + (unsigned)nxt.k0 * (unsigned)kstep : cA, nB = has_next ? (unsigned)nxt.pb * (unsigned)tstep + (unsigned)nxt.k0 * (unsigned)kstep : cB;
        if constexpr (GATHER) { if (has_next) PG8_GOFF(vgn, nxt); else {
#pragma unroll
            for (int h = 0; h < 2; ++h)
#pragma unroll
                for (int i = 0; i < 2; ++i) vgn[h][i] = vgc[h][i]; } }
        const int nk = cur.nk;
        for (int t = 0; t < nk; t += 2) {
            const bool last = (t == nk - 2);
            if constexpr (Epi::MID) { if (t == Epi::MID_T) E.mid(acc, cur, ui, wr, wc, fr, fq, est); }
            const unsigned a1 = cA + (unsigned)(t + 1) * (unsigned)kstep;
            const unsigned a2 = last ? nA : cA + (unsigned)(t + 2) * (unsigned)kstep, b2 = last ? nB : cB + (unsigned)(t + 2) * (unsigned)kstep;
            const unsigned a3 = a2 + (unsigned)kstep, b3 = b2 + (unsigned)kstep;
            unsigned vgs[2][2];
#pragma unroll
            for (int h = 0; h < 2; ++h)
#pragma unroll
                for (int i = 0; i < 2; ++i) vgs[h][i] = last ? vgn[h][i] : vgc[h][i];
            if constexpr (SP2) {
            PG8_LDB(B0, 0, 0); PG8_LDB(B1, 0, 1); PG8_SCHED; PG8_LDA(At, 0, 0); PG8_STAGE_A(PG8_SA(1, 1), a1, 1, vgc);
            PG8_WAIT_V(8); PG8_WAIT_L(0); PG8_BAR; PG8_MMA(0, 0, At, B0); PG8_MMA(0, 1, At, B1); PG8_BAR; PG8_SCHED;
            PG8_LDA(At, 0, 1); PG8_STAGE(PG8_SB(0, 0), b2, voffB); PG8_STAGE(PG8_SB(0, 1), b2 + hstep, voffB); PG8_STAGE_A(PG8_SA(0, 0), a2, 0, vgs);
            PG8_WAIT_V(8); PG8_WAIT_L(0); PG8_BAR; PG8_MMA(1, 0, At, B0); PG8_MMA(1, 1, At, B1); PG8_BAR; PG8_SCHED;
            PG8_LDB(B0, 1, 0); PG8_LDB(B1, 1, 1); PG8_SCHED; PG8_LDA(At, 1, 0); PG8_STAGE_A(PG8_SA(0, 1), a2, 1, vgs);
            PG8_WAIT_V(8); PG8_WAIT_L(0); PG8_BAR; PG8_MMA(0, 0, At, B0); PG8_MMA(0, 1, At, B1); PG8_BAR; PG8_SCHED;
            PG8_LDA(At, 1, 1); PG8_STAGE(PG8_SB(1, 0), b3, voffB); PG8_STAGE(PG8_SB(1, 1), b3 + hstep, voffB); PG8_STAGE_A(PG8_SA(1, 0), a3, 0, vgs);
            PG8_WAIT_V(8); PG8_WAIT_L(0); PG8_BAR; PG8_MMA(1, 0, At, B0); PG8_MMA(1, 1, At, B1); PG8_BAR; PG8_SCHED;
            } else {
            PG8_LDB(B0, 0, 0); PG8_SCHED; PG8_LDA(At, 0, 0); PG8_STAGE_A(PG8_SA(1, 1), a1, 1, vgc);
            PG8_WAIT_L(8); PG8_BAR; PG8_WAIT_L(0); PG8_MMA(0, 0, At, B0); PG8_BAR; PG8_SCHED;
            PG8_LDB(B1, 0, 1); PG8_STAGE(PG8_SB(0, 0), b2, voffB);
            PG8_BAR; PG8_WAIT_L(0); PG8_MMA(0, 1, At, B1); PG8_BAR;
            PG8_LDA(At, 0, 1); PG8_STAGE_A(PG8_SA(0, 0), a2, 0, vgs);
            PG8_BAR; PG8_WAIT_L(0); PG8_MMA(1, 0, At, B0); PG8_BAR; PG8_SCHED;
            PG8_STAGE(PG8_SB(0, 1), b2 + hstep, voffB);
            PG8_WAIT_V(6); PG8_BAR; PG8_MMA(1, 1, At, B1); PG8_BAR;
            PG8_LDB(B0, 1, 0); PG8_SCHED; PG8_LDA(At, 1, 0); PG8_STAGE_A(PG8_SA(0, 1), a2, 1, vgs);
            PG8_WAIT_L(8); PG8_BAR; PG8_WAIT_L(0); PG8_MMA(0, 0, At, B0); PG8_BAR; PG8_SCHED;
            PG8_LDB(B1, 1, 1); PG8_STAGE(PG8_SB(1, 0), b3, voffB);
            PG8_BAR; PG8_WAIT_L(0); PG8_MMA(0, 1, At, B1); PG8_BAR;
            PG8_LDA(At, 1, 1); PG8_STAGE_A(PG8_SA(1, 0), a3, 0, vgs);
            PG8_BAR; PG8_WAIT_L(0); PG8_MMA(1, 0, At, B0); PG8_BAR; PG8_SCHED;
            PG8_STAGE(PG8_SB(1, 1), b3 + hstep, voffB);
            PG8_WAIT_V(6); PG8_BAR; PG8_MMA(1, 1, At, B1); PG8_BAR;
            }
        }
        if constexpr (ALIGN_EPI) { if (wr == 0) PG8_BAR; }
        E(acc, cur, ui, wr, wc, fr, fq, est);
        if (!has_next) break;
#pragma unroll
        for (int a = 0; a < 2; ++a)
#pragma unroll
            for (int b = 0; b < 2; ++b)
#pragma unroll
                for (int m = 0; m < 4; ++m)
#pragma unroll
                    for (int n = 0; n < 2; ++n) acc[a][b][m][n] = (f32x4){0.f, 0.f, 0.f, 0.f};
        cur = nxt; cA = nA; cB = nB; ++ui;
        E.begin(cur, ui, tid, est);
#pragma unroll
        for (int h = 0; h < 2; ++h)
#pragma unroll
            for (int i = 0; i < 2; ++i) vgc[h][i] = vgn[h][i];
        if constexpr (ALIGN_EPI) { if (wr == 1) PG8_BAR; }
    }
    PG8_WAIT_V(0);
    if constexpr (!ALIGN_EPI) { if (wr == 0) PG8_BAR; }
    PG8_BAR;
#undef PG8_SA
#undef PG8_SB
#undef PG8_STAGE
#undef PG8_STAGE_A
#undef PG8_LDA
#undef PG8_LDB
#undef PG8_MMA
#undef PG8_WAIT_V
#undef PG8_WAIT_L
#undef PG8_BAR
#undef PG8_SCHED
#undef PG8_GOFF
}
}

constexpr size_t MiB = 1u << 20;
constexpr size_t WS_CTL = 0, CTL_ZERO_BYTES = 128 * 1024;
constexpr size_t WS_SSQ_A = 1 * MiB, WS_SSQ_F = 2 * MiB, WS_SSQ_ATT = 3 * MiB, WS_SSQ_SSM = 3 * MiB + 512 * 1024;
constexpr size_t WS_ROUTE = 4 * MiB;
constexpr size_t RT_IDX = 0, RT_GATE = 160 * 1024, RT_RINVS = 320 * 1024, RT_POS = 480 * 1024, RT_TOPE = 608 * 1024, RT_TOPG = 736 * 1024, RT_RINVT = 864 * 1024, RT_HIST = 928 * 1024, RT_PEND = 944 * 1024;
constexpr size_t WS_SSMPRE = 6 * MiB, SSMPRE_STRIDE = 9 * MiB;
constexpr size_t WS_WSMALL = 24 * MiB, WSMALL_STRIDE = 5 * MiB, WS_WIN = 0, WS_WGLU = 5 * MiB / 2, WS_WO = 3 * MiB;
constexpr size_t WS_DGU = 34 * MiB, WS_DD = 48 * MiB;
constexpr size_t WS_MOEW = 56 * MiB, WS_XB = 168 * MiB, WS_YS = 56 * MiB, WS_YS2 = WS_YS + (size_t)28672 * 1024 * 2;
constexpr int YS_SPLIT = 28672;
constexpr size_t WS_RA = 200 * MiB, WS_QKVU = WS_RA, WS_MIX = 240 * MiB, WS_YG = 272 * MiB, WS_HD = 288 * MiB, WS_HS = WS_RA;
constexpr size_t WS_UG = WS_HD;
constexpr size_t WS_END = 446 * MiB;
static_assert(WS_YS2 + (size_t)(CAP - YS_SPLIT) * D * 2 <= 124 * MiB && WS_HS + (size_t)CAP * FF * 2 <= WS_END && WS_HD + (size_t)T * FF * 2 <= WS_END, "ws map");
constexpr int CW_BAR = 4096, CW_TAILMAP = 16384;
constexpr size_t WS_SLAB = 124 * MiB;
static_assert(WS_SLAB + (size_t)pg8::KS_MAXSLAB * 256 * 256 * 4 <= 168 * MiB, "slabs");
constexpr size_t WS_WDT = 6 * MiB, WDT_TILEB = (size_t)256 * FF * 2;
constexpr int WDT_E7 = 247;
static_assert(WS_WDT + 7 * 4 * WDT_TILEB <= 55 * MiB && WS_WDT + WDT_E7 * WDT_TILEB >= 438 * MiB, "MoE down weight copies");

constexpr int RING_OFF = 0, RING_BYTES = 131072;
constexpr int LDSCTL_OFF = RING_BYTES, MISC_OFF = LDSCTL_OFF + 320;
constexpr int TAB_OFF = MISC_OFF + 192;
constexpr int LDS_BYTES = 147456;
constexpr int TAB2_OFF = TAB_OFF + 4096, TAB2_UNITS = 11;
static_assert(TAB_OFF % 16 == 0 && TAB2_OFF + TAB2_UNITS * 1024 <= LDS_BYTES, "LDS map");
constexpr int NWAVES = 8;

#define GAS __attribute__((address_space(1)))
#define LAS __attribute__((address_space(3)))
typedef unsigned short bf16;
typedef unsigned v4u __attribute__((ext_vector_type(4)));
typedef float f32x4 __attribute__((ext_vector_type(4)));
typedef GAS unsigned gu32;
#define RLX_AGENT __ATOMIC_RELAXED, __HIP_MEMORY_SCOPE_AGENT
#define LDS_WAIT() asm volatile("s_waitcnt lgkmcnt(0)" ::: "memory")
#define VM_WAIT() asm volatile("s_waitcnt vmcnt(0)" ::: "memory")
__device__ __forceinline__ unsigned f2bf(float f) { unsigned u = __builtin_bit_cast(unsigned, f); return (u + 0x7fffu + ((u >> 16) & 1u)) >> 16; }
__device__ __forceinline__ unsigned pk2(float lo, float hi) { return f2bf(lo) | (f2bf(hi) << 16); }
__device__ __forceinline__ float bf2f(bf16 v) { return __uint_as_float((unsigned)v << 16); }

#define XB_TMO      128
#define XB_XCNT(j)  (256  + 64 * (j))
#define XB_XSUB(j)  (1280 + 64 * (j))
#define XB_XGEN(j)  (2304 + 64 * (j))
#define XB_TOP      3328
#define XB_TOPGEN   3392
#define XCD_BAR_WORDS 3456
#define XB_SPIN_CAP (1u << 22)
__device__ __forceinline__ unsigned xb_ld(unsigned* p)              { return __hip_atomic_load(p, __ATOMIC_RELAXED, __HIP_MEMORY_SCOPE_AGENT); }
__device__ __forceinline__ unsigned xb_add(unsigned* p, unsigned v) { return __hip_atomic_fetch_add(p, v, __ATOMIC_RELAXED, __HIP_MEMORY_SCOPE_AGENT); }
__device__ __forceinline__ unsigned xb_xcc_id() { return (unsigned)__builtin_amdgcn_s_getreg((3 << 11) | 20) & 0xFu; }
#define XB_SPIN(cond, bar) do { unsigned _sp = 0; while (cond) { __builtin_amdgcn_s_sleep(1); \
    if ((++_sp & 255u) == 0u) { if (xb_ld(&(bar)[XB_TMO])) break; if (_sp > XB_SPIN_CAP) { atomicAdd(&(bar)[XB_TMO], 1u); break; } } } } while (0)
struct XcdBarrier { unsigned* bar; unsigned x; volatile LAS unsigned* st; };
__device__ __forceinline__ XcdBarrier xcd_barrier_post(unsigned* bar, volatile LAS unsigned* st) {
    XcdBarrier b; b.bar = bar; b.x = xb_xcc_id(); b.st = st;
    if (threadIdx.x == 0) (void)xb_add(&bar[XB_XCNT(b.x)], 1u);
    return b;
}
__device__ __forceinline__ void xcd_barrier_complete(unsigned* bar, unsigned x, unsigned& nloc, unsigned& nx) {
    const unsigned G = gridDim.x * gridDim.y * gridDim.z;
    unsigned sum, cnt, mine, sp = 0u;
    for (;;) {
        sum = 0u; cnt = 0u; mine = 0u;
#pragma unroll
        for (unsigned j = 0; j < 16; ++j) { const unsigned c = xb_ld(&bar[XB_XCNT(j)]); sum += c; cnt += (c > 0u) ? 1u : 0u; mine = (j == x) ? c : mine; }
        if (sum == G) break;
        __builtin_amdgcn_s_sleep(1);
        if ((++sp & 255u) == 0u) { if (xb_ld(&bar[XB_TMO])) break; if (sp > XB_SPIN_CAP) { atomicAdd(&bar[XB_TMO], 1u); break; } }
    }
    nloc = mine > 0u ? mine : 1u; nx = cnt > 0u ? cnt : 1u;
}
__device__ __forceinline__ void xcd_barrier(const XcdBarrier& b) {
    asm volatile("s_waitcnt vmcnt(0)" ::: "memory");
    __syncthreads();
    if (threadIdx.x == 0) {
        unsigned* bar = b.bar;
        __builtin_amdgcn_s_waitcnt(0);
        unsigned nloc = b.st[0], nx = b.st[1];
        if (nloc == 0u) { xcd_barrier_complete(bar, b.x, nloc, nx); b.st[0] = nloc; b.st[1] = nx; }
        const unsigned old = xb_add(&bar[XB_XSUB(b.x)], 1u);
        const unsigned gen = old / nloc;
        if (old + 1u == (gen + 1u) * nloc) {
            __builtin_amdgcn_fence(__ATOMIC_RELEASE, "agent");
            asm volatile("s_waitcnt vmcnt(0)" ::: "memory");
            const unsigned og = xb_add(&bar[XB_TOP], 1u);
            const unsigned tg = og / nx;
            if (og + 1u == (tg + 1u) * nx) xb_add(&bar[XB_TOPGEN], 1u);
            else XB_SPIN(xb_ld(&bar[XB_TOPGEN]) == tg, bar);
            __builtin_amdgcn_fence(__ATOMIC_ACQUIRE, "agent");
            xb_add(&bar[XB_XGEN(b.x)], 1u);
            asm volatile("s_waitcnt vmcnt(0)" ::: "memory");
        } else {
            XB_SPIN(xb_ld(&bar[XB_XGEN(b.x)]) == gen, bar);
            __builtin_amdgcn_fence(__ATOMIC_ACQUIRE, "agent");
            asm volatile("s_waitcnt vmcnt(0)" ::: "memory");
        }
    }
    __syncthreads();
}

struct Args { const float* in[26]; float* out; unsigned char* ws; int ph_lo, ph_hi; };
typedef __attribute__((address_space(4))) const Args* KA;
struct Frame {
    LAS unsigned char* lds; volatile LAS unsigned* MISC; gu32* ctl;
    int tid, lane, wave, vcu, G, bx;
    unsigned char* ws; float* out;
};
__device__ __forceinline__ float wave_sum(float v) {
#pragma unroll
    for (int o = 1; o < 64; o <<= 1) v += __shfl_xor(v, o);
    return v;
}
__device__ __forceinline__ float wave_max(float v) {
#pragma unroll
    for (int o = 1; o < 64; o <<= 1) v = fmaxf(v, __shfl_xor(v, o));
    return v;
}

constexpr int CKB = 64;
constexpr int CONV_LDS = 64 * 144;
__device__ __forceinline__ void conv_item(const float* srcl, int ldn, int k0, const float* ks, bf16* dst0  , int K, LAS unsigned char* scr, int lane) {
    float v[CKB];
    { const float* q = srcl + (size_t)k0 * ldn;
#pragma unroll
      for (int i = 0; i < CKB; ++i) { if ((i & 7) == 0) asm volatile("" : "+v"(q)); v[i] = __builtin_nontemporal_load(q + (size_t)(i & 7) * ldn); if ((i & 7) == 7) q += (size_t)8 * ldn; } }
    if (ks) {
#pragma unroll
        for (int i = 0; i < CKB; ++i) v[i] *= ks[k0 + i]; }
#pragma unroll
    for (int j = 0; j < CKB / 8; ++j) { v4u o; o.x = pg8::cvt_pk_bf16(v[8 * j], v[8 * j + 1]); o.y = pg8::cvt_pk_bf16(v[8 * j + 2], v[8 * j + 3]); o.z = pg8::cvt_pk_bf16(v[8 * j + 4], v[8 * j + 5]); o.w = pg8::cvt_pk_bf16(v[8 * j + 6], v[8 * j + 7]);
        *(LAS v4u*)(scr + lane * 144 + j * 16) = o; }
    asm volatile("s_waitcnt lgkmcnt(0)" ::: "memory");
#pragma unroll
    for (int i = 0; i < 8; ++i) { const int row = 8 * i + (lane >> 3), ch = lane & 7; const v4u o = *(const LAS v4u*)(scr + row * 144 + ch * 16);
        *(GAS v4u*)(dst0 + (size_t)row * K + ch * 8) = o; }
    asm volatile("s_waitcnt lgkmcnt(0)" ::: "memory");
}
__device__ __forceinline__ void conv_plain(const float* W, int K, int N, const float* ks_lo, const float* ks_hi, bf16* WT, int item, int lane, LAS unsigned char* scr) {
    const int nblk = N / 64, kb = item / nblk, nb = item % nblk, k0 = CKB * kb;
    const float* ks = ks_lo ? (k0 < 512 || !ks_hi ? ks_lo : ks_hi - 512) : nullptr;
    conv_item(W + 64 * nb + lane, N, k0, ks, WT + (size_t)(64 * nb) * K + k0, K, scr, lane);
}
__device__ __forceinline__ void conv_inproj(const float* W, const float* ks, bf16* WT, int item, int lane, LAS unsigned char* scr) {
    const int nblk = INW / 64, kb = item / nblk, db = item % nblk, drow = 64 * db + lane, pn = drow >> 8, bj = (drow >> 7) & 1, wc = (drow >> 5) & 3, i = drow & 31;
    conv_item(W + 256 * pn + 64 * wc + 32 * bj + i, INW, CKB * kb, ks, WT + (size_t)(64 * db) * D + CKB * kb, D, scr, lane);
}
__device__ __forceinline__ void conv_gu(const float* Wg, const float* Wu, const float* ks, bf16* WT, int item, int lane, LAS unsigned char* scr) {
    const int nblk = 2 * FF / 64, kb = item / nblk, db = item % nblk, drow = 64 * db + lane, pn = drow >> 8, bj = (drow >> 7) & 1, r = drow & 127;
    conv_item((bj ? Wu : Wg) + 128 * pn + r, FF, CKB * kb, ks, WT + (size_t)(64 * db) * D + CKB * kb, D, scr, lane);
}

constexpr int IT_IN = (D / CKB) * (INW / 64), IT_GLU = (SW / CKB) * (SW / 64), IT_WO = (D / CKB) * (D / 64), IT_L = IT_IN + IT_GLU + IT_WO;
constexpr int IT_GU = (D / CKB) * (2 * FF / 64), IT_DN = (FF / CKB) * (D / 64);
constexpr int IT_P0 = 2 * IT_L;
constexpr int IT_BG = IT_GU + IT_DN + NE * IT_GU;
#ifndef BGQ
#define BGQ 2000, 0, 2900, 3000, 0, 2900
#endif
constexpr int BG_Q[6] = {BGQ};
constexpr int BG_B1 = BG_Q[0], BG_B2 = BG_B1 + BG_Q[1], BG_B3 = BG_B2 + BG_Q[2], BG_B4 = BG_B3 + BG_Q[3], BG_B5 = BG_B4 + BG_Q[4], BG_B6 = BG_B5 + BG_Q[5];
static_assert(BG_B3 >= IT_GU + IT_DN && BG_B6 <= IT_BG, "dense FFN weights are needed right after slot 3");

__device__ __forceinline__ void p0_convert(Frame& F, KA a, int rank, int nranks, int lo, int hi) {
    LAS unsigned char* scr = F.lds + RING_OFF + F.wave * CONV_LDS;
    const int gw = rank * NWAVES + F.wave, NGW = nranks * NWAVES;
    for (int it = lo + gw; it < hi; it += NGW) {
        const int l = it / IT_L; int r = it - l * IT_L; unsigned char* wb = F.ws + WS_WSMALL + l * WSMALL_STRIDE;
        if (r < IT_IN) { conv_inproj(a->in[2] + (size_t)l * D * INW, a->in[1] + l * D, (bf16*)(wb + WS_WIN), r, F.lane, scr); continue; } r -= IT_IN;
        if (r < IT_GLU) { conv_plain(a->in[14] + (size_t)l * SW * SW, SW, SW, nullptr, nullptr, (bf16*)(wb + WS_WGLU), r, F.lane, scr); continue; } r -= IT_GLU;
        conv_plain(a->in[17] + (size_t)l * D * D, D, D, a->in[15] + l * AW, a->in[16] + l * SW, (bf16*)(wb + WS_WO), r, F.lane, scr);
    }
}
__device__ __forceinline__ void bg_convert(Frame& F, KA a, int lo, int hi, int rank, int nranks) {
    if (rank < 0) return;
    LAS unsigned char* scr = F.lds + RING_OFF + F.wave * CONV_LDS;
    for (int it = lo + rank * NWAVES + F.wave; it < hi; it += nranks * NWAVES) {
        int r = it;
        if (r < IT_GU) { conv_gu(a->in[19], a->in[20], a->in[18], (bf16*)(F.ws + WS_DGU), r, F.lane, scr); continue; } r -= IT_GU;
        if (r < IT_DN) { conv_plain(a->in[21], FF, D, nullptr, nullptr, (bf16*)(F.ws + WS_DD), r, F.lane, scr); continue; } r -= IT_DN;
        { const int e = r / IT_GU; r -= e * IT_GU;
          conv_gu(a->in[23] + (size_t)e * D * FF, a->in[24] + (size_t)e * D * FF, a->in[18] + D, (bf16*)(F.ws + WS_MOEW) + (size_t)e * 2 * FF * D, r, F.lane, scr); }
    }
}
__device__ __forceinline__ void moe_wd_convert(Frame& F, KA a) {
    LAS unsigned char* scr = F.lds + RING_OFF + F.wave * CONV_LDS;
    const int gw = F.vcu * NWAVES + F.wave, NGW = F.G * NWAVES;
    for (int it = gw; it < NE * IT_DN; it += NGW) { const int e = it / IT_DN, r = it % IT_DN;
        conv_plain(a->in[25] + (size_t)e * FF * D, FF, D, nullptr, nullptr, (bf16*)(F.ws + WS_WDT + (size_t)(e < 7 ? 4 * e : WDT_E7) * WDT_TILEB), r, F.lane, scr); }
}
__device__ __forceinline__ void conv_load2(const float* srcl, int ldn, int k0, float (&v)[CKB]) {
    const float* q = srcl + (size_t)k0 * ldn;
#pragma unroll
    for (int i = 0; i < CKB; ++i) { if ((i & 7) == 0) asm volatile("" : "+v"(q)); v[i] = __builtin_nontemporal_load(q + (size_t)(i & 7) * ldn); if ((i & 7) == 7) q += (size_t)8 * ldn; }
}
__device__ __forceinline__ void conv_store2(float (&v)[CKB], const float* ks, int k0, bf16* dst0, int K, LAS unsigned char* scr, int lane) {
    if (ks) {
#pragma unroll
        for (int i = 0; i < CKB; ++i) v[i] *= ks[k0 + i]; }
#pragma unroll
    for (int j = 0; j < CKB / 8; ++j) { v4u o; o.x = pg8::cvt_pk_bf16(v[8 * j], v[8 * j + 1]); o.y = pg8::cvt_pk_bf16(v[8 * j + 2], v[8 * j + 3]); o.z = pg8::cvt_pk_bf16(v[8 * j + 4], v[8 * j + 5]); o.w = pg8::cvt_pk_bf16(v[8 * j + 6], v[8 * j + 7]);
        *(LAS v4u*)(scr + lane * 144 + j * 16) = o; }
    asm volatile("s_waitcnt lgkmcnt(0)" ::: "memory");
#pragma unroll
    for (int i = 0; i < 8; ++i) { const int row = 8 * i + (lane >> 3), ch = lane & 7; const v4u o = *(const LAS v4u*)(scr + row * 144 + ch * 16);
        *(GAS v4u*)(dst0 + (size_t)row * K + ch * 8) = o; }
    asm volatile("s_waitcnt lgkmcnt(0)" ::: "memory");
}
struct CvI { const float* srcl; const float* ks; bf16* dst0; int ldn, k0, K; };
__device__ __forceinline__ CvI cvi_gu(const float* Wg, const float* Wu, const float* ks, bf16* WT, int item, int lane) {
    const int nblk = 2 * FF / 64, kb = item / nblk, db = item % nblk, drow = 64 * db + lane, pn = drow >> 8, bj = (drow >> 7) & 1, r = drow & 127;
    return CvI{(bj ? Wu : Wg) + 128 * pn + r, ks, WT + (size_t)(64 * db) * D + CKB * kb, FF, CKB * kb, D};
}
__device__ __forceinline__ CvI cvi_plain(const float* W, int K, int N, bf16* WT, int item, int lane) {
    const int nblk = N / 64, kb = item / nblk, nb = item % nblk, k0 = CKB * kb;
    return CvI{W + 64 * nb + lane, nullptr, WT + (size_t)(64 * nb) * K + k0, N, k0, K};
}
template <int WHICH> __device__ __forceinline__ void conv_run2(Frame& F, KA a, int first, int step, int hi) {
    LAS unsigned char* scr = F.lds + RING_OFF + F.wave * CONV_LDS;
    auto dec = [&](int it) {
        if (WHICH == 1) { const int e = it / IT_DN, r = it % IT_DN; return cvi_plain(a->in[25] + (size_t)e * FF * D, FF, D, (bf16*)(F.ws + WS_WDT + (size_t)(e < 7 ? 4 * e : WDT_E7) * WDT_TILEB), r, F.lane); }
        int r = it;
        if (r < IT_GU) return cvi_gu(a->in[19], a->in[20], a->in[18], (bf16*)(F.ws + WS_DGU), r, F.lane);
        r -= IT_GU;
        if (r < IT_DN) return cvi_plain(a->in[21], FF, D, (bf16*)(F.ws + WS_DD), r, F.lane);
        r -= IT_DN;
        const int e = r / IT_GU; r -= e * IT_GU;
        return cvi_gu(a->in[23] + (size_t)e * D * FF, a->in[24] + (size_t)e * D * FF, a->in[18] + D, (bf16*)(F.ws + WS_MOEW) + (size_t)e * 2 * FF * D, r, F.lane); };
    if (first >= hi) return;
    static_assert(BG_B6 >= IT_GU + IT_DN, "the left-over background items are all MoE gate|up items (row length FF)");
    constexpr int LDN = WHICH == 1 ? D : FF;
    float va[CKB], vb[CKB];
    CvI ca = dec(first), cb = ca; conv_load2(ca.srcl, LDN, ca.k0, va);
    for (int it = first;; ) {
        const bool nb = it + step < hi; if (nb) { cb = dec(it + step); conv_load2(cb.srcl, LDN, cb.k0, vb); }
        conv_store2(va, ca.ks, ca.k0, ca.dst0, ca.K, scr, F.lane); if (!nb) break; it += step;
        const bool na = it + step < hi; if (na) { ca = dec(it + step); conv_load2(ca.srcl, LDN, ca.k0, va); }
        conv_store2(vb, cb.ks, cb.k0, cb.dst0, cb.K, scr, F.lane); if (!na) break; it += step;
    }
}
__device__ __forceinline__ void p0_xb(Frame& F, const float* x, int rank, int nranks) {
    const int gw = rank * NWAVES + F.wave, NGW = nranks * NWAVES;
    bf16* XB = (bf16*)(F.ws + WS_XB); float* ssq = (float*)(F.ws + WS_SSQ_A);
    for (int m0 = gw * 4; m0 < T; m0 += NGW * 4) {
        f32x4 v[4][4];
#pragma unroll
        for (int r = 0; r < 4; ++r) { const GAS f32x4* xr = (const GAS f32x4*)(x + (size_t)(m0 + r) * D) + F.lane;
#pragma unroll
            for (int j = 0; j < 4; ++j) v[r][j] = __builtin_nontemporal_load(xr + 64 * j); }
#pragma unroll
        for (int r = 0; r < 4; ++r) { float s = 0.f; GAS unsigned long long* o8 = (GAS unsigned long long*)(XB + (size_t)(m0 + r) * D) + F.lane;
#pragma unroll
            for (int j = 0; j < 4; ++j) { const f32x4 w = v[r][j]; s += (w.x * w.x + w.y * w.y) + (w.z * w.z + w.w * w.w);
                o8[64 * j] = (unsigned long long)pk2(w.x, w.y) | ((unsigned long long)pk2(w.z, w.w) << 32); }
            s = wave_sum(s);
            if (F.lane < 16) ssq[(size_t)(m0 + r) * 16 + F.lane] = F.lane == 0 ? s : 0.f; }
    }
}
constexpr size_t SP_TOEP = 0  , SP_PW = 1 * MiB, SP_ACC = 2 * MiB, SP_AC64 = 2 * MiB + 16 * 1024, SP_WSTT = 4 * MiB, SP_WOUTT = 6 * MiB;
constexpr size_t WS_EB = 5 * MiB;
constexpr unsigned EB_TAG = 0x5EED0001u;
__device__ __forceinline__ void ssm_precompute(Frame& F, KA a, int l, int g) {
    LAS float* apr = (LAS float*)(F.lds + RING_OFF); LAS float* api = apr + 17 * 64; LAS float* bbr = api + 17 * 64; LAS float* bbi = bbr + 1024; LAS float* cr = bbi + 1024; LAS float* ci = cr + 1024; LAS float* KT = ci + 1024;
    unsigned char* sp = F.ws + WS_SSMPRE + l * SSMPRE_STRIDE;
    bf16* TOEP = (bf16*)(sp + SP_TOEP) + (size_t)g * 8192; bf16* WSTT = (bf16*)(sp + SP_WSTT) + (size_t)g * 32768; bf16* WOUTT = (bf16*)(sp + SP_WOUTT) + (size_t)g * 32768; float* AC = (float*)(sp + SP_ACC) + g * 128;
    const int lg = l * NG + g, tid = F.tid;
    __syncthreads();
    if (tid < 64) { const int n = tid;
        const double lr = a->in[6][lg * 64 + n], li = a->in[7][lg * 64 + n], dt = exp((double)a->in[8][lg]);
        const double mag = exp(lr * dt), ang = li * dt, a1r = mag * cos(ang), a1i = mag * sin(ang);
        double pr = 1.0, pi = 0.0, a16r = 0.0, a16i = 0.0;
        for (int tau = 0; tau <= 16; ++tau) { apr[tau * 64 + n] = (float)pr; api[tau * 64 + n] = (float)pi; if (tau == 16) { a16r = pr; a16i = pi; } const double qr = pr * a1r - pi * a1i, qi = pr * a1i + pi * a1r; pr = qr; pi = qi; }
        { float* PW = (float*)(sp + SP_PW) + (size_t)g * 8192; float* AC64 = (float*)(sp + SP_AC64) + g * 128; double qr = 1.0, qi = 0.0;
          for (int c = 0; c < 64; ++c) { PW[(c * 64 + n) * 2] = (float)qr; PW[(c * 64 + n) * 2 + 1] = (float)qi; const double tr = qr * a16r - qi * a16i, ti = qr * a16i + qi * a16r; qr = tr; qi = ti; }
          AC64[n] = (float)qr; AC64[64 + n] = (float)qi; }
        const double nr = a1r - 1.0, den = lr * lr + li * li, fre = (nr * lr + a1i * li) / den, fim = (a1i * lr - nr * li) / den;
        for (int c = 0; c < 16; ++c) { const double br = a->in[9][(size_t)(lg * 64 + n) * 16 + c], bi = a->in[10][(size_t)(lg * 64 + n) * 16 + c];
            bbr[n * 16 + c] = (float)(fre * br - fim * bi); bbi[n * 16 + c] = (float)(fre * bi + fim * br); }
        AC[n] = apr[16 * 64 + n]; AC[64 + n] = api[16 * 64 + n];
    }
    for (int o = tid; o < 1024; o += 512) { cr[o] = a->in[11][(size_t)lg * 1024 + o]; ci[o] = a->in[12][(size_t)lg * 1024 + o]; }
    __syncthreads();
    {
        const int co = tid >> 5, c = (tid >> 1) & 15, th = tid & 1; float acc8[8];
#pragma unroll
        for (int q = 0; q < 8; ++q) acc8[q] = 0.f;
        for (int n = 0; n < 64; ++n) { const float c_r = cr[co * 64 + n], c_i = ci[co * 64 + n], br = bbr[n * 16 + c], bi = bbi[n * 16 + c];
            const float xr = c_r * br - c_i * bi, xi = c_r * bi + c_i * br;
#pragma unroll
            for (int q = 0; q < 8; ++q) { const int tau = 8 * th + q; acc8[q] += xr * apr[tau * 64 + n] - xi * api[tau * 64 + n]; } }
#pragma unroll
        for (int q = 0; q < 8; ++q) { const int tau = 8 * th + q; float sv = acc8[q]; if (tau == 0 && co == c) sv += a->in[13][l * SW + g * 16 + co]; KT[tau * 256 + co * 16 + c] = sv; }
    }
    __syncthreads();
    for (int o = tid; o < 4096; o += 512) {
        const int col = 224 + (o >> 7), k = (o & 127) * 2, t = col >> 4, co = col & 15, s0 = k >> 4, c0 = k & 15;
        const float v0 = t >= s0 ? KT[(t - s0) * 256 + co * 16 + c0] : 0.f, v1 = t >= s0 ? KT[(t - s0) * 256 + co * 16 + c0 + 1] : 0.f;
        *(unsigned*)(TOEP + (size_t)((((k >> 4) * 64) + ((k >> 3) & 1) * 32 + (col - 224)) * 8 + (k & 7))) = pk2(v0, v1); }
    for (int o = tid; o < 16384; o += 512) {
        const int n2 = o >> 7, k = (o & 127) * 2, n = n2 & 63, sidx = k >> 4, c0 = k & 15; float v[2];
#pragma unroll
        for (int q = 0; q < 2; ++q) { const float pr = apr[(15 - sidx) * 64 + n], pi = api[(15 - sidx) * 64 + n], br = bbr[n * 16 + c0 + q], bi = bbi[n * 16 + c0 + q]; v[q] = (n2 < 64) ? (pr * br - pi * bi) : (pr * bi + pi * br); }
        *(unsigned*)(WSTT + (size_t)(((((n2 >> 5) * 16 + (k >> 4)) * 64) + ((k >> 3) & 1) * 32 + (n2 & 31)) * 8 + (k & 7))) = pk2(v[0], v[1]); }
    for (int o = tid; o < 16384; o += 512) {
        const int col = o >> 6, n = o & 63, tl = col >> 4, co = col & 15;
        const float pr = apr[(tl + 1) * 64 + n], pi = api[(tl + 1) * 64 + n], c_r = cr[co * 64 + n], c_i = ci[co * 64 + n];
        { const int k = 2 * n; *(unsigned*)(WOUTT + (size_t)(((((col >> 5) * 8 + (k >> 4)) * 64) + ((k >> 3) & 1) * 32 + (col & 31)) * 8 + (k & 7))) = pk2(c_r * pr - c_i * pi, -(c_r * pi + c_i * pr)); } }
    __syncthreads();
}

namespace att {
typedef short bf16x8 __attribute__((ext_vector_type(8)));
typedef short s16x4 __attribute__((ext_vector_type(4)));
typedef short v4i16_t __attribute__((ext_vector_type(4)));
typedef float f32x16 __attribute__((ext_vector_type(16)));
typedef unsigned u32x4 __attribute__((ext_vector_type(4)));
typedef __attribute__((address_space(3))) const char* lds_cptr;
constexpr int SLOTB = 8192, BUFB = 6 * SLOTB, LDS_K = 0, LDS_V = 3 * SLOTB, LDS_WS = 2 * BUFB, LDS_OST = LDS_WS + 8 * 64 * 4, LDS_TOTAL = LDS_OST + 8 * 2048;
static_assert(LDS_TOTAL <= RING_BYTES, "attention LDS");
__device__ __forceinline__ int crow(int r, int hi) { return (r & 3) + 8 * (r >> 2) + 4 * hi; }
__device__ __forceinline__ void glds16(const void* gsrc, unsigned lds_dst) { unsigned keep;
    asm volatile("s_mov_b32 %0, m0\n\ts_mov_b32 m0, %2\n\ts_nop 0\n\tglobal_load_lds_dwordx4 %1, off\n\ts_mov_b32 m0, %0" : "=&s"(keep) : "v"(gsrc), "s"(lds_dst) : "memory"); }
typedef float f32x2_t __attribute__((ext_vector_type(2))); typedef __bf16 bf16x2_t __attribute__((ext_vector_type(2)));
__device__ __forceinline__ unsigned cvtpk(float lo, float hi) { f32x2_t v = {lo, hi}; bf16x2_t b = __builtin_convertvector(v, bf16x2_t); return __builtin_bit_cast(unsigned, b); }
__device__ __forceinline__ s16x4 vtr(lds_cptr p) { return __builtin_bit_cast(s16x4, __builtin_amdgcn_ds_read_tr16_b64_v4i16((__attribute__((address_space(3))) v4i16_t*)p)); }
__device__ __forceinline__ float xhalf_max(float m) { auto rr = __builtin_amdgcn_permlane32_swap(__float_as_uint(m), __float_as_uint(m), false, false); return fmaxf(__uint_as_float(rr[0]), __uint_as_float(rr[1])); }
__device__ __forceinline__ float xhalf_sum(float m) { auto rr = __builtin_amdgcn_permlane32_swap(__float_as_uint(m), __float_as_uint(m), false, false); return __uint_as_float(rr[0]) + __uint_as_float(rr[1]); }

struct Ctx { int tid, lane, r32, hi, wid; };
__device__ __forceinline__ void attn_issue(const Ctx& c, int u, int buf, const bf16* QKVU, LAS unsigned char* shm, bf16x8 (&qn)[4]) {
    const int qb = u % (SEQ / 64), kvh = (u / (SEQ / 64)) % NKV, b = u / (NKV * (SEQ / 64));
    const int h = kvh * 4 + (c.wid >> 1), q0 = qb * 64, qw = q0 + 32 * (c.wid & 1);
    const size_t rowbase = (size_t)b * SEQ; const unsigned lds0 = (unsigned)(uintptr_t)shm + buf * BUFB;
#pragma unroll
    for (int j = 0; j < 3; ++j) {
        const int kv0 = q0 - 128 + 64 * j;
        int kr = kv0 + c.lane; kr = kr < 0 ? 0 : kr;
        int vr = kv0 + 16 * (c.wid & 3) + (c.lane >> 2); vr = vr < 0 ? 0 : vr;
        glds16(QKVU + (rowbase + kr) * INW + KOFF + kvh * 64 + c.wid * 8, (unsigned)__builtin_amdgcn_readfirstlane(lds0 + LDS_K + j * SLOTB + c.wid * 1024));
        glds16(QKVU + (rowbase + vr) * INW + VOFF + kvh * 64 + (c.wid >> 2) * 32 + (c.lane & 3) * 8, (unsigned)__builtin_amdgcn_readfirstlane(lds0 + LDS_V + j * SLOTB + c.wid * 1024));
    }
    const bf16* qp = QKVU + (rowbase + qw + c.r32) * INW + QOFF + h * 64 + c.hi * 8;
#pragma unroll
    for (int d0 = 0; d0 < 4; ++d0) qn[d0] = *(const bf16x8*)(qp + d0 * 16);
}
__device__ __forceinline__ void attn_compute(const Ctx& c, int u, int buf, const bf16x8 (&qr)[4], bf16* MIX, float* ssq, const float* sinks, LAS unsigned char* shm0) {
    const int lane = c.lane, r32 = c.r32, hi = c.hi, wid = c.wid;
    const int qb = u % (SEQ / 64), kvh = (u / (SEQ / 64)) % NKV, b = u / (NKV * (SEQ / 64));
    const int h = kvh * 4 + (wid >> 1), qsub = wid & 1, q0 = qb * 64, qw = q0 + 32 * qsub;
    const size_t rowbase = (size_t)b * SEQ;
    LAS unsigned char* shm = shm0 + buf * BUFB;
    const float sink2 = sinks[h] * LOG2E;
    f32x16 p[5];
    const lds_cptr kbase = (lds_cptr)shm + LDS_K + hi * 1024 + r32 * 16;
#pragma unroll
    for (int hb = 0; hb < 5; ++hb) {
        const int G = qsub + hb;
        const lds_cptr kp = kbase + (G >> 1) * SLOTB + (G & 1) * 512;
        f32x16 acc = {};
#pragma unroll
        for (int d0 = 0; d0 < 4; ++d0) { const bf16x8 kf = *(const __attribute__((address_space(3))) bf16x8*)(kp + d0 * 2048); acc = __builtin_amdgcn_mfma_f32_32x32x16_bf16(kf, qr[d0], acc, 0, 0, 0); }
        p[hb] = acc;
    }
    const float NEG = -1.0e30f;
#pragma unroll
    for (int r = 0; r < 16; ++r) { const int cr_ = crow(r, hi); if (!(r32 < cr_)) p[0][r] = NEG; if (!(cr_ <= r32)) p[4][r] = NEG; }
    if (q0 < 128) {
#pragma unroll
        for (int hb = 0; hb < 5; ++hb)
#pragma unroll
            for (int r = 0; r < 16; ++r) { if (qw - 128 + 32 * hb + crow(r, hi) < 0) p[hb][r] = NEG; }
    }
    float m = sink2;
#pragma unroll
    for (int hb = 0; hb < 5; ++hb)
#pragma unroll
        for (int r = 0; r < 16; ++r) m = fmaxf(m, p[hb][r]);
    m = xhalf_max(m);
    float lsum = 0.f;
#pragma unroll
    for (int hb = 0; hb < 5; ++hb)
#pragma unroll
        for (int r = 0; r < 16; ++r) { const float e = __builtin_amdgcn_exp2f(p[hb][r] - m); p[hb][r] = e; lsum += e; }
    lsum = xhalf_sum(lsum) + __builtin_amdgcn_exp2f(sink2 - m);
    f32x16 o[2]; o[0] = f32x16{}; o[1] = f32x16{};
    const lds_cptr vp0 = (lds_cptr)shm + LDS_V + ((lane >> 4) & 1) * 32 + (lane & 3) * 8 + (4 * hi + ((lane & 15) >> 2)) * 64;
#pragma unroll
    for (int hb = 0; hb < 5; ++hb) {
#pragma unroll
        for (int kk = 0; kk < 2; ++kk) {
            const int ko = 32 * (qsub + hb) + 16 * kk, j = ko >> 6, ks = (ko >> 4) & 3;
            u32x4 pw; pw.x = cvtpk(p[hb][8 * kk + 0], p[hb][8 * kk + 1]); pw.y = cvtpk(p[hb][8 * kk + 2], p[hb][8 * kk + 3]); pw.z = cvtpk(p[hb][8 * kk + 4], p[hb][8 * kk + 5]); pw.w = cvtpk(p[hb][8 * kk + 6], p[hb][8 * kk + 7]);
            const bf16x8 pa = __builtin_bit_cast(bf16x8, pw);
#pragma unroll
            for (int d0 = 0; d0 < 2; ++d0) {
                const lds_cptr vp = vp0 + j * SLOTB + d0 * 4096 + ks * 1024;
                const s16x4 lo = vtr(vp), hh = vtr(vp + 512);
                const bf16x8 vf = (bf16x8){lo[0], lo[1], lo[2], lo[3], hh[0], hh[1], hh[2], hh[3]};
                o[d0] = __builtin_amdgcn_mfma_f32_32x32x16_bf16(pa, vf, o[d0], 0, 0, 0);
            }
        }
    }
    LAS float* wsf = (LAS float*)(shm0 + LDS_WS) + wid * 64;
    if (hi == 0) wsf[r32] = lsum;
    asm volatile("s_waitcnt lgkmcnt(0)" ::: "memory");
    float rli[16];
#pragma unroll
    for (int r = 0; r < 16; ++r) rli[r] = __builtin_amdgcn_rcpf(wsf[crow(r, hi)]);
    LAS bf16* stg = (LAS bf16*)(shm0 + LDS_OST) + wid * 1024;
    bf16* Ow = MIX + (rowbase + qw) * D + h * 64;
    float ssrow[2] = {0.f, 0.f};
#pragma unroll
    for (int d0 = 0; d0 < 2; ++d0) {
#pragma unroll
        for (int r = 0; r < 16; ++r) stg[crow(r, hi) * 32 + r32] = (bf16)pg8::cvt_pk_bf16(o[d0][r] * rli[r], 0.f);
        asm volatile("s_waitcnt lgkmcnt(0)" ::: "memory");
#pragma unroll
        for (int i = 0; i < 2; ++i) { const int row = i * 16 + (lane >> 2), ch = lane & 3; const u32x4 v = *(const LAS u32x4*)(stg + row * 32 + ch * 8);
            *(u32x4*)(Ow + (size_t)row * D + d0 * 32 + ch * 8) = v;
            const unsigned w4[4] = {v.x, v.y, v.z, v.w};
#pragma unroll
            for (int k = 0; k < 4; ++k) { const float a = pg8::bf_lo(w4[k]), cc = pg8::bf_hi(w4[k]); ssrow[i] += a * a + cc * cc; } }
        asm volatile("s_waitcnt lgkmcnt(0)" ::: "memory");
    }
#pragma unroll
    for (int i = 0; i < 2; ++i) { float ss = ssrow[i]; ss += __shfl_xor(ss, 1); ss += __shfl_xor(ss, 2); if ((lane & 3) == 0) ssq[(rowbase + qw + i * 16 + (lane >> 2)) * 8 + h] = ss; }
}
}
__device__ __forceinline__ void attn_phase_v1(Frame& F, KA a, int l, int first, int count) {
    const int me = F.bx - first; if (me < 0 || me >= count) return;
    const bf16* QKVU = (const bf16*)(F.ws + WS_QKVU); bf16* MIX = (bf16*)(F.ws + WS_MIX); float* ssq = (float*)(F.ws + WS_SSQ_ATT);
    att::Ctx c; { int tid_ = F.tid; asm volatile("" : "+v"(tid_)); c.tid = tid_; c.lane = tid_ & 63; c.r32 = c.lane & 31; c.hi = c.lane >> 5; c.wid = __builtin_amdgcn_readfirstlane(tid_ >> 6); }
    constexpr int NU = BATCH * NKV * (SEQ / 64);
    att::bf16x8 qr[4], qn[4];
    int u = me, it = 0;
    if (u >= NU) return;
    asm volatile("s_waitcnt lgkmcnt(0)\n\ts_barrier" ::: "memory");
    att::attn_issue(c, u, 0, QKVU, F.lds + RING_OFF, qr);
    for (; u < NU; u += count, ++it) {
        const bool has_next = u + count < NU;
        if (has_next) att::attn_issue(c, u + count, (it + 1) & 1, QKVU, F.lds + RING_OFF, qn);
        if (has_next && it > 0) asm volatile("s_waitcnt vmcnt(14)" ::: "memory"); else if (has_next) asm volatile("s_waitcnt vmcnt(10)" ::: "memory"); else asm volatile("s_waitcnt vmcnt(0)" ::: "memory");
        asm volatile("s_barrier" ::: "memory");
        att::attn_compute(c, u, it & 1, qr, MIX, ssq, a->in[5] + l * NH, F.lds + RING_OFF);
        asm volatile("s_waitcnt lgkmcnt(0)\n\ts_barrier" ::: "memory");
#pragma unroll
        for (int d0 = 0; d0 < 4; ++d0) qr[d0] = qn[d0];
    }
}

__device__ __forceinline__ float gelu_tanh(float y) {
    const float t = y * (2.0f * 0.7978845608028654f * LOG2E + (2.0f * 0.7978845608028654f * 0.044715f * LOG2E) * y * y);
    return y - y * __builtin_amdgcn_rcpf(1.0f + __builtin_amdgcn_exp2f(t));
}
namespace ssm {
typedef short bf16x8 __attribute__((ext_vector_type(8)));
typedef float f32x16 __attribute__((ext_vector_type(16)));
constexpr int UST = 528, UBUF = 64 * UST, HST = 272;
constexpr int L_U = 0, L_SL = 2 * UBUF, L_HB = L_SL  , L_TF = L_SL + 64 * 128 * 4, L_END = L_TF + 19 * 1024;
static_assert(L_END <= RING_BYTES, "ssm LDS");
__device__ __forceinline__ int crow(int r, int hi) { return (r & 3) + 8 * (r >> 2) + 4 * hi; }
constexpr int M_U = 0, M_SL = UBUF, M_HB = M_SL + 64 * 128 * 4, M_TF = M_HB + 64 * HST, M_HIN = M_TF + 19 * 1024, M_END = M_HIN + 512;
static_assert(M_END <= RING_BYTES, "ssm LDS (decoupled)");
typedef __attribute__((address_space(1))) unsigned long long gu64s;
__device__ __forceinline__ void ssm_job2(int bg, int sb, int l, unsigned char* ws, LAS unsigned char* shm) {
    int tid_ = threadIdx.x; asm volatile("" : "+v"(tid_));
    const int tid = tid_, lane = tid & 63, r32 = lane & 31, hi = lane >> 5; const int w = __builtin_amdgcn_readfirstlane(tid >> 6);
    const int b = bg / NG, g = bg % NG;
    const bf16* UGp = (const bf16*)(ws + WS_UG); bf16* YG = (bf16*)(ws + WS_YG);
    unsigned char* sp = ws + WS_SSMPRE + l * SSMPRE_STRIDE;
    const bf16* TOEP = (const bf16*)(sp + SP_TOEP) + (size_t)g * 8192; const bf16* WSTT = (const bf16*)(sp + SP_WSTT) + (size_t)g * 32768; const bf16* WOUTT = (const bf16*)(sp + SP_WOUTT) + (size_t)g * 32768;
    const float* AC = (const float*)(sp + SP_ACC) + g * 128; const float* AC64 = (const float*)(sp + SP_AC64) + g * 128; const float* PW = (const float*)(sp + SP_PW) + (size_t)g * 8192;
    gu64s* eb = (gu64s*)(ws + WS_EB) + (size_t)((l * 64 + bg) * 8) * 128;
    const int mt1 = w >> 2, nt1 = w & 3;
    const int J = w < 4 ? w : 11 - w, ns = 2 * J + 2;
    const size_t rowb = (size_t)b * SEQ + (size_t)sb * 1024;
    v4u up[4];
#pragma unroll
    for (int i = 0; i < 4; ++i) { const int pi = tid + 512 * i; up[i] = *(const v4u*)(UGp + ((size_t)g * T + rowb) * GD + (size_t)pi * 8); }
    bf16x8 tfr[2];
#pragma unroll
    for (int i = 0; i < 2; ++i) tfr[i] = *(const bf16x8*)(TOEP + (size_t)((2 * w + i) * 64 + lane) * 8);
    float2 pwv[8];
#pragma unroll
    for (int i = 0; i < 8; ++i) pwv[i] = *(const float2*)(PW + (size_t)(((tid >> 6) + 8 * i) * 64 + (tid & 63)) * 2);
    const float acr = AC[lane], aci = AC[64 + lane], a64r = AC64[lane], a64i = AC64[64 + lane];
    bf16x8 bw1[16], bc[8];
#pragma unroll
    for (int ks = 0; ks < 16; ++ks) bw1[ks] = *(const bf16x8*)(WSTT + (size_t)((nt1 * 16 + ks) * 64 + lane) * 8);
#pragma unroll
    for (int ks = 0; ks < 8; ++ks) bc[ks] = *(const bf16x8*)(WOUTT + (size_t)((J * 8 + ks) * 64 + lane) * 8);
#pragma unroll
    for (int i = 0; i < 4; ++i) { const int pi = tid + 512 * i, row = pi >> 1; *(LAS v4u*)(shm + M_U + (row >> 4) * UST + (row & 15) * 32 + (pi & 1) * 16) = up[i]; }
#pragma unroll
    for (int i = 0; i < 2; ++i) *(LAS bf16x8*)(shm + M_TF + (2 * w + i) * 1024 + lane * 16) = tfr[i];
    if (w < 3) { unsigned z0, z1, z2, z3; asm volatile("v_mov_b32 %0, 0\n\tv_mov_b32 %1, 0\n\tv_mov_b32 %2, 0\n\tv_mov_b32 %3, 0" : "=v"(z0), "=v"(z1), "=v"(z2), "=v"(z3));
        *(LAS v4u*)(shm + M_TF + (16 + w) * 1024 + lane * 16) = (v4u){z0, z1, z2, z3}; }
    asm volatile("s_waitcnt lgkmcnt(0)\n\ts_barrier" ::: "memory");
    const LAS unsigned char* ub = shm + M_U + hi * 16;
    {
        f32x16 acc = {};
#pragma unroll
        for (int ks = 0; ks < 16; ++ks) { const bf16x8 af = *(const LAS bf16x8*)(ub + (32 * mt1 + r32) * UST + ks * 32); acc = __builtin_amdgcn_mfma_f32_32x32x16_bf16(af, bw1[ks], acc, 0, 0, 0); }
        LAS float* sl = (LAS float*)(shm + M_SL);
#pragma unroll
        for (int r = 0; r < 16; ++r) sl[(32 * mt1 + crow(r, hi)) * 128 + 32 * nt1 + r32] = acc[r];
    }
    asm volatile("s_waitcnt lgkmcnt(0)\n\ts_barrier" ::: "memory");
    if (w == 0) {
        LAS float* sl = (LAS float*)(shm + M_SL);
        float pwr[4], pwi[4]; pwr[0] = acr; pwi[0] = aci;
#pragma unroll
        for (int j = 1; j < 4; ++j) { pwr[j] = pwr[j - 1] * acr - pwi[j - 1] * aci; pwi[j] = pwr[j - 1] * aci + pwi[j - 1] * acr; }
        float hr = 0.f, hi_ = 0.f;
        for (int c0 = 0; c0 < 64; c0 += 16) {
            float sr[16], si[16];
#pragma unroll
            for (int i = 0; i < 16; ++i) { sr[i] = sl[(c0 + i) * 128 + lane]; si[i] = sl[(c0 + i) * 128 + 64 + lane]; }
            asm volatile("s_waitcnt lgkmcnt(0)" ::: "memory");
#pragma unroll
            for (int gq = 0; gq < 4; ++gq) {
                float tr[4], ti[4]; tr[0] = sr[4 * gq]; ti[0] = si[4 * gq];
#pragma unroll
                for (int j = 1; j < 4; ++j) { tr[j] = __builtin_fmaf(acr, tr[j - 1], __builtin_fmaf(-aci, ti[j - 1], sr[4 * gq + j])); ti[j] = __builtin_fmaf(acr, ti[j - 1], __builtin_fmaf(aci, tr[j - 1], si[4 * gq + j])); }
                sl[(c0 + 4 * gq) * 128 + lane] = hr; sl[(c0 + 4 * gq) * 128 + 64 + lane] = hi_;
#pragma unroll
                for (int j = 1; j < 4; ++j) { const float xr = __builtin_fmaf(pwr[j - 1], hr, __builtin_fmaf(-pwi[j - 1], hi_, tr[j - 1])), xi = __builtin_fmaf(pwr[j - 1], hi_, __builtin_fmaf(pwi[j - 1], hr, ti[j - 1]));
                    sl[(c0 + 4 * gq + j) * 128 + lane] = xr; sl[(c0 + 4 * gq + j) * 128 + 64 + lane] = xi; }
                const float nr = __builtin_fmaf(pwr[3], hr, __builtin_fmaf(-pwi[3], hi_, tr[3])), ni = __builtin_fmaf(pwr[3], hi_, __builtin_fmaf(pwi[3], hr, ti[3])); hr = nr; hi_ = ni;
            }
        }
        { unsigned tagv; asm volatile("v_mov_b32 %0, %1" : "=v"(tagv) : "s"(EB_TAG));
          __hip_atomic_store(eb + sb * 128 + lane, ((unsigned long long)tagv << 32) | __float_as_uint(hr), __ATOMIC_RELAXED, __HIP_MEMORY_SCOPE_AGENT);
          __hip_atomic_store(eb + sb * 128 + 64 + lane, ((unsigned long long)tagv << 32) | __float_as_uint(hi_), __ATOMIC_RELAXED, __HIP_MEMORY_SCOPE_AGENT); }
        float Hr = 0.f, Hi = 0.f;
        for (int sp_ = 0; sp_ < sb; ++sp_) {
            unsigned long long xr = 0, xi = 0;
            for (unsigned spins = 0;; ++spins) {
                xr = __hip_atomic_load(eb + sp_ * 128 + lane, __ATOMIC_RELAXED, __HIP_MEMORY_SCOPE_AGENT); xi = __hip_atomic_load(eb + sp_ * 128 + 64 + lane, __ATOMIC_RELAXED, __HIP_MEMORY_SCOPE_AGENT);
                const bool ok = (unsigned)(xr >> 32) == EB_TAG && (unsigned)(xi >> 32) == EB_TAG;
                if (__all(ok)) break;
                if (spins > (1u << 20)) break;
                __builtin_amdgcn_s_sleep(2);
            }
            const float er = __uint_as_float((unsigned)xr), ei = __uint_as_float((unsigned)xi);
            const float nr = __builtin_fmaf(a64r, Hr, __builtin_fmaf(-a64i, Hi, er)), ni = __builtin_fmaf(a64r, Hi, __builtin_fmaf(a64i, Hr, ei)); Hr = nr; Hi = ni;
        }
        LAS float* hin = (LAS float*)(shm + M_HIN); hin[lane] = Hr; hin[64 + lane] = Hi;
    }
    f32x16 acc2[2]; acc2[0] = f32x16{}; acc2[1] = f32x16{};
#pragma unroll
    for (int kb = 0; kb < 4; ++kb) { if (4 * kb < ns) {
        bf16x8 bf[4];
#pragma unroll
        for (int q = 0; q < 4; ++q) bf[q] = *(const LAS bf16x8*)(shm + M_TF + (14 - 2 * J + 4 * kb + q) * 1024 + lane * 16);
#pragma unroll
        for (int mt = 0; mt < 2; ++mt) { bf16x8 af[4];
#pragma unroll
            for (int q = 0; q < 4; ++q) af[q] = *(const LAS bf16x8*)(ub + (32 * mt + r32) * UST + (4 * kb + q) * 32);
#pragma unroll
            for (int q = 0; q < 4; ++q) acc2[mt] = __builtin_amdgcn_mfma_f32_32x32x16_bf16(af[q], bf[q], acc2[mt], 0, 0, 0); }
    } }
    asm volatile("s_waitcnt lgkmcnt(0)\n\ts_barrier" ::: "memory");
    {
        const int n = tid & 63, cq = tid >> 6; const LAS float* sl = (const LAS float*)(shm + M_SL); const LAS float* hin = (const LAS float*)(shm + M_HIN);
        const float Hr = hin[n], Hi = hin[64 + n];
#pragma unroll
        for (int i = 0; i < 8; ++i) { const int c = cq + 8 * i; const float2 pw = pwv[i];
            const float xr = sl[c * 128 + n] + pw.x * Hr - pw.y * Hi, xi = sl[c * 128 + 64 + n] + pw.x * Hi + pw.y * Hr;
            *(LAS unsigned*)(shm + M_HB + c * HST + n * 4) = pg8::cvt_pk_bf16(xr, xi); }
    }
    asm volatile("s_waitcnt lgkmcnt(0)\n\ts_barrier" ::: "memory");
#pragma unroll
    for (int ks = 0; ks < 8; ++ks) {
#pragma unroll
        for (int mt = 0; mt < 2; ++mt) { const bf16x8 af = *(const LAS bf16x8*)(shm + M_HB + (32 * mt + r32) * HST + ks * 32 + hi * 16); acc2[mt] = __builtin_amdgcn_mfma_f32_32x32x16_bf16(af, bc[ks], acc2[mt], 0, 0, 0); } }
    {   const int t = 2 * J + (r32 >> 4), co = r32 & 15;
#pragma unroll
        for (int mt = 0; mt < 2; ++mt)
#pragma unroll
            for (int r = 0; r < 16; ++r) { const int chunk = 32 * mt + crow(r, hi);
                YG[(rowb + (size_t)chunk * 16 + t) * SW + 16 * g + co] = (bf16)pg8::cvt_pk_bf16(gelu_tanh(acc2[mt][r]), 0.f); } }
    asm volatile("s_waitcnt lgkmcnt(0)\n\ts_barrier" ::: "memory");
}
}
__device__ __forceinline__ void ssm_phase_v2(Frame& F, int l) {
    for (int j = F.bx; j < BATCH * NG * (SEQ / 1024); j += F.G) ssm::ssm_job2(j % (BATCH * NG), j / (BATCH * NG), l, F.ws, F.lds + RING_OFF);
}

__device__ __forceinline__ void route1(Frame& F, KA a) {
    LAS int* hl = (LAS int*)(F.lds + RING_OFF);
    unsigned char* rt = F.ws + WS_ROUTE; int* TOPE = (int*)(rt + RT_TOPE); float* TOPG = (float*)(rt + RT_TOPG); float* RINVT = (float*)(rt + RT_RINVT); int* HIST = (int*)(rt + RT_HIST);
    const float* wr = a->in[22]; const float* gn = a->in[18] + D;
    f32x4 w0[4][4], w1[4][4];
#pragma unroll
    for (int j = 0; j < 4; ++j)
#pragma unroll
        for (int q = 0; q < 4; ++q) { const int k = 4 * (F.lane + 64 * j) + q; const float g = gn[k]; w0[j][q] = *(const f32x4*)(wr + k * 8) * g; w1[j][q] = *(const f32x4*)(wr + k * 8 + 4) * g; }
    for (int blk = F.bx; blk < T / 64; blk += F.G) {
        __syncthreads();
        if (F.tid < 8) hl[F.tid] = 0;
        __syncthreads();
        for (int ib = 0; ib < 8; ib += 2) {
            f32x4 xv4[2][4];
#pragma unroll
            for (int i = 0; i < 2; ++i) { const GAS unsigned long long* xr = (const GAS unsigned long long*)((const bf16*)(F.ws + WS_XB) + (size_t)(blk * 64 + F.wave * 8 + ib + i) * D) + F.lane;
#pragma unroll
                for (int j = 0; j < 4; ++j) { const unsigned long long w = xr[64 * j]; const unsigned lo = (unsigned)w, hi2 = (unsigned)(w >> 32); xv4[i][j] = (f32x4){pg8::bf_lo(lo), pg8::bf_hi(lo), pg8::bf_lo(hi2), pg8::bf_hi(hi2)}; } }
#pragma unroll
            for (int i = 0; i < 2; ++i) {
            const int t = blk * 64 + F.wave * 8 + ib + i;
            f32x4 la = {0.f, 0.f, 0.f, 0.f}, lb = {0.f, 0.f, 0.f, 0.f}; float ss = 0.f;
#pragma unroll
            for (int j = 0; j < 4; ++j) { const f32x4 v = xv4[i][j]; const float xv[4] = {v.x, v.y, v.z, v.w};
#pragma unroll
                for (int q = 0; q < 4; ++q) { ss += xv[q] * xv[q]; la += w0[j][q] * xv[q]; lb += w1[j][q] * xv[q]; } }
            ss = wave_sum(ss);
            float lg[8] = {la.x, la.y, la.z, la.w, lb.x, lb.y, lb.z, lb.w};
#pragma unroll
            for (int e = 0; e < 8; ++e) lg[e] = wave_sum(lg[e]);
            const float rinv = 1.0f / sqrtf(ss * (1.0f / D) + EPS);
            int e1 = 0; float l1 = lg[0];
#pragma unroll
            for (int e = 1; e < 8; ++e) if (lg[e] > l1) { l1 = lg[e]; e1 = e; }
            int e2 = -1; float l2 = -3.0e38f;
#pragma unroll
            for (int e = 0; e < 8; ++e) if (e != e1 && lg[e] > l2) { l2 = lg[e]; e2 = e; }
            const float g2 = 1.0f / (1.0f + __expf((l1 - l2) * rinv)), g1 = 1.0f - g2;
            if (F.lane == 0) { TOPE[t * 2] = e1; TOPE[t * 2 + 1] = e2; TOPG[t * 2] = g1; TOPG[t * 2 + 1] = g2; RINVT[t] = rinv; atomicAdd((int*)&hl[e1], 1); atomicAdd((int*)&hl[e2], 1); }
            }
        }
        __syncthreads();
        if (F.tid < 8) HIST[blk * 8 + F.tid] = hl[F.tid];
    }
    __syncthreads();
}
__device__ __forceinline__ void route2(Frame& F) {
    LAS int* sb = (LAS int*)(F.lds + RING_OFF);
    unsigned char* rt = F.ws + WS_ROUTE; const int* TOPE = (const int*)(rt + RT_TOPE); const float* TOPG = (const float*)(rt + RT_TOPG); const float* RINVT = (const float*)(rt + RT_RINVT); const int* HIST = (const int*)(rt + RT_HIST);
    int* IDX = (int*)(rt + RT_IDX); float* GATE = (float*)(rt + RT_GATE); float* RINVS = (float*)(rt + RT_RINVS); int* POS = (int*)(rt + RT_POS); int* PEND = (int*)(rt + RT_PEND);
    for (int blk = F.bx; blk < T / 64; blk += F.G) {
        __syncthreads();
        if (F.tid < 16) sb[F.tid] = 0;
        __syncthreads();
        if (F.tid < T / 64) {
            const int4 h0 = *(const int4*)(HIST + F.tid * 8), h1 = *(const int4*)(HIST + F.tid * 8 + 4); const int hv[8] = {h0.x, h0.y, h0.z, h0.w, h1.x, h1.y, h1.z, h1.w};
#pragma unroll
            for (int e = 0; e < 8; ++e) { atomicAdd((int*)&sb[e], hv[e]); if (F.tid < blk) atomicAdd((int*)&sb[8 + e], hv[e]); }
        }
        __syncthreads();
        if (F.tid == 0) { int ps = 0; for (int e = 0; e < 8; ++e) { const int pd = (sb[e] + 255) & ~255; sb[16 + e] = ps; sb[24 + e] = pd; ps += pd; if (blk == 0) PEND[e] = ps >> 8; } }
        __syncthreads();
        if (F.wave == 0) {
            const int t = blk * 64 + F.lane; int run[8];
#pragma unroll
            for (int e = 0; e < 8; ++e) run[e] = sb[16 + e] + sb[8 + e];
#pragma unroll
            for (int k = 0; k < 2; ++k) { const int e = TOPE[t * 2 + k]; int slot = 0;
#pragma unroll
                for (int ee = 0; ee < 8; ++ee) { const unsigned long long mk = __ballot(e == ee); const int below = __popcll(mk & ((1ull << F.lane) - 1ull));
                    if (e == ee) slot = run[ee] + below; run[ee] += __popcll(mk); }
                IDX[slot] = t; GATE[slot] = TOPG[t * 2 + k]; RINVS[slot] = RINVT[t]; POS[t * 2 + k] = slot; }
        }
        if (blk == 0) {
            for (int e = 0; e < 8; ++e) { const int s0 = sb[16 + e] + sb[e], s1 = sb[16 + e] + sb[24 + e]; for (int s = s0 + F.tid; s < s1; s += 512) { IDX[s] = 0; GATE[s] = 0.f; RINVS[s] = 0.f; } }
        }
    }
    __syncthreads();
}
__device__ __forceinline__ void moe_combine(Frame& F) {
    const bf16* YS = (const bf16*)(F.ws + WS_YS); const int* POS = (const int*)(F.ws + WS_ROUTE + RT_POS); const float* GATE = (const float*)(F.ws + WS_ROUTE + RT_GATE);
    const unsigned* TM = (const unsigned*)(F.ws + WS_CTL) + CW_TAILMAP; const float* SLAB = (const float*)(F.ws + WS_SLAB);
    const int S = pg8::ks_slices(((const int*)(F.ws + WS_ROUTE + RT_PEND))[7] * (D / 256), F.G);
    const int gw = F.vcu * NWAVES + F.wave, NGW = F.G * NWAVES;
    for (int t = gw; t < T; t += NGW) {
        const int p0 = POS[t * 2], p1 = POS[t * 2 + 1];
        const v4u tm0 = *(const v4u*)(TM + (p0 >> 8) * 4), tm1 = *(const v4u*)(TM + (p1 >> 8) * 4);
        GAS f32x4* xr = (GAS f32x4*)(F.out + (size_t)t * D) + F.lane;
        const GAS unsigned long long* xb = (const GAS unsigned long long*)((const bf16*)(F.ws + WS_XB) + (size_t)t * D) + F.lane;
        const bf16* YS2 = (const bf16*)(F.ws + WS_YS2);
        const GAS unsigned long long* y0 = (const GAS unsigned long long*)(p0 < YS_SPLIT ? YS + (size_t)p0 * D : YS2 + (size_t)(p0 - YS_SPLIT) * D) + F.lane; const GAS unsigned long long* y1 = (const GAS unsigned long long*)(p1 < YS_SPLIT ? YS + (size_t)p1 * D : YS2 + (size_t)(p1 - YS_SPLIT) * D) + F.lane;
        f32x4 v[4]; unsigned long long a0[4], a1[4];
#pragma unroll
        for (int j = 0; j < 4; ++j) { const unsigned long long w = xb[64 * j]; const unsigned lo = (unsigned)w, hi2 = (unsigned)(w >> 32); v[j] = (f32x4){pg8::bf_lo(lo), pg8::bf_hi(lo), pg8::bf_lo(hi2), pg8::bf_hi(hi2)}; a0[j] = y0[64 * j]; a1[j] = y1[64 * j]; }
        const unsigned t0[4] = {tm0.x, tm0.y, tm0.z, tm0.w}, t1[4] = {tm1.x, tm1.y, tm1.z, tm1.w};
#pragma unroll
        for (int j = 0; j < 4; ++j) { f32x4 y = {0.f, 0.f, 0.f, 0.f};
#pragma unroll
            for (int k = 0; k < 2; ++k) { const int p = k ? p1 : p0; const unsigned tm = k ? t1[j] : t0[j]; const unsigned long long aa = k ? a1[j] : a0[j];
                if (tm == 0u) { const unsigned lo = (unsigned)aa, hi = (unsigned)(aa >> 32); y.x += pg8::bf_lo(lo); y.y += pg8::bf_hi(lo); y.z += pg8::bf_lo(hi); y.w += pg8::bf_hi(hi); }
                else {
                    f32x4 a = {0.f, 0.f, 0.f, 0.f}; const float* sp = SLAB + (size_t)(tm - 1u) * S * 65536 + (size_t)(p & 255) * 256 + 4 * F.lane;
                    for (int q = 0; q < S; ++q) a += *(const f32x4*)(sp + (size_t)q * 65536);
                    y += a * GATE[p]; }
            }
            xr[64 * j] = v[j] + y; }
    }
}

__device__ __forceinline__ int wd_quota(int rem, int G) { if (rem == 0) return 0; const int q = (G - rem) * NWAVES * 7; return q < NE * IT_DN ? q : NE * IT_DN; }
constexpr int NPHASE = 19;
__global__ void __launch_bounds__(NWAVES * 64, 2) hymba_fwd(Args args_) {
    KA args = (KA)__builtin_amdgcn_kernarg_segment_ptr();
    (void)args_;
    extern __shared__ __attribute__((aligned(16))) unsigned char lds[];
    Frame F;
    F.lds = (LAS unsigned char*)lds; F.MISC = (volatile LAS unsigned*)(F.lds + MISC_OFF);
    F.tid = threadIdx.x; F.lane = F.tid & 63; F.wave = __builtin_amdgcn_readfirstlane(F.tid >> 6);
    F.G = gridDim.x; F.bx = blockIdx.x; { const int bx = blockIdx.x; F.vcu = (F.G % 8 == 0) ? (bx % 8) * (F.G / 8) + bx / 8 : bx; }
    F.ws = args->ws; F.out = args->out; F.ctl = (gu32*)(args->ws + WS_CTL);
    for (int u = F.tid; u < (LDS_BYTES - LDSCTL_OFF) / 4; u += NWAVES * 64) ((LAS unsigned*)(F.lds + LDSCTL_OFF))[u] = 0u;
    __syncthreads();
    const int lo = args->ph_lo, hi = args->ph_hi;
    XcdBarrier bar; bar.bar = (unsigned*)(F.ctl + CW_BAR); bar.x = 0; bar.st = nullptr;
    if (hi - lo > 1) bar = xcd_barrier_post((unsigned*)(F.ctl + CW_BAR), F.MISC + 8);
#ifndef PH_MASK
#define PH_MASK 0x7FFFF
#endif
#define IN(k) (((PH_MASK >> (k)) & 1) && lo <= (k) && (k) < hi)
#define SEAM(k) do { if ((k) + 1 < hi) xcd_barrier(bar); } while (0)
#ifndef PH_TWICE
#define PH_TWICE 0
#endif
#define REP(k) for (int rep_ = 0; rep_ < 1 + ((PH_TWICE >> (k)) & 1); ++rep_)
#define REPSEAM() do { if (rep_ == 0 && hi - lo > 1) xcd_barrier(bar); } while (0)
    unsigned char* ws = args->ws;
#define PH() do { asm volatile("" : "+s"(args)); GAS unsigned char* w_ = (GAS unsigned char*)args->ws; GAS float* o_ = (GAS float*)args->out; int t_ = threadIdx.x; int b_ = blockIdx.x, g_ = gridDim.x; asm volatile("" : "+s"(w_), "+s"(o_), "+v"(t_), "+s"(b_), "+s"(g_)); F.ws = (unsigned char*)w_; F.out = (float*)o_; F.tid = t_; F.lane = t_ & 63; F.bx = b_; F.G = g_; F.vcu = (g_ % 8 == 0) ? (b_ % 8) * (g_ / 8) + b_ / 8 : b_; ws = (unsigned char*)w_; } while (0)
#define XB_ ((bf16*)(ws + WS_XB))
#define QKVU_ ((bf16*)(ws + WS_QKVU))
#define MIX_ ((bf16*)(ws + WS_MIX))
#define YG_ ((bf16*)(ws + WS_YG))
#define SSQ_A_ ((float*)(ws + WS_SSQ_A))
#define SSQ_F_ ((float*)(ws + WS_SSQ_F))
#define SSQ_ATT_ ((float*)(ws + WS_SSQ_ATT))
#define SSQ_SSM_ ((float*)(ws + WS_SSQ_SSM))

    if (IN(0)) REP(0) {
        PH();
        { v4u* ebz = (v4u*)(ws + WS_EB); for (int i = F.bx * 512 + F.tid; i < 65536; i += F.G * 512) ebz[i] = (v4u){0u, 0u, 0u, 0u}; }
        p0_xb(F, args->in[0], F.bx, F.G);
        { LAS unsigned char* scr = F.lds + RING_OFF + F.wave * CONV_LDS; const int it = F.vcu * NWAVES + F.wave;
          if (it < IT_IN) conv_inproj(args->in[2], args->in[1], (bf16*)(ws + WS_WSMALL + WS_WIN), it, F.lane, scr); }
        SEAM(0);
    }
    if (IN(1) && lo <= 1 && 1 < hi) { PH(); if (F.bx >= 64 && F.bx < 64 + 2 * NG) ssm_precompute(F, args, (F.bx - 64) / NG, (F.bx - 64) % NG); }
    for (int l = 0; l < 2; ++l) {
        const int pb = l == 0 ? 1 : 8;
        if (IN(pb)) REP(pb) {
            PH(); unsigned char* wb = ws + WS_WSMALL + l * WSMALL_STRIDE;
            pg8::Gemm g{XB_, (const bf16*)(wb + WS_WIN), nullptr}; pg8::StaticOrder S; S.init(T, INW, F.G, F.bx);
            pg8::EpiInProj E{QKVU_, (bf16*)(ws + WS_UG), (LAS float*)(F.lds + TAB2_OFF), args->in[3] + l * HD, args->in[4] + l * HD, 0.125f * LOG2E};
            pg8::fill_rinv_tab(S, SSQ_A_, (LAS float*)(F.lds + TAB2_OFF), F.tid, TAB2_UNITS);
            pg8::gemm_phase<pg8::EpiInProj, pg8::StaticOrder, false, D>(F.lds + RING_OFF, g, S, E);
            if (l == 0 && F.bx >= 64 + 2 * NG) p0_convert(F, args, F.bx - 64 - 2 * NG, F.G - 64 - 2 * NG, IT_IN, IT_P0);
            bg_convert(F, args, l == 0 ? 0 : BG_B3, l == 0 ? BG_B1 : BG_B4, F.bx - (l == 0 ? 64 + 2 * NG : 64), F.G - (l == 0 ? 64 + 2 * NG : 64));
            SEAM(pb);
        }
        if (IN(pb + 1)) REP(pb + 1) { PH(); ssm_phase_v2(F, l); attn_phase_v1(F, args, l, 0, F.G); bg_convert(F, args, l == 0 ? BG_B1 : BG_B4, l == 0 ? BG_B2 : BG_B5, F.bx, F.G); SEAM(pb + 1); }
        if (IN(pb + 3)) REP(pb + 3) {
            PH(); unsigned char* wb = ws + WS_WSMALL + l * WSMALL_STRIDE;
            pg8::Gemm g{YG_, (const bf16*)(wb + WS_WGLU), nullptr}; pg8::StaticOrder S; S.init(T, SW, F.G, F.bx);
            pg8::EpiGlu E{YG_, MIX_, SSQ_SSM_};
            pg8::gemm_phase<pg8::EpiGlu, pg8::StaticOrder, false, SW>(F.lds + RING_OFF, g, S, E);
            bg_convert(F, args, l == 0 ? BG_B2 : BG_B5, l == 0 ? BG_B3 : BG_B6, F.bx - 128, F.G - 128);
            SEAM(pb + 3);
        }
        if (IN(pb + 4)) REP(pb + 4) {
            PH(); unsigned char* wb = ws + WS_WSMALL + l * WSMALL_STRIDE;
            pg8::Gemm g{MIX_, (const bf16*)(wb + WS_WO), nullptr}; pg8::StaticOrder S; S.init(T, D, F.G, F.bx);
            pg8::EpiRes<true, false> E{nullptr, XB_, SSQ_F_, SSQ_ATT_, SSQ_SSM_, (LAS float*)(F.lds + TAB_OFF)};
            pg8::gemm_phase<pg8::EpiRes<true, false>, pg8::StaticOrder, false, D>(F.lds + RING_OFF, g, S, E);
            SEAM(pb + 4);
        }
    if (l == 0) {
        if (IN(6)) REP(6) {
            PH();
            pg8::Gemm g{XB_, (const bf16*)(ws + WS_DGU), nullptr}; pg8::StaticOrder S; S.init(T, 2 * FF, F.G, F.bx);
            pg8::EpiSwiglu<false> E{(bf16*)(ws + WS_HD), nullptr, (LAS float*)(F.lds + TAB2_OFF)};
            pg8::fill_rinv_tab(S, SSQ_F_, (LAS float*)(F.lds + TAB2_OFF), F.tid, TAB2_UNITS);
            pg8::gemm_phase<pg8::EpiSwiglu<false>, pg8::StaticOrder, false, D>(F.lds + RING_OFF, g, S, E);
            SEAM(6);
        }
        if (IN(7)) REP(7) {
            PH();
            pg8::Gemm g{(const bf16*)(ws + WS_HD), (const bf16*)(ws + WS_DD), nullptr}; pg8::StaticOrder S; S.init(T, D, F.G, F.bx);
            pg8::EpiRes<false, false> E{nullptr, XB_, SSQ_A_, nullptr, nullptr, (LAS float*)(F.lds + TAB_OFF)};
            pg8::gemm_phase<pg8::EpiRes<false, false>, pg8::StaticOrder, false, FF>(F.lds + RING_OFF, g, S, E);
            SEAM(7);
        }
    } else {
        if (IN(13)) REP(13) { PH(); route1(F, args); SEAM(13); }
        if (IN(14)) REP(14) { PH(); route2(F); conv_run2<0>(F, args, BG_B6 + F.bx * NWAVES + F.wave, F.G * NWAVES, IT_BG); SEAM(14); }
        if (IN(15)) REP(15) {
            PH(); unsigned char* rt = ws + WS_ROUTE;
            pg8::Gemm g{XB_, (const bf16*)(ws + WS_MOEW), (const int*)(rt + RT_IDX)}; pg8::MoeOrder S; S.init((const int*)(rt + RT_PEND), 2 * FF, F.G, F.bx);
            pg8::EpiSwiglu<true> E{(bf16*)(ws + WS_HS), (const float*)(rt + RT_RINVS), nullptr};
            pg8::gemm_phase<pg8::EpiSwiglu<true>, pg8::MoeOrder, true, D>(F.lds + RING_OFF, g, S, E);
            { const int rem = S.nwg % F.G, q = wd_quota(rem, F.G);
              if (rem && F.bx >= rem) conv_run2<1>(F, args, (F.bx - rem) * NWAVES + F.wave, (F.G - rem) * NWAVES, q); }
            SEAM(15);
        }
        if (IN(16)) REP(16) { PH(); const int nwgu = ((const int*)(ws + WS_ROUTE + RT_PEND))[7] * (2 * FF / 256), q = wd_quota(nwgu % F.G, F.G);
            if (q < NE * IT_DN) { conv_run2<1>(F, args, q + F.vcu * NWAVES + F.wave, F.G * NWAVES, NE * IT_DN); SEAM(16); } }
        if (IN(17)) REP(17) {
            PH(); unsigned char* rt = ws + WS_ROUTE;
            pg8::Gemm g{(const bf16*)(ws + WS_HS), (const bf16*)(ws + WS_WDT), nullptr}; pg8::MoeOrderSplit<FF / 64> S; S.init((const int*)(rt + RT_PEND), D, F.G, F.bx, WDT_E7);
            pg8::EpiMoeDown E{(bf16*)(ws + WS_YS), (bf16*)(ws + WS_YS2), YS_SPLIT, (const float*)(rt + RT_GATE), (float*)(ws + WS_SLAB), (unsigned*)(ws + WS_CTL) + CW_TAILMAP, S.S};
            pg8::gemm_phase<pg8::EpiMoeDown, pg8::MoeOrderSplit<FF / 64>, false, FF>(F.lds + RING_OFF, g, S, E);
            SEAM(17);
        }
        if (IN(18)) REP(18) { PH(); moe_combine(F); }
    }
    }
#undef IN
#undef SEAM
}

extern "C" void kernel_launch(void* const* d_in, const int* in_sizes, int n_in, void* d_out, int out_size, void* d_ws, size_t ws_size, hipStream_t stream) {
    static int grid = 0;
    if (grid == 0) {
        if (n_in != 26 || in_sizes[0] != T * D || out_size != T * D || ws_size < WS_END) { fprintf(stderr, "kernel_launch: unexpected shapes/workspace (n_in %d, in0 %d, out %d, ws %zu, need %zu); nothing launched\n", n_in, n_in > 0 ? in_sizes[0] : -1, out_size, ws_size, (size_t)WS_END); grid = -1; return; }
        int dev = 0, cus = 0, per_cu = 0;
        if (hipGetDevice(&dev) != hipSuccess || hipDeviceGetAttribute(&cus, hipDeviceAttributeMultiprocessorCount, dev) != hipSuccess) { grid = -1; return; }
        if (hipFuncSetAttribute((const void*)hymba_fwd, hipFuncAttributeMaxDynamicSharedMemorySize, LDS_BYTES) != hipSuccess) { fprintf(stderr, "kernel_launch: hipFuncSetAttribute failed\n"); grid = -1; return; }
        if (hipOccupancyMaxActiveBlocksPerMultiprocessor(&per_cu, (const void*)hymba_fwd, NWAVES * 64, LDS_BYTES) != hipSuccess || per_cu < 1) { fprintf(stderr, "kernel_launch: occupancy query reports %d workgroups per CU\n", per_cu); (void)hipGetLastError(); grid = -1; return; }
        grid = cus;
    }
    if (grid < 0) return;
    (void)hipMemsetAsync((char*)d_ws + WS_CTL, 0, CTL_ZERO_BYTES, stream);
    Args a{};
    for (int i = 0; i < 26; ++i) a.in[i] = (const float*)d_in[i];
    a.out = (float*)d_out; a.ws = (unsigned char*)d_ws;
#if MK_N_LAUNCHES == 1
    a.ph_lo = 0; a.ph_hi = NPHASE;
    hipLaunchKernelGGL(hymba_fwd, dim3(grid), dim3(NWAVES * 64), LDS_BYTES, stream, a);
#else
    for (int p = 0; p < NPHASE; ++p) { a.ph_lo = p; a.ph_hi = p + 1; hipLaunchKernelGGL(hymba_fwd, dim3(grid), dim3(NWAVES * 64), LDS_BYTES, stream, a); }
#endif
}
```
